# Optimizing an MI355X kernel written in HIP

```python
import math
import jax, jax.numpy as jnp
from jax import lax
import numpy as np

D_MODEL = 1024
BATCH = 16
SEQ = 2048
DEPTH = 1

PLE_DIM = 256
EPS = 1e-6

GLA_HEADS = 4
GLA_DK = 64
GLA_DV = 128
GLA_LOWRANK = 16
GLA_TAU = 16.0
GLA_CHUNK = 64

DIFF_HEADS = 4
DIFF_DH = 64
DIFF_DV = 2 * DIFF_DH
ROPE_THETA = 500000.0
ROPE_DIM = DIFF_DH // 4
Q_BLOCK = 128

N_GROUPS = 4
EXPERTS_PER_GROUP = 8
N_EXPERTS = N_GROUPS * EXPERTS_PER_GROUP
TOP_K = 2
D_EXPERT = 256

SPLIT_SIZES = (
    GLA_HEADS * GLA_DK,
    GLA_HEADS * GLA_DK,
    GLA_HEADS * GLA_DV,
    GLA_HEADS * GLA_DV,
    GLA_LOWRANK,
    DIFF_HEADS * 2 * DIFF_DH,
    DIFF_HEADS * 2 * DIFF_DH,
    DIFF_HEADS * DIFF_DV,
    D_MODEL,
    D_MODEL,
)
D_IN = sum(SPLIT_SIZES)

kernel_name = "hybrid_gla_diffattn_hmoe_block"


def rmsnorm(x, g):
    xf = x.astype(jnp.float32)
    y = xf * lax.rsqrt(jnp.mean(xf * xf, axis=-1, keepdims=True) + EPS)
    return (y * g.astype(jnp.float32)).astype(x.dtype)


def rope_partial(x, pos):
    half = ROPE_DIM // 2
    inv = ROPE_THETA ** (-jnp.arange(0, ROPE_DIM, 2, dtype=jnp.float32) / ROPE_DIM)
    ang = pos.astype(jnp.float32)[..., None] * inv
    cos = jnp.cos(ang)[:, :, None, :]
    sin = jnp.sin(ang)[:, :, None, :]
    xr = x[..., :ROPE_DIM].astype(jnp.float32)
    x1, x2 = xr[..., :half], xr[..., half:]
    rot = jnp.concatenate([x1 * cos - x2 * sin, x2 * cos + x1 * sin], axis=-1)
    return jnp.concatenate([rot.astype(x.dtype), x[..., ROPE_DIM:]], axis=-1)


def gla_branch(q, k, v, log_a):
    B, S, H, DK = q.shape
    DV = v.shape[-1]
    N = S // GLA_CHUNK

    def chunks(t):
        return t.astype(jnp.float32).reshape(B, N, GLA_CHUNK, H, t.shape[-1]).transpose(0, 3, 1, 2, 4)

    qc, kc, vc, lac = chunks(q), chunks(k), chunks(v), chunks(log_a)
    b = jnp.cumsum(lac, axis=3)
    b_last = b[:, :, :, -1, :]
    q_dec = qc * jnp.exp(b)
    k_inv = kc * jnp.exp(-b)
    causal = jnp.tril(jnp.ones((GLA_CHUNK, GLA_CHUNK), dtype=bool))
    att = jnp.einsum('bhncd,bhnsd->bhncs', q_dec, k_inv)
    att = jnp.where(causal, att, 0.0)
    o_intra = jnp.einsum('bhncs,bhnsv->bhncv', att, vc)

    k_end = kc * jnp.exp(b_last[:, :, :, None, :] - b)
    u = jnp.einsum('bhncd,bhncv->bhndv', k_end, vc)
    decay = jnp.exp(b_last)

    def step(state, inp):
        dec, un = inp
        return state * dec[..., None] + un, state

    s0 = jnp.zeros((B, H, DK, DV), jnp.float32)
    _, s_prev = lax.scan(step, s0, (jnp.moveaxis(decay, 2, 0), jnp.moveaxis(u, 2, 0)))
    s_prev = jnp.moveaxis(s_prev, 0, 2)
    o_inter = jnp.einsum('bhncd,bhndv->bhncv', q_dec, s_prev)
    o = o_intra + o_inter
    return o.transpose(0, 2, 3, 1, 4).reshape(B, S, H, DV)


def diff_attention(q, k, v, lam):
    B, H, _, S, Dh = q.shape
    DV = v.shape[-1]
    nb = S // Q_BLOCK
    scale = Dh ** -0.5
    qb = q.reshape(B, H, 2, nb, Q_BLOCK, Dh).transpose(3, 0, 1, 2, 4, 5)
    kpos = jnp.arange(S)
    neg = jnp.finfo(jnp.float32).min

    def block(args):
        qblk, i = args
        s = jnp.einsum('bhcqd,bhckd->bhcqk', qblk, k).astype(jnp.float32) * scale
        qpos = i * Q_BLOCK + jnp.arange(Q_BLOCK)
        mask = qpos[:, None] >= kpos[None, :]
        s = jnp.where(mask, s, neg)
        a = jax.nn.softmax(s, axis=-1)
        w = a[:, :, 0] - lam * a[:, :, 1]
        return jnp.einsum('bhqk,bhkv->bhqv', w.astype(v.dtype), v)

    out = lax.map(block, (qb, jnp.arange(nb)))
    return out.transpose(1, 0, 3, 2, 4).reshape(B, S, H, DV)


def token_mixers(n, positions, w_in, w_a2, b_a, gla_norm, lq1, lk1, lq2, lk2,
                 diff_subln, w_branch_a, w_branch_b, w_out, lambda_init):
    B, S, _ = n.shape
    proj = n @ w_in
    idx = [int(c) for c in np.cumsum(SPLIT_SIZES)[:-1]]
    (g_q, g_k, g_v, g_r, g_al, d_q, d_k, d_v, gate_a, gate_b) = jnp.split(proj, idx, axis=-1)

    gq = g_q.reshape(B, S, GLA_HEADS, GLA_DK) * (GLA_DK ** -0.5)
    gk = g_k.reshape(B, S, GLA_HEADS, GLA_DK)
    gv = g_v.reshape(B, S, GLA_HEADS, GLA_DV)
    a_logit = (g_al @ w_a2 + b_a).astype(jnp.float32)
    log_a = (jax.nn.log_sigmoid(a_logit) / GLA_TAU).reshape(B, S, GLA_HEADS, GLA_DK)
    o_a = gla_branch(gq, gk, gv, log_a)
    o_a = rmsnorm(o_a, gla_norm).reshape(B, S, GLA_HEADS * GLA_DV).astype(n.dtype)
    o_a = o_a * jax.nn.silu(g_r)
    y_a = o_a @ w_branch_a

    dq = rope_partial(d_q.reshape(B, S, DIFF_HEADS * 2, DIFF_DH), positions)
    dk = rope_partial(d_k.reshape(B, S, DIFF_HEADS * 2, DIFF_DH), positions)
    dq = dq.reshape(B, S, DIFF_HEADS, 2, DIFF_DH).transpose(0, 2, 3, 1, 4)
    dk = dk.reshape(B, S, DIFF_HEADS, 2, DIFF_DH).transpose(0, 2, 3, 1, 4)
    dv = d_v.reshape(B, S, DIFF_HEADS, DIFF_DV).transpose(0, 2, 1, 3)
    lam = (jnp.exp(jnp.sum(lq1.astype(jnp.float32) * lk1.astype(jnp.float32)))
           - jnp.exp(jnp.sum(lq2.astype(jnp.float32) * lk2.astype(jnp.float32)))
           + lambda_init)
    o_b = diff_attention(dq, dk, dv, lam)
    o_b = rmsnorm(o_b, diff_subln) * (1.0 - lambda_init)
    y_b = o_b.reshape(B, S, DIFF_HEADS * DIFF_DV).astype(n.dtype) @ w_branch_b

    merged = jax.nn.sigmoid(gate_a) * y_a + jax.nn.sigmoid(gate_b) * y_b
    return merged @ w_out


def hierarchical_moe(n, w_rg, b_rg, w_re, b_re, w_gate, w_up, w_down):
    B, S, D = n.shape
    xt = n.reshape(B * S, D)
    T = xt.shape[0]
    g_logits = (xt @ w_rg + b_rg).astype(jnp.float32)
    g_prob = jax.nn.softmax(g_logits, axis=-1)
    g_p, g_idx = lax.top_k(g_prob, 1)
    e_logits = (xt @ w_re + b_re).astype(jnp.float32).reshape(T, N_GROUPS, EXPERTS_PER_GROUP)
    e_logits = jnp.take_along_axis(e_logits, g_idx[:, :, None], axis=1)[:, 0]
    e_prob = jax.nn.softmax(e_logits, axis=-1)
    e_p, e_idx = lax.top_k(e_prob, TOP_K)
    e_p = e_p / jnp.sum(e_p, axis=-1, keepdims=True)
    weights = g_p * e_p
    eid = g_idx * EXPERTS_PER_GROUP + e_idx
    comb = jnp.sum(jax.nn.one_hot(eid, N_EXPERTS, dtype=jnp.float32) * weights[..., None], axis=1)
    comb = comb.astype(n.dtype)
    y = jnp.zeros_like(xt)
    for e in range(N_EXPERTS):
        he = jax.nn.silu(xt @ w_gate[e]) * (xt @ w_up[e])
        y = y + comb[:, e:e + 1] * (he @ w_down[e])
    return y.reshape(B, S, D)


def setup_inputs(seed: int = 0) -> dict:
    key = jax.random.key(seed)
    ks = iter(jax.random.split(key, 40))

    def nrm(shape, fan_in):
        return jax.random.normal(next(ks), shape, jnp.float32) * (fan_in ** -0.5)

    def gain(shape):
        return 1.0 + 0.01 * jax.random.normal(next(ks), shape, jnp.float32)

    x = jax.random.normal(next(ks), (BATCH, SEQ, D_MODEL), jnp.float32)
    p = jax.random.normal(next(ks), (DEPTH, BATCH, SEQ, PLE_DIM), jnp.float32)
    offs = jax.random.randint(next(ks), (BATCH, 1), 0, 4096, dtype=jnp.int32)
    positions = offs + jnp.arange(SEQ, dtype=jnp.int32)[None, :]
    return {
        "x": x,
        "p": p,
        "positions": positions,
        "attn_norm": gain((DEPTH, D_MODEL)),
        "w_in": nrm((DEPTH, D_MODEL, D_IN), D_MODEL),
        "w_a2": nrm((DEPTH, GLA_LOWRANK, GLA_HEADS * GLA_DK), GLA_LOWRANK),
        "b_a": 0.1 * jax.random.normal(next(ks), (DEPTH, GLA_HEADS * GLA_DK), jnp.float32),
        "gla_norm": gain((DEPTH, GLA_DV)),
        "lambda_q1": 0.1 * jax.random.normal(next(ks), (DEPTH, DIFF_DH), jnp.float32),
        "lambda_k1": 0.1 * jax.random.normal(next(ks), (DEPTH, DIFF_DH), jnp.float32),
        "lambda_q2": 0.1 * jax.random.normal(next(ks), (DEPTH, DIFF_DH), jnp.float32),
        "lambda_k2": 0.1 * jax.random.normal(next(ks), (DEPTH, DIFF_DH), jnp.float32),
        "diff_subln": gain((DEPTH, DIFF_DV)),
        "w_branch_a": nrm((DEPTH, GLA_HEADS * GLA_DV, D_MODEL), GLA_HEADS * GLA_DV),
        "w_branch_b": nrm((DEPTH, DIFF_HEADS * DIFF_DV, D_MODEL), DIFF_HEADS * DIFF_DV),
        "w_out": nrm((DEPTH, D_MODEL, D_MODEL), D_MODEL),
        "ffn_norm": gain((DEPTH, D_MODEL)),
        "w_router_group": nrm((DEPTH, D_MODEL, N_GROUPS), D_MODEL),
        "b_router_group": 0.01 * jax.random.normal(next(ks), (DEPTH, N_GROUPS), jnp.float32),
        "w_router_expert": nrm((DEPTH, D_MODEL, N_EXPERTS), D_MODEL),
        "b_router_expert": 0.01 * jax.random.normal(next(ks), (DEPTH, N_EXPERTS), jnp.float32),
        "w_gate": nrm((DEPTH, N_EXPERTS, D_MODEL, D_EXPERT), D_MODEL),
        "w_up": nrm((DEPTH, N_EXPERTS, D_MODEL, D_EXPERT), D_MODEL),
        "w_down": nrm((DEPTH, N_EXPERTS, D_EXPERT, D_MODEL), D_EXPERT),
        "w_ple": nrm((DEPTH, PLE_DIM, D_MODEL), PLE_DIM),
        "ple_norm": gain((DEPTH, D_MODEL)),
        "w_ple_gate": nrm((DEPTH, D_MODEL, D_MODEL), D_MODEL),
        "final_norm": gain((D_MODEL,)),
    }


def reference(x, p, positions, attn_norm, w_in, w_a2, b_a, gla_norm,
              lambda_q1, lambda_k1, lambda_q2, lambda_k2, diff_subln,
              w_branch_a, w_branch_b, w_out, ffn_norm,
              w_router_group, b_router_group, w_router_expert, b_router_expert,
              w_gate, w_up, w_down, w_ple, ple_norm, w_ple_gate, final_norm):
    h = x
    for i in range(DEPTH):
        lambda_init = 0.8 - 0.6 * math.exp(-0.3 * i)
        n = rmsnorm(h, attn_norm[i])
        h = h + token_mixers(n, positions, w_in[i], w_a2[i], b_a[i], gla_norm[i],
                             lambda_q1[i], lambda_k1[i], lambda_q2[i], lambda_k2[i],
                             diff_subln[i], w_branch_a[i], w_branch_b[i], w_out[i],
                             lambda_init)
        n2 = rmsnorm(h, ffn_norm[i])
        h = h + hierarchical_moe(n2, w_router_group[i], b_router_group[i],
                                 w_router_expert[i], b_router_expert[i],
                                 w_gate[i], w_up[i], w_down[i])
        e = rmsnorm(p[i] @ w_ple[i], ple_norm[i])
        h = h + jax.nn.sigmoid(h @ w_ple_gate[i]) * e
    return rmsnorm(h, final_norm)
```

```cpp
#include <hip/hip_runtime.h>
#include <math.h>

namespace orc {
constexpr int B = 16, S = 2048, D = 1024, T = B * S, DIN = 5136, PLE = 256;
constexpr int C_Q = 0, C_K = 256, C_V = 512, C_R = 1024, C_AL = 1536, C_DQ = 1552, C_DK = 2064, C_DV = 2576, C_GA = 3088, C_GB = 4112;
constexpr float EPS = 1e-6f;

template <bool TB>
__global__ void __launch_bounds__(256) gemm(const float* A, int lda, const float* Bm, int ldb, float* C, int ldc, int M, int N, int K, long sA, long sB, long sC) {
    __shared__ float As[16][65];
    __shared__ float Bs[16][65];
    A += (long)blockIdx.z * sA; Bm += (long)blockIdx.z * sB; C += (long)blockIdx.z * sC;
    const int m0 = blockIdx.y * 64, n0 = blockIdx.x * 64, tid = threadIdx.x, tx = tid & 15, ty = tid >> 4;
    float acc[4][4];
#pragma unroll
    for (int i = 0; i < 4; ++i)
#pragma unroll
        for (int j = 0; j < 4; ++j) acc[i][j] = 0.f;
    for (int k0 = 0; k0 < K; k0 += 16) {
#pragma unroll
        for (int i = 0; i < 4; ++i) { const int e = tid + i * 256, m = e >> 4, k = e & 15; float v = 0.f; if (m0 + m < M && k0 + k < K) v = A[(long)(m0 + m) * lda + k0 + k]; As[k][m] = v; }
#pragma unroll
        for (int i = 0; i < 4; ++i) { const int e = tid + i * 256;
            if (!TB) { const int k = e >> 6, n = e & 63; float v = 0.f; if (n0 + n < N && k0 + k < K) v = Bm[(long)(k0 + k) * ldb + n0 + n]; Bs[k][n] = v; }
            else { const int n = e >> 4, k = e & 15; float v = 0.f; if (n0 + n < N && k0 + k < K) v = Bm[(long)(n0 + n) * ldb + k0 + k]; Bs[k][n] = v; } }
        __syncthreads();
#pragma unroll
        for (int k = 0; k < 16; ++k) {
            float a[4], b[4];
#pragma unroll
            for (int i = 0; i < 4; ++i) { a[i] = As[k][ty * 4 + i]; b[i] = Bs[k][tx * 4 + i]; }
#pragma unroll
            for (int i = 0; i < 4; ++i)
#pragma unroll
                for (int j = 0; j < 4; ++j) acc[i][j] += a[i] * b[j];
        }
        __syncthreads();
    }
#pragma unroll
    for (int i = 0; i < 4; ++i)
#pragma unroll
        for (int j = 0; j < 4; ++j) { const int m = m0 + ty * 4 + i, n = n0 + tx * 4 + j; if (m < M && n < N) C[(long)m * ldc + n] = acc[i][j]; }
}

__device__ __forceinline__ float block_sum(float v, float* red) {
#pragma unroll
    for (int o = 32; o > 0; o >>= 1) v += __shfl_xor(v, o);
    const int w = threadIdx.x >> 6, nw = blockDim.x >> 6;
    __syncthreads();
    if ((threadIdx.x & 63) == 0) red[w] = v;
    __syncthreads();
    float s = 0.f;
    for (int i = 0; i < nw; ++i) s += red[i];
    return s;
}
__device__ __forceinline__ float block_max(float v, float* red) {
#pragma unroll
    for (int o = 32; o > 0; o >>= 1) v = fmaxf(v, __shfl_xor(v, o));
    const int w = threadIdx.x >> 6, nw = blockDim.x >> 6;
    __syncthreads();
    if ((threadIdx.x & 63) == 0) red[w] = v;
    __syncthreads();
    float s = -INFINITY;
    for (int i = 0; i < nw; ++i) s = fmaxf(s, red[i]);
    return s;
}
__device__ __forceinline__ float sigm(float x) { return 1.f / (1.f + expf(-x)); }

__global__ void __launch_bounds__(256) rmsnorm_rows(const float* in, int ldi, const float* g, float* out, int ldo, int n, float mul) {
    __shared__ float red[4];
    const float* r = in + (long)blockIdx.x * ldi; float* o = out + (long)blockIdx.x * ldo;
    float v[4]; float s = 0.f;
#pragma unroll
    for (int i = 0; i < 4; ++i) { const int c = threadIdx.x + i * 256; v[i] = c < n ? r[c] : 0.f; s += v[i] * v[i]; }
    const float tot = block_sum(s, red), rs = rsqrtf(tot / (float)n + EPS) * mul;
#pragma unroll
    for (int i = 0; i < 4; ++i) { const int c = threadIdx.x + i * 256; if (c < n) o[c] = v[i] * rs * g[c]; }
}
__global__ void __launch_bounds__(128) headnorm(const float* in, const float* g, float mul, const float* gate, int ldg, float* out) {
    __shared__ float red[2];
    const long row = blockIdx.x; const int h = blockIdx.y, j = threadIdx.x;
    const float v = in[row * 512 + h * 128 + j];
    const float tot = block_sum(v * v, red);
    float o = v * rsqrtf(tot / 128.f + EPS) * g[j] * mul;
    if (gate) { const float r = gate[row * ldg + h * 128 + j]; o *= r * sigm(r); }
    out[row * 512 + h * 128 + j] = o;
}
__global__ void loga_kernel(float* al, const float* b_a, int n) {
    const int i = blockIdx.x * blockDim.x + threadIdx.x; if (i >= n) return;
    const float x = al[i] + b_a[i & 255];
    al[i] = (fminf(x, 0.f) - log1pf(expf(-fabsf(x)))) * (1.f / 16.f);
}
__global__ void __launch_bounds__(128) gla_rec(const float* proj, const float* loga, float* o_raw) {
    const int h = blockIdx.x, j = threadIdx.x;
    float st[64];
#pragma unroll
    for (int d = 0; d < 64; ++d) st[d] = 0.f;
    for (int t = 0; t < S; ++t) {
        const float* pr = proj + (long)t * DIN; const float* la = loga + (long)t * 256 + h * 64;
        const float v = pr[C_V + h * 128 + j];
        float o = 0.f;
#pragma unroll
        for (int d = 0; d < 64; ++d) {
            st[d] = expf(la[d]) * st[d] + pr[C_K + h * 64 + d] * v;
            o += pr[C_Q + h * 64 + d] * 0.125f * st[d];
        }
        o_raw[(long)t * 512 + h * 128 + j] = o;
    }
}
__global__ void rope_kernel(float* proj, const int* pos) {
    const int i = blockIdx.x * blockDim.x + threadIdx.x; if (i >= S * 2 * 8 * 8) return;
    const int j = i & 7, g = (i >> 3) & 7, which = (i >> 6) & 1, t = i >> 7;
    float* p = proj + (long)t * DIN + (which ? C_DK : C_DQ) + g * 64;
    const double ang = (double)pos[t] * pow(500000.0, -(double)(2 * j) / 16.0);
    const float c = (float)cos(ang), s = (float)sin(ang);
    const float x1 = p[j], x2 = p[j + 8];
    p[j] = x1 * c - x2 * s; p[j + 8] = x2 * c + x1 * s;
}
__global__ void __launch_bounds__(256) softmax_diff(float* sc, const float* lq1, const float* lk1, const float* lq2, const float* lk2, float lambda_init) {
    __shared__ float red[4];
    const int q = blockIdx.x, h = blockIdx.y;
    float d1 = 0.f, d2 = 0.f;
    for (int i = 0; i < 64; ++i) { d1 += lq1[i] * lk1[i]; d2 += lq2[i] * lk2[i]; }
    const float lam = expf(d1) - expf(d2) + lambda_init;
    float* s1 = sc + ((long)(h * 2 + 0) * S + q) * S; float* s2 = sc + ((long)(h * 2 + 1) * S + q) * S;
    float a[8], b[8]; float m1 = -INFINITY, m2 = -INFINITY;
#pragma unroll
    for (int i = 0; i < 8; ++i) { const int k = threadIdx.x + i * 256; a[i] = k <= q ? s1[k] * 0.125f : -INFINITY; b[i] = k <= q ? s2[k] * 0.125f : -INFINITY; m1 = fmaxf(m1, a[i]); m2 = fmaxf(m2, b[i]); }
    m1 = block_max(m1, red); m2 = block_max(m2, red);
    float l1 = 0.f, l2 = 0.f;
#pragma unroll
    for (int i = 0; i < 8; ++i) { a[i] = expf(a[i] - m1); b[i] = expf(b[i] - m2); l1 += a[i]; l2 += b[i]; }
    l1 = block_sum(l1, red); l2 = block_sum(l2, red);
#pragma unroll
    for (int i = 0; i < 8; ++i) { const int k = threadIdx.x + i * 256; s1[k] = a[i] / l1 - lam * b[i] / l2; }
}
__global__ void merge_kernel(const float* proj, const float* ya, const float* yb, float* mg, int n) {
    const int i = blockIdx.x * blockDim.x + threadIdx.x; if (i >= n) return;
    const int t = i >> 10, c = i & 1023;
    mg[i] = sigm(proj[(long)t * DIN + C_GA + c]) * ya[i] + sigm(proj[(long)t * DIN + C_GB + c]) * yb[i];
}
__global__ void add_kernel(const float* a, const float* b, float* o, int n) { const int i = blockIdx.x * blockDim.x + threadIdx.x; if (i < n) o[i] = a[i] + b[i]; }

__global__ void __launch_bounds__(256) moe_token(const float* n2, float* h, const float* w_rg, const float* b_rg, const float* w_re, const float* b_re,
                                                 const float* w_gate, const float* w_up, const float* w_down) {
    __shared__ float x[1024]; __shared__ float lg[36]; __shared__ float he[256]; __shared__ int sel[2]; __shared__ float sw[2];
    const long row = blockIdx.x; const int tid = threadIdx.x;
    for (int i = tid; i < 1024; i += 256) x[i] = n2[row * 1024 + i];
    __syncthreads();
    if (tid < 36) { float s = 0.f;
        if (tid < 4) { for (int k = 0; k < 1024; ++k) s += x[k] * w_rg[k * 4 + tid]; s += b_rg[tid]; }
        else { const int e = tid - 4; for (int k = 0; k < 1024; ++k) s += x[k] * w_re[k * 32 + e]; s += b_re[e]; }
        lg[tid] = s; }
    __syncthreads();
    if (tid == 0) {
        int g = 0; float mg = lg[0]; for (int i = 1; i < 4; ++i) if (lg[i] > mg) { mg = lg[i]; g = i; }
        float sg = 0.f; for (int i = 0; i < 4; ++i) sg += expf(lg[i] - mg);
        const float gp = 1.f / sg;
        const float* el = lg + 4 + g * 8;
        int e0 = 0; float m0 = el[0]; for (int i = 1; i < 8; ++i) if (el[i] > m0) { m0 = el[i]; e0 = i; }
        int e1 = -1; float m1 = -INFINITY; for (int i = 0; i < 8; ++i) if (i != e0 && el[i] > m1) { m1 = el[i]; e1 = i; }
        const float p0 = 1.f, p1 = expf(m1 - m0);
        sel[0] = g * 8 + e0; sel[1] = g * 8 + e1; sw[0] = gp * p0 / (p0 + p1); sw[1] = gp * p1 / (p0 + p1);
    }
    __syncthreads();
    float y[4] = {0.f, 0.f, 0.f, 0.f};
    for (int kk = 0; kk < 2; ++kk) {
        const int e = sel[kk]; const float w = sw[kk];
        const float* wg = w_gate + (long)e * 1024 * 256; const float* wu = w_up + (long)e * 1024 * 256; const float* wd = w_down + (long)e * 256 * 1024;
        float g = 0.f, u = 0.f;
        for (int k = 0; k < 1024; ++k) { g += x[k] * wg[k * 256 + tid]; u += x[k] * wu[k * 256 + tid]; }
        __syncthreads();
        he[tid] = g * sigm(g) * u;
        __syncthreads();
#pragma unroll
        for (int c = 0; c < 4; ++c) { float s = 0.f; for (int j = 0; j < 256; ++j) s += he[j] * wd[j * 1024 + tid + c * 256]; y[c] += w * s; }
    }
#pragma unroll
    for (int c = 0; c < 4; ++c) h[row * 1024 + tid + c * 256] += y[c];
}
__global__ void __launch_bounds__(256) final_kernel(float* h, const float* G, const float* E, const float* g) {
    __shared__ float red[4];
    const long row = blockIdx.x; float v[4]; float s = 0.f;
#pragma unroll
    for (int i = 0; i < 4; ++i) { const long c = row * 1024 + threadIdx.x + i * 256; v[i] = h[c] + sigm(G[c]) * E[c]; s += v[i] * v[i]; }
    const float rs = rsqrtf(block_sum(s, red) / 1024.f + EPS);
#pragma unroll
    for (int i = 0; i < 4; ++i) { const int c = threadIdx.x + i * 256; h[row * 1024 + c] = v[i] * rs * g[c]; }
}
}

extern "C" void kernel_launch(void* const* d_in, const int* in_sizes, int n_in, void* d_out, int out_size, void* d_ws, size_t ws_size, hipStream_t stream) {
    using namespace orc;
    const float* x = (const float*)d_in[0]; const float* p = (const float*)d_in[1]; const int* pos = (const int*)d_in[2];
    const float* attn_norm = (const float*)d_in[3]; const float* w_in = (const float*)d_in[4]; const float* w_a2 = (const float*)d_in[5]; const float* b_a = (const float*)d_in[6];
    const float* gla_norm = (const float*)d_in[7]; const float* lq1 = (const float*)d_in[8]; const float* lk1 = (const float*)d_in[9]; const float* lq2 = (const float*)d_in[10]; const float* lk2 = (const float*)d_in[11];
    const float* subln = (const float*)d_in[12]; const float* w_ba = (const float*)d_in[13]; const float* w_bb = (const float*)d_in[14]; const float* w_out = (const float*)d_in[15];
    const float* ffn_norm = (const float*)d_in[16]; const float* w_rg = (const float*)d_in[17]; const float* b_rg = (const float*)d_in[18]; const float* w_re = (const float*)d_in[19]; const float* b_re = (const float*)d_in[20];
    const float* w_gate = (const float*)d_in[21]; const float* w_up = (const float*)d_in[22]; const float* w_down = (const float*)d_in[23];
    const float* w_ple = (const float*)d_in[24]; const float* ple_norm = (const float*)d_in[25]; const float* w_pg = (const float*)d_in[26]; const float* final_norm = (const float*)d_in[27];
    float* H = (float*)d_out;
    char* ws = (char*)d_ws; const size_t MiB = 1u << 20;
    float* nb = (float*)(ws + 0 * MiB);
    float* proj = (float*)(ws + 8 * MiB);
    float* la = (float*)(ws + 50 * MiB);
    float* oraw = (float*)(ws + 52 * MiB);
    float* oa = (float*)(ws + 56 * MiB);
    float* obraw = (float*)(ws + 60 * MiB);
    float* ob = (float*)(ws + 64 * MiB);
    float* ya = (float*)(ws + 68 * MiB);
    float* yb = (float*)(ws + 76 * MiB);
    float* mg = (float*)(ws + 84 * MiB);
    float* mo = (float*)(ws + 92 * MiB);
    float* sc = (float*)(ws + 100 * MiB);
    const float lambda_init = 0.8f - 0.6f * 1.0f;
    for (int b = 0; b < B; ++b) {
        const float* xb = x + (size_t)b * S * D;
        rmsnorm_rows<<<S, 256, 0, stream>>>(xb, D, attn_norm, nb, D, D, 1.f);
        gemm<false><<<dim3((DIN + 63) / 64, S / 64, 1), 256, 0, stream>>>(nb, D, w_in, DIN, proj, DIN, S, DIN, D, 0, 0, 0);
        gemm<false><<<dim3(256 / 64, S / 64, 1), 256, 0, stream>>>(proj + C_AL, DIN, w_a2, 256, la, 256, S, 256, 16, 0, 0, 0);
        loga_kernel<<<S * 256 / 256, 256, 0, stream>>>(la, b_a, S * 256);
        gla_rec<<<4, 128, 0, stream>>>(proj, la, oraw);
        headnorm<<<dim3(S, 4), 128, 0, stream>>>(oraw, gla_norm, 1.f, proj + C_R, DIN, oa);
        rope_kernel<<<S * 128 / 256, 256, 0, stream>>>(proj, pos + b * S);
        gemm<true><<<dim3(S / 64, S / 64, 8), 256, 0, stream>>>(proj + C_DQ, DIN, proj + C_DK, DIN, sc, S, S, S, 64, 64, 64, (long)S * S);
        softmax_diff<<<dim3(S, 4), 256, 0, stream>>>(sc, lq1, lk1, lq2, lk2, lambda_init);
        gemm<false><<<dim3(128 / 64, S / 64, 4), 256, 0, stream>>>(sc, S, proj + C_DV, DIN, obraw, 512, S, 128, S, 2L * S * S, 128, 128);
        headnorm<<<dim3(S, 4), 128, 0, stream>>>(obraw, subln, 1.f - lambda_init, nullptr, 0, ob);
        gemm<false><<<dim3(D / 64, S / 64, 1), 256, 0, stream>>>(oa, 512, w_ba, D, ya, D, S, D, 512, 0, 0, 0);
        gemm<false><<<dim3(D / 64, S / 64, 1), 256, 0, stream>>>(ob, 512, w_bb, D, yb, D, S, D, 512, 0, 0, 0);
        merge_kernel<<<S * D / 256, 256, 0, stream>>>(proj, ya, yb, mg, S * D);
        gemm<false><<<dim3(D / 64, S / 64, 1), 256, 0, stream>>>(mg, D, w_out, D, mo, D, S, D, D, 0, 0, 0);
        add_kernel<<<S * D / 256, 256, 0, stream>>>(xb, mo, H + (size_t)b * S * D, S * D);
    }
    float* n2 = (float*)(ws + 0 * MiB);
    float* E = (float*)(ws + 128 * MiB);
    float* G = (float*)(ws + 256 * MiB);
    rmsnorm_rows<<<T, 256, 0, stream>>>(H, D, ffn_norm, n2, D, D, 1.f);
    moe_token<<<T, 256, 0, stream>>>(n2, H, w_rg, b_rg, w_re, b_re, w_gate, w_up, w_down);
    gemm<false><<<dim3(D / 64, T / 64, 1), 256, 0, stream>>>(p, PLE, w_ple, D, E, D, T, D, PLE, 0, 0, 0);
    rmsnorm_rows<<<T, 256, 0, stream>>>(E, D, ple_norm, E, D, D, 1.f);
    gemm<false><<<dim3(D / 64, T / 64, 1), 256, 0, stream>>>(H, D, w_pg, D, G, D, T, D, D, 0, 0, 0);
    final_kernel<<<T, 256, 0, stream>>>(H, G, E, final_norm);
}
```

```cpp
#include <hip/hip_runtime.h>
#include <hip/hip_cooperative_groups.h>
#include <hip/hip_bf16.h>
#include <cstdio>
#include <cstdint>
#include <cmath>
namespace cg = cooperative_groups;

constexpr int NB = 16, SEQ = 2048, DM = 1024, T = NB * SEQ, DIN = 5136, NPROJ = 5376, PLE = 256;
constexpr int NEXP = 32, DEXP = 256;
constexpr float EPS = 1e-6f;
constexpr float LOG2E = 1.4426950408889634f;
constexpr float QSCALE2 = 0.125f * LOG2E;
constexpr float LAMBDA_INIT = 0.2f;
constexpr int C_Q = 0, C_K = 256, C_V = 512, C_R = 1024, C_AL = 1536, C_DQ = 1552, C_DK = 2064, C_DV = 2576, C_GA = 3088, C_GB = 4112;
constexpr int P_Q = 0, P_K = 256, P_V = 512, P_R = 1024, P_AL = 1536, P_DQ = 1792, P_DK = 2304, P_DV = 2816, P_GA = 3328, P_GB = 4352;

constexpr size_t MiB = 1u << 20;
constexpr size_t WS_CTL = 0, CTL_ZERO_BYTES = 1 * MiB;
constexpr int CW_CNT = 64;
constexpr int CW_QUEUE = 128;
constexpr int CW_SS2 = 65536;
constexpr int CW_SSE = 65536 + 32768;
constexpr int CW_SSF = 65536 + 65536;
static_assert((CW_SSF + 32768) * 4 <= (int)CTL_ZERO_BYTES, "ctl");
constexpr size_t WS_RSTD1 = 1 * MiB;
constexpr size_t WS_TOKE = 1 * MiB + 256 * 1024;
constexpr size_t WS_TOKW = 1 * MiB + 512 * 1024;
constexpr size_t WS_COS = 2 * MiB, WS_SIN = 3 * MiB;
constexpr size_t WS_LIST = 4 * MiB;
constexpr size_t WS_WP = 8 * MiB;
constexpr size_t WS_WGU = 19 * MiB;
constexpr size_t WS_WD = 51 * MiB;
constexpr size_t WS_WAB = 67 * MiB;
constexpr size_t WS_WO = 69 * MiB;
constexpr size_t WS_WPG = 71 * MiB;
constexpr size_t WS_WPLE = 73 * MiB;
constexpr size_t WS_WR = 73 * MiB + 512 * 1024;
constexpr size_t WS_XB = 74 * MiB;
constexpr size_t WS_PB = 138 * MiB;
constexpr size_t WS_ER = 154 * MiB;
constexpr size_t WS_GQ = 218 * MiB, WS_GK = 234 * MiB, WS_GV = 250 * MiB, WS_SR = 282 * MiB, WS_LA = 314 * MiB, WS_DQ = 346 * MiB, WS_DK = 378 * MiB, WS_DV = 410 * MiB;
constexpr size_t WS_MG = 218 * MiB;
constexpr size_t WS_H2B = 282 * MiB;
constexpr size_t WS_YB = 346 * MiB;
constexpr size_t WS_HE = 474 * MiB;
constexpr size_t WS_END = 512 * MiB;
constexpr int MOE_ROWS = 2 * T + NEXP * 256;
static_assert(WS_HE + (size_t)MOE_ROWS * DEXP * 2 <= WS_END, "ws");

constexpr int RING_BYTES = 131072;
constexpr int XTRA_OFF = RING_BYTES;
constexpr int LDS_BYTES = RING_BYTES + 20480;
constexpr int NTHREADS = 512;

#define GAS __attribute__((address_space(1)))
#define LAS __attribute__((address_space(3)))
typedef unsigned short bf16_t;
typedef unsigned v4u __attribute__((ext_vector_type(4)));
typedef unsigned v2u __attribute__((ext_vector_type(2)));
typedef float f32x4 __attribute__((ext_vector_type(4)));
typedef float f32x2 __attribute__((ext_vector_type(2)));
typedef float f32x16 __attribute__((ext_vector_type(16)));
typedef short bf16x8 __attribute__((ext_vector_type(8)));
typedef short s16x4 __attribute__((ext_vector_type(4)));

__device__ __forceinline__ unsigned cvt_pk_bf16(float lo, float hi) { unsigned r; asm volatile("v_cvt_pk_bf16_f32 %0, %1, %2" : "=v"(r) : "v"(lo), "v"(hi)); return r; }
__device__ __forceinline__ float bf_lo(unsigned w) { return __uint_as_float(w << 16); }
__device__ __forceinline__ float bf_hi(unsigned w) { return __uint_as_float(w & 0xffff0000u); }
__device__ __forceinline__ float sigmoidf_(float x) { return __builtin_amdgcn_rcpf(1.f + __builtin_amdgcn_exp2f(-x * LOG2E)); }
__device__ __forceinline__ float wave_sum(float v) {
#pragma unroll
    for (int o = 1; o < 64; o <<= 1) v += __shfl_xor(v, o);
    return v;
}

namespace pg8 {
constexpr int BM = 256, BK = 64, HALF = 128, HTB = HALF * BK * 2, STAGE_BYTES = 8 * HTB, NXCD = 8, WGM = 8;
__host__ __device__ __forceinline__ int lds_byte(int r, int c) { const int st = (r >> 4) * 2 + (c >> 5), rr = r & 15, cc = c & 31, ob = rr * 64 + cc * 2; return st * 1024 + (ob ^ (((ob >> 9) & 1) << 5)); }
__host__ __device__ __forceinline__ void stage_rc(int b, int& R, int& C) { const int st = b / 1024, sb = b % 1024, swz = sb ^ (((sb >> 9) & 1) << 5); R = (st >> 1) * 16 + swz / 64; C = (st & 1) * 32 + (swz % 64) / 2; }
__host__ __device__ __forceinline__ int perm32(int rho) { const int n = rho >> 4, i = rho & 15; return 8 * (i >> 2) + 4 * n + (i & 3); }
struct Unit { int pm, pn; };
struct Gemm { const bf16_t* A; const bf16_t* Bt; int M, N, K; };
struct StaticOrder {
    int nM, nN, nwg, G, c;
    __host__ __device__ void init(int M, int N, int G_, int c_) { nM = M / BM; nN = N / BM; nwg = nM * nN; G = G_; c = c_; }
    __host__ __device__ bool next(int i, Unit& u) const {
        const long L = (long)i * G + c; if (L >= nwg) return false;
        int wgid = (int)L; { const int q = nwg / NXCD, r = nwg % NXCD, xcd = wgid % NXCD, off = wgid / NXCD; wgid = (xcd < r ? xcd * (q + 1) : r * (q + 1) + (xcd - r) * q) + off; }
        const int nig = WGM * nN, gid = wgid / nig, fm = gid * WGM, gsz = (nM - fm) < WGM ? (nM - fm) : WGM;
        u.pm = fm + ((wgid % nig) % gsz); u.pn = (wgid % nig) / gsz; return true;
    }
    __device__ __forceinline__ unsigned arow(const Unit&, int) const { return 0u; }
};

template <class Epi, class Sched, bool ALIGN_EPI, bool GATHER>
__device__ __forceinline__ void gemm_phase(LAS unsigned char* lds, const Gemm g, const Sched& S, const Epi& E) {
    int tid = threadIdx.x; asm volatile("" : "+v"(tid));
    const int wid = __builtin_amdgcn_readfirstlane(tid >> 6), lane = tid & 63, wr = wid >> 2, wc = wid & 3, fr = lane & 15, fq = lane >> 4;
    const int K = g.K, nt = K / BK;
    unsigned voffB[2]; int RA[2], CA[2];
#pragma unroll
    for (int i = 0; i < 2; ++i) { int R, C; stage_rc(tid * 16 + i * 8192, R, C); const int Rb = Epi::PERM ? ((R & ~31) + perm32(R & 31)) : R;
        RA[i] = R; CA[i] = C; voffB[i] = (unsigned)(Rb * K + C) * 2u; }
    const size_t kstep = (size_t)(BK * 2);
    const size_t hstep = (size_t)HALF * K * 2;
    const size_t tstep = 2 * hstep;
    const unsigned ldsw = (unsigned)wid * 1024u;
    const int aoff = lds_byte(wr * 64 + fr, fq * 8), boff = lds_byte(wc * 32 + fr, fq * 8);
#define PG8_SA(b, h) (((b) * 2 + (h)) * HTB)
#define PG8_SB(b, h) ((4 + (b) * 2 + (h)) * HTB)
#define PG8_STAGE(bufoff, gbase, voff) do { _Pragma("unroll") for (int _i = 0; _i < 2; ++_i) \
        __builtin_amdgcn_global_load_lds((const unsigned*)((const char*)(gbase) + (voff)[_i]), (LAS unsigned*)(lds + (bufoff) + ldsw + _i * 8192), 16, 0, 0); } while (0)
#define PG8_STA(bufoff, gbase, v0, v1) do { \
        __builtin_amdgcn_global_load_lds((const unsigned*)((const char*)(gbase) + (v0)), (LAS unsigned*)(lds + (bufoff) + ldsw), 16, 0, 0); \
        __builtin_amdgcn_global_load_lds((const unsigned*)((const char*)(gbase) + (v1)), (LAS unsigned*)(lds + (bufoff) + ldsw + 8192), 16, 0, 0); } while (0)
#define PG8_LDA(dst, b, h) do { _Pragma("unroll") for (int m = 0; m < 4; ++m) _Pragma("unroll") for (int k = 0; k < 2; ++k) dst[m][k] = *(const LAS bf16x8*)(lds + PG8_SA(b, h) + aoff + m * 2048 + k * 1024); } while (0)
#define PG8_LDB(dst, b, h) do { _Pragma("unroll") for (int n = 0; n < 2; ++n) _Pragma("unroll") for (int k = 0; k < 2; ++k) dst[n][k] = *(const LAS bf16x8*)(lds + PG8_SB(b, h) + boff + n * 2048 + k * 1024); } while (0)
#define PG8_MMA(ai, bj, At, Bt) do { __builtin_amdgcn_s_setprio(1); _Pragma("unroll") for (int m = 0; m < 4; ++m) _Pragma("unroll") for (int n = 0; n < 2; ++n) _Pragma("unroll") for (int k = 0; k < 2; ++k) \
        acc[ai][bj][m][n] = __builtin_amdgcn_mfma_f32_16x16x32_bf16(Bt[n][k], At[m][k], acc[ai][bj][m][n], 0, 0, 0); __builtin_amdgcn_s_setprio(0); } while (0)
#define PG8_WAIT_V(n) asm volatile("s_waitcnt vmcnt(" #n ")" ::: "memory")
#define PG8_WAIT_L(n) asm volatile("s_waitcnt lgkmcnt(" #n ")" ::: "memory")
#define PG8_BAR __builtin_amdgcn_s_barrier()
#define PG8_SCHED __builtin_amdgcn_sched_barrier(0)
    Unit cur, nxt; int ui = 0;
    if (!S.next(0, cur)) return;
    f32x4 acc[2][2][4][2];
#pragma unroll
    for (int a = 0; a < 2; ++a)
#pragma unroll
        for (int b = 0; b < 2; ++b)
#pragma unroll
            for (int m = 0; m < 4; ++m)
#pragma unroll
                for (int n = 0; n < 2; ++n) acc[a][b][m][n] = (f32x4){0.f, 0.f, 0.f, 0.f};
    bf16x8 At[4][2], B0[2][2], B1[2][2];
    unsigned vA00, vA01, vA10, vA11, vN00, vN01, vN10, vN11;
#define PG8_AOFF(u, h, i) (GATHER ? (unsigned)(((size_t)S.arow(u, (h) * HALF + RA[i]) * (size_t)K + CA[i]) * 2u) : (unsigned)((h) * hstep + ((size_t)RA[i] * K + CA[i]) * 2u))
    vA00 = PG8_AOFF(cur, 0, 0); vA01 = PG8_AOFF(cur, 0, 1); vA10 = PG8_AOFF(cur, 1, 0); vA11 = PG8_AOFF(cur, 1, 1);
    vN00 = vA00; vN01 = vA01; vN10 = vA10; vN11 = vA11;
    const char* cA = (const char*)g.A + (GATHER ? (size_t)0 : (size_t)cur.pm * tstep); const char* cB = (const char*)g.Bt + (size_t)cur.pn * tstep;
    PG8_STAGE(PG8_SB(0, 0), cB, voffB); PG8_STAGE(PG8_SB(0, 1), cB + hstep, voffB); PG8_STA(PG8_SA(0, 0), cA, vA00, vA01); PG8_STA(PG8_SA(0, 1), cA, vA10, vA11);
    if (wr == 1) PG8_BAR;
    PG8_WAIT_V(2); PG8_BAR;
    PG8_STAGE(PG8_SB(1, 0), cB + kstep, voffB); PG8_STA(PG8_SA(1, 0), cA + kstep, vA00, vA01); PG8_STAGE(PG8_SB(1, 1), cB + hstep + kstep, voffB);
    PG8_WAIT_V(6); PG8_BAR;
#pragma unroll 1
    for (;;) {
        const bool has_next = S.next(ui + 1, nxt);
        const char* nA = has_next ? (const char*)g.A + (GATHER ? (size_t)0 : (size_t)nxt.pm * tstep) : cA; const char* nB = has_next ? (const char*)g.Bt + (size_t)nxt.pn * tstep : cB;
        if constexpr (GATHER) { if (has_next) { vN00 = PG8_AOFF(nxt, 0, 0); vN01 = PG8_AOFF(nxt, 0, 1); vN10 = PG8_AOFF(nxt, 1, 0); vN11 = PG8_AOFF(nxt, 1, 1); } else { vN00 = vA00; vN01 = vA01; vN10 = vA10; vN11 = vA11; } }
#pragma unroll 1
        for (int t = 0; t < nt; t += 2) {
            const bool last = (t == nt - 2);
            const char* a1 = cA + (size_t)(t + 1) * kstep;
            const char* a2 = last ? nA : cA + (size_t)(t + 2) * kstep; const char* b2 = last ? nB : cB + (size_t)(t + 2) * kstep;
            const char* a3 = a2 + kstep; const char* b3 = b2 + kstep;
            unsigned w00 = vA00, w01 = vA01, w10 = vA10, w11 = vA11;
            if constexpr (GATHER) { if (last) { w00 = vN00; w01 = vN01; w10 = vN10; w11 = vN11; } }
            PG8_LDB(B0, 0, 0); PG8_LDB(B1, 0, 1); PG8_SCHED; PG8_LDA(At, 0, 0); PG8_STA(PG8_SA(1, 1), a1, vA10, vA11);
            PG8_WAIT_V(8); PG8_WAIT_L(0); PG8_BAR; PG8_MMA(0, 0, At, B0); PG8_MMA(0, 1, At, B1); PG8_BAR; PG8_SCHED;
            PG8_LDA(At, 0, 1); PG8_STAGE(PG8_SB(0, 0), b2, voffB); PG8_STAGE(PG8_SB(0, 1), b2 + hstep, voffB); PG8_STA(PG8_SA(0, 0), a2, w00, w01);
            PG8_WAIT_V(8); PG8_WAIT_L(0); PG8_BAR; PG8_MMA(1, 0, At, B0); PG8_MMA(1, 1, At, B1); PG8_BAR; PG8_SCHED;
            PG8_LDB(B0, 1, 0); PG8_LDB(B1, 1, 1); PG8_SCHED; PG8_LDA(At, 1, 0); PG8_STA(PG8_SA(0, 1), a2, w10, w11);
            PG8_WAIT_V(8); PG8_WAIT_L(0); PG8_BAR; PG8_MMA(0, 0, At, B0); PG8_MMA(0, 1, At, B1); PG8_BAR; PG8_SCHED;
            PG8_LDA(At, 1, 1); PG8_STAGE(PG8_SB(1, 0), b3, voffB); PG8_STAGE(PG8_SB(1, 1), b3 + hstep, voffB); PG8_STA(PG8_SA(1, 0), a3, w00, w01);
            PG8_WAIT_V(8); PG8_WAIT_L(0); PG8_BAR; PG8_MMA(1, 0, At, B0); PG8_MMA(1, 1, At, B1); PG8_BAR; PG8_SCHED;
        }
        if constexpr (ALIGN_EPI) { if (wr == 0) PG8_BAR; }
        E(acc, cur, wr, wc, fr, fq);
        if (!has_next) break;
#pragma unroll
        for (int a = 0; a < 2; ++a)
#pragma unroll
            for (int b = 0; b < 2; ++b)
#pragma unroll
                for (int m = 0; m < 4; ++m)
#pragma unroll
                    for (int n = 0; n < 2; ++n) acc[a][b][m][n] = (f32x4){0.f, 0.f, 0.f, 0.f};
        cur = nxt; cA = nA; cB = nB; ++ui;
        vA00 = vN00; vA01 = vN01; vA10 = vN10; vA11 = vN11;
        if constexpr (ALIGN_EPI) { if (wr == 1) PG8_BAR; }
    }
    PG8_WAIT_V(0);
    if constexpr (!ALIGN_EPI) { if (wr == 0) PG8_BAR; }
    PG8_BAR;
#undef PG8_AOFF
#undef PG8_SA
#undef PG8_SB
#undef PG8_STAGE
#undef PG8_STA
#undef PG8_LDA
#undef PG8_LDB
#undef PG8_MMA
#undef PG8_WAIT_V
#undef PG8_WAIT_L
#undef PG8_BAR
#undef PG8_SCHED
}
}

struct Params { const void* p[30]; };
__device__ __forceinline__ const void* parg(const Params& P, int i) { asm volatile("" : "+s"(i)); return P.p[i]; }
#define PIN(i) ((const float*)parg(P, (i)))
#define POUT() ((float*)parg(P, 28))
#define PWS() ((unsigned char*)parg(P, 29))
struct Frame {
    LAS unsigned char* lds;
    int tid, lane, wave, vcu, G;
};

__device__ __forceinline__ void tr_item(const float* W, int ld, int k0, const float* gain, float scale, bf16_t* dst, int K, LAS float* scr, int lane) {
#pragma unroll 8
    for (int i = 0; i < 32; ++i) { const int kk = 2 * i + (lane >> 5); float v = W[(size_t)(k0 + kk) * ld + (lane & 31)]; if (gain) v *= gain[k0 + kk]; scr[kk * 33 + (lane & 31)] = v * scale; }
    asm volatile("s_waitcnt lgkmcnt(0)" ::: "memory");
    const int c = lane & 7;
#pragma unroll
    for (int j = 0; j < 4; ++j) { const int n = (lane >> 3) + 8 * j; const LAS float* s = scr + (8 * c) * 33 + n;
        v4u o; o.x = cvt_pk_bf16(s[0 * 33], s[1 * 33]); o.y = cvt_pk_bf16(s[2 * 33], s[3 * 33]); o.z = cvt_pk_bf16(s[4 * 33], s[5 * 33]); o.w = cvt_pk_bf16(s[6 * 33], s[7 * 33]);
        *(v4u*)(dst + (size_t)n * K + k0 + 8 * c) = o; }
    asm volatile("s_waitcnt lgkmcnt(0)" ::: "memory");
}

__device__ __forceinline__ void p0_prologue(const Frame& F, const Params& P) {
    unsigned char* ws = PWS();
    const float* x = PIN(0); const float* p = PIN(1); const int* pos = (const int*)PIN(2);
    const float* attn_norm = PIN(3); const float* w_in = PIN(4); const float* w_a2 = PIN(5);
    const float* w_ba = PIN(13); const float* w_bb = PIN(14); const float* w_out = PIN(15); const float* ffn_norm = PIN(16);
    const float* w_rg = PIN(17); const float* w_re = PIN(19);
    const float* w_gate = PIN(21); const float* w_up = PIN(22); const float* w_down = PIN(23); const float* w_ple = PIN(24); const float* w_pg = PIN(26);
    bf16_t* Wp = (bf16_t*)(ws + WS_WP); bf16_t* Wgu = (bf16_t*)(ws + WS_WGU); bf16_t* Wd = (bf16_t*)(ws + WS_WD); bf16_t* Wab = (bf16_t*)(ws + WS_WAB);
    bf16_t* Wo = (bf16_t*)(ws + WS_WO); bf16_t* Wpg = (bf16_t*)(ws + WS_WPG); bf16_t* Wple = (bf16_t*)(ws + WS_WPLE); bf16_t* Wr = (bf16_t*)(ws + WS_WR);
    LAS float* scr = (LAS float*)(F.lds + F.wave * 16384);
    const int gw = F.vcu * 8 + F.wave, NGW = F.G * 8, lane = F.lane;
    constexpr int I0 = 16 * 48, I1 = 16 * 112, I2 = 8 * 32, I3 = 8 * 32, I4 = 16 * 32, I5 = 16 * 32, I6 = 4 * 32, I7 = 32 * 16 * 8, I8 = I7, I9 = 32 * 4 * 32;
    constexpr int NITEMS = I0 + I1 + I2 + I3 + I4 + I5 + I6 + I7 + I8 + I9;
    for (int it = gw; it < NITEMS; it += NGW) {
        int r = it;
        if (r < I0) { const int kb = r / 48, nb = r % 48; tr_item(w_in + nb * 32, DIN, kb * 64, attn_norm, nb < 8 ? 0.125f : 1.f, Wp + (size_t)(nb * 32) * DM, DM, scr, lane); continue; } r -= I0;
        if (r < I1) { const int kb = r / 112, nb = r % 112; tr_item(w_in + C_DQ + nb * 32, DIN, kb * 64, attn_norm, nb < 16 ? QSCALE2 : 1.f, Wp + (size_t)(P_DQ + nb * 32) * DM, DM, scr, lane); continue; } r -= I1;
        if (r < I2) { const int kb = r / 32, nb = r % 32; tr_item(w_ba + nb * 32, DM, kb * 64, nullptr, 1.f, Wab + (size_t)(nb * 32) * 512, 512, scr, lane); continue; } r -= I2;
        if (r < I3) { const int kb = r / 32, nb = r % 32; tr_item(w_bb + nb * 32, DM, kb * 64, nullptr, 1.f, Wab + (size_t)(1024 + nb * 32) * 512, 512, scr, lane); continue; } r -= I3;
        if (r < I4) { const int kb = r / 32, nb = r % 32; tr_item(w_out + nb * 32, DM, kb * 64, nullptr, 1.f, Wo + (size_t)(nb * 32) * DM, DM, scr, lane); continue; } r -= I4;
        if (r < I5) { const int kb = r / 32, nb = r % 32; tr_item(w_pg + nb * 32, DM, kb * 64, nullptr, 1.f, Wpg + (size_t)(nb * 32) * DM, DM, scr, lane); continue; } r -= I5;
        if (r < I6) { const int kb = r / 32, nb = r % 32; tr_item(w_ple + nb * 32, DM, kb * 64, nullptr, 1.f, Wple + (size_t)(nb * 32) * PLE, PLE, scr, lane); continue; } r -= I6;
        if (r < I7 + I8) { const int up = r >= I7; if (up) r -= I7; const int e = r / 128, q = r % 128, kb = q / 8, nb = q % 8;
            const float* src = (up ? w_up : w_gate) + (size_t)e * DM * DEXP + nb * 32;
            tr_item(src, DEXP, kb * 64, ffn_norm, 1.f, Wgu + (size_t)(e * 512 + (nb >> 2) * 256 + up * 128 + (nb & 3) * 32) * DM, DM, scr, lane); continue; } r -= I7 + I8;
        { const int e = r / 128, q = r % 128, kb = q / 32, nb = q % 32;
          tr_item(w_down + (size_t)e * DEXP * DM + nb * 32, DM, kb * 64, nullptr, 1.f, Wd + (size_t)(e * 1024 + nb * 32) * DEXP, DEXP, scr, lane); }
    }
    for (int it = gw; it < 16 * 8; it += NGW) { const int kb = it / 8, jb = it % 8, k = kb * 64 + lane;
        float wv[16];
#pragma unroll
        for (int r = 0; r < 16; ++r) wv[r] = w_in[(size_t)k * DIN + C_AL + r];
        const float g = attn_norm[k];
        for (int jj = 0; jj < 32; ++jj) { const int j = jb * 32 + jj; float s = 0.f;
#pragma unroll
            for (int r = 0; r < 16; ++r) s += wv[r] * w_a2[r * 256 + j];
            Wp[(size_t)(P_AL + j) * DM + k] = (bf16_t)(cvt_pk_bf16(s * g, 0.f) & 0xffffu); } }
    const int gt = F.vcu * NTHREADS + F.tid, NGT = F.G * NTHREADS;
    for (int i = gt; i < 48 * DM; i += NGT) { const int n = i >> 10, k = i & 1023; float v = 0.f;
        if (n < 4) v = w_rg[k * 4 + n] * ffn_norm[k]; else if (n < 36) v = w_re[k * 32 + (n - 4)] * ffn_norm[k];
        Wr[i] = (bf16_t)(cvt_pk_bf16(v, 0.f) & 0xffffu); }
    { bf16_t* xb = (bf16_t*)(ws + WS_XB); float* rstd1 = (float*)(ws + WS_RSTD1);
      for (int m = gw; m < T; m += NGW) { const GAS f32x4* xr = (const GAS f32x4*)(x + (size_t)m * DM) + lane; f32x4 v[4]; float s = 0.f;
#pragma unroll
          for (int j = 0; j < 4; ++j) { v[j] = xr[64 * j]; s += (v[j].x * v[j].x + v[j].y * v[j].y) + (v[j].z * v[j].z + v[j].w * v[j].w); }
          s = wave_sum(s);
          GAS v2u* o8 = (GAS v2u*)(xb + (size_t)m * DM) + lane;
#pragma unroll
          for (int j = 0; j < 4; ++j) { v2u o; o.x = cvt_pk_bf16(v[j].x, v[j].y); o.y = cvt_pk_bf16(v[j].z, v[j].w); o8[64 * j] = o; }
          if (lane == 0) rstd1[m] = 1.0f / sqrtf(s * (1.f / DM) + EPS); } }
    { bf16_t* pb = (bf16_t*)(ws + WS_PB);
      for (int i = gt; i < T * PLE / 8; i += NGT) { const f32x4 a = *(const f32x4*)(p + (size_t)i * 8), b = *(const f32x4*)(p + (size_t)i * 8 + 4);
          v4u o; o.x = cvt_pk_bf16(a.x, a.y); o.y = cvt_pk_bf16(a.z, a.w); o.z = cvt_pk_bf16(b.x, b.y); o.w = cvt_pk_bf16(b.z, b.w); *(v4u*)(pb + (size_t)i * 8) = o; } }
    { float* ct = (float*)(ws + WS_COS); float* st = (float*)(ws + WS_SIN);
      for (int i = gt; i < T * 8; i += NGT) { const int t = i >> 3, j = i & 7; const double ang = (double)pos[t] * exp2(-(double)j * (18.931568569324174 / 8.0));
          ct[i] = (float)cos(ang); st[i] = (float)sin(ang); } }
}

namespace pg8 {
struct EpiProj {
    static constexpr bool PERM = true;
    unsigned char* ws; bf16_t* gates; const float* rstd; const float* b_a; const float* cost; const float* sint;
    __device__ __forceinline__ void operator()(const f32x4 (&acc)[2][2][4][2], const Unit& u, int wr, int wc, int fr, int fq) const {
        const int pn = u.pn, row0 = u.pm * BM + wr * 64 + fr, cl0 = wc * 32 + 8 * fq;
        int mode = 0, pitch = 512, cb = 0; unsigned char* dst = nullptr;
        if (pn == 0) { dst = ws + WS_GQ; pitch = 256; }
        else if (pn == 1) { dst = ws + WS_GK; pitch = 256; }
        else if (pn < 4) { dst = ws + WS_GV; cb = (pn - 2) * 256; }
        else if (pn < 6) { dst = ws + WS_SR; cb = (pn - 4) * 256; mode = 1; }
        else if (pn == 6) { dst = ws + WS_LA; pitch = 256; mode = 2; }
        else if (pn < 9) { dst = ws + WS_DQ; cb = (pn - 7) * 256; mode = 3; }
        else if (pn < 11) { dst = ws + WS_DK; cb = (pn - 9) * 256; mode = 3; }
        else if (pn < 13) { dst = ws + WS_DV; cb = (pn - 11) * 256; }
        else { dst = (unsigned char*)gates; pitch = 2048; cb = (pn - 13) * 256; mode = 4; }
#pragma unroll
        for (int ai = 0; ai < 2; ++ai)
#pragma unroll
            for (int m = 0; m < 4; ++m) {
                const int row = row0 + ai * HALF + m * 16; const float rs = rstd[row];
                f32x4 cs0, cs1, sn0, sn1;
                if (mode == 3) { cs0 = *(const f32x4*)(cost + (size_t)row * 8); cs1 = *(const f32x4*)(cost + (size_t)row * 8 + 4); sn0 = *(const f32x4*)(sint + (size_t)row * 8); sn1 = *(const f32x4*)(sint + (size_t)row * 8 + 4); }
#pragma unroll
                for (int bj = 0; bj < 2; ++bj) {
                    f32x4 v0 = acc[ai][bj][m][0] * rs, v1 = acc[ai][bj][m][1] * rs;
                    const int col = cb + bj * HALF + cl0;
                    if (mode == 2) {
                        const f32x4 b0 = *(const f32x4*)(b_a + col), b1 = *(const f32x4*)(b_a + col + 4);
                        v0 = v0 + b0; v1 = v1 + b1;
#pragma unroll
                        for (int i = 0; i < 4; ++i) { float xx = v0[i]; v0[i] = (fminf(xx, 0.f) - __builtin_amdgcn_logf(1.f + __builtin_amdgcn_exp2f(-fabsf(xx) * LOG2E)) * 0.6931471805599453f) * 0.0625f;
                                                      xx = v1[i]; v1[i] = (fminf(xx, 0.f) - __builtin_amdgcn_logf(1.f + __builtin_amdgcn_exp2f(-fabsf(xx) * LOG2E)) * 0.6931471805599453f) * 0.0625f; }
                        float* o = (float*)dst + (size_t)row * pitch + col; *(f32x4*)o = v0; *(f32x4*)(o + 4) = v1;
                        continue;
                    }
                    if (mode == 1) {
#pragma unroll
                        for (int i = 0; i < 4; ++i) { v0[i] = v0[i] * sigmoidf_(v0[i]); v1[i] = v1[i] * sigmoidf_(v1[i]); }
                    } else if (mode == 4) {
#pragma unroll
                        for (int i = 0; i < 4; ++i) { v0[i] = sigmoidf_(v0[i]); v1[i] = sigmoidf_(v1[i]); }
                    } else if (mode == 3) {
                        if ((wc & 1) == 0) {
                            f32x4 p0, p1;
#pragma unroll
                            for (int i = 0; i < 4; ++i) { p0[i] = __shfl_xor(v0[i], 16); p1[i] = __shfl_xor(v1[i], 16); }
                            if (fq == 0) { v0 = v0 * cs0 - p0 * sn0; v1 = v1 * cs1 - p1 * sn1; }
                            else if (fq == 1) { v0 = v0 * cs0 + p0 * sn0; v1 = v1 * cs1 + p1 * sn1; }
                        }
                    }
                    v4u w; w.x = cvt_pk_bf16(v0[0], v0[1]); w.y = cvt_pk_bf16(v0[2], v0[3]); w.z = cvt_pk_bf16(v1[0], v1[1]); w.w = cvt_pk_bf16(v1[2], v1[3]);
                    *(v4u*)((bf16_t*)dst + (size_t)row * pitch + col) = w;
                }
            }
    }
};
struct EpiPle {
    static constexpr bool PERM = true;
    bf16_t* er; float* sse;
    __device__ __forceinline__ void operator()(const f32x4 (&acc)[2][2][4][2], const Unit& u, int wr, int wc, int fr, int fq) const {
        const int row0 = u.pm * BM + wr * 64 + fr, col0 = u.pn * BM + wc * 32 + 8 * fq;
#pragma unroll
        for (int ai = 0; ai < 2; ++ai)
#pragma unroll
            for (int m = 0; m < 4; ++m) { const int row = row0 + ai * HALF + m * 16; float s = 0.f;
#pragma unroll
                for (int bj = 0; bj < 2; ++bj) { const f32x4 v0 = acc[ai][bj][m][0], v1 = acc[ai][bj][m][1];
                    s += (v0[0] * v0[0] + v0[1] * v0[1]) + (v0[2] * v0[2] + v0[3] * v0[3]) + (v1[0] * v1[0] + v1[1] * v1[1]) + (v1[2] * v1[2] + v1[3] * v1[3]);
                    v4u w; w.x = cvt_pk_bf16(v0[0], v0[1]); w.y = cvt_pk_bf16(v0[2], v0[3]); w.z = cvt_pk_bf16(v1[0], v1[1]); w.w = cvt_pk_bf16(v1[2], v1[3]);
                    *(v4u*)(er + (size_t)row * DM + col0 + bj * HALF) = w; }
                s += __shfl_xor(s, 16); s += __shfl_xor(s, 32);
                if (fq == 0) atomicAdd(sse + row, s); }
    }
};
}

namespace da {
constexpr int NW = 8, QBLK = 32, KVBLK = 64, QB = 128, PITCH = 512;
constexpr int SHM_V = KVBLK * 128 * 2, SHM_K = KVBLK * 128 * 2;
constexpr int OFF_WS = 2 * SHM_V + 2 * SHM_K, OFF_EX = OFF_WS + NW * 64 * 4, LDS_NEED = OFF_EX + 4 * 32 * 128 * 4;
constexpr float THRL = 11.5f;
#define KSWZ(row, colB) ((row) * 256 + ((colB) ^ (((row) & 7) << 4)))
#define SBAR() __builtin_amdgcn_sched_barrier(0)
__device__ __forceinline__ int v_st(int k, int c) { const int kk = (k & ~0xC) | ((k & 4) << 1) | ((k & 8) >> 1); return ((kk >> 3) * 4 + (c >> 5)) * 512 + ((kk & 7) * 32 + (c & 31)) * 2; }
__device__ __forceinline__ int v_rd_base(int lane) { return ((lane & 3) << 3) | (((lane >> 2) & 3) << 6) | (((lane >> 4) & 1) << 5) | (((lane >> 5) & 1) << 8); }
constexpr int v_rd_off(int d0, int ks, int half) { return d0 * 512 + ks * 4096 + half * 2048; }
__device__ __forceinline__ int crow(int r, int hi) { return (r & 3) + 8 * (r >> 2) + 4 * hi; }
__device__ __forceinline__ void mask_tile(f32x16& p0, f32x16& p1, int dq) {
    const float NEG = -__builtin_inff();
#pragma unroll
    for (int r = 0; r < 16; ++r) { const int c = (r & 3) + 8 * (r >> 2); if (dq - c < 0) p0[r] = NEG; if (dq - c - 32 < 0) p1[r] = NEG; }
}
__device__ __forceinline__ void partialSM(f32x16& p0, f32x16& p1, float& m_reg, float& mn, float& alpha) {
    float pmax = p0[0];
#pragma unroll
    for (int r = 1; r < 16; ++r) pmax = fmaxf(pmax, p0[r]);
#pragma unroll
    for (int r = 0; r < 16; ++r) pmax = fmaxf(pmax, p1[r]);
    { auto rr = __builtin_amdgcn_permlane32_swap(__float_as_uint(pmax), __float_as_uint(pmax), false, false); pmax = fmaxf(__uint_as_float(rr[0]), __uint_as_float(rr[1])); }
    if (__builtin_expect(__all((pmax - m_reg) <= THRL), 1)) { mn = m_reg; alpha = 1.f; }
    else { mn = fmaxf(m_reg, pmax); alpha = __builtin_amdgcn_exp2f(m_reg - mn); m_reg = mn; }
#pragma unroll
    for (int r = 0; r < 16; ++r) { p0[r] = p0[r] - mn; p1[r] = p1[r] - mn; }
#pragma unroll
    for (int r = 0; r < 16; ++r) p0[r] = __builtin_amdgcn_exp2f(p0[r]);
}
__device__ __forceinline__ void finishSM(f32x16& p0, f32x16& p1, float alpha, float& l_reg, bf16x8& pa0, bf16x8& pa1, bf16x8& pa2, bf16x8& pa3) {
#pragma unroll
    for (int r = 0; r < 16; ++r) p1[r] = __builtin_amdgcn_exp2f(p1[r]);
    float ps = 0;
#pragma unroll
    for (int r = 0; r < 16; ++r) ps += p0[r];
#pragma unroll
    for (int r = 0; r < 16; ++r) ps += p1[r];
    { auto rr = __builtin_amdgcn_permlane32_swap(__float_as_uint(ps), __float_as_uint(ps), false, false); ps = __uint_as_float(rr[0]) + __uint_as_float(rr[1]); }
    l_reg = l_reg * alpha + ps;
#define PK4(P, B_, OUT) do { unsigned a0 = cvt_pk_bf16(P[B_+0], P[B_+1]), a1 = cvt_pk_bf16(P[B_+2], P[B_+3]); unsigned b0 = cvt_pk_bf16(P[B_+4], P[B_+5]), b1 = cvt_pk_bf16(P[B_+6], P[B_+7]); \
        auto r0 = __builtin_amdgcn_permlane32_swap(a0, b0, false, false); auto r1 = __builtin_amdgcn_permlane32_swap(a1, b1, false, false); \
        v4u w = {r0[0], r1[0], r0[1], r1[1]}; OUT = *reinterpret_cast<bf16x8*>(&w); } while (0)
    PK4(p0, 0, pa0); PK4(p0, 8, pa1); PK4(p1, 0, pa2); PK4(p1, 8, pa3);
#undef PK4
}
template <int KB>
__device__ __forceinline__ void qkt(f32x16& p0, f32x16& p1, const char* K_lds, int r32, int hi, int comp, const bf16x8* qr) {
    p0 = f32x16{}; p1 = f32x16{};
#pragma unroll
    for (int dd = 0; dd < 4; ++dd) { const char* a = K_lds + KB * SHM_K + KSWZ(r32, (dd * 16 + hi * 8) * 2) + comp * 128;
        bf16x8 b0 = *reinterpret_cast<const bf16x8*>(a);
        bf16x8 b1 = *reinterpret_cast<const bf16x8*>(a + 32 * 256);
        p0 = __builtin_amdgcn_mfma_f32_32x32x16_bf16(b0, qr[dd], p0, 0, 0, 0);
        p1 = __builtin_amdgcn_mfma_f32_32x32x16_bf16(b1, qr[dd], p1, 0, 0, 0); }
}
template <int VB>
__device__ __forceinline__ void pv_tile(f32x16* o, int vb0, bf16x8 pa0, bf16x8 pa1, bf16x8 pa2, bf16x8 pa3) {
#define TRRD(dst, off) asm volatile("ds_read_b64_tr_b16 %0, %1 offset:%2" : "=&v"(dst) : "v"(vb0), "i"(off) : "memory")
#define PV_D0(d0) do { s16x4 l0, l1, l2, l3, h0, h1, h2, h3; constexpr int b_ = VB * SHM_V + v_rd_off(d0, 0, 0); \
        TRRD(l0, b_); TRRD(h0, b_ + 2048); TRRD(l1, b_ + 4096); TRRD(h1, b_ + 6144); TRRD(l2, b_ + 8192); TRRD(h2, b_ + 10240); TRRD(l3, b_ + 12288); TRRD(h3, b_ + 14336); \
        asm volatile("s_waitcnt lgkmcnt(0)" ::: "memory"); SBAR(); \
        o[d0] = __builtin_amdgcn_mfma_f32_32x32x16_bf16(pa0, (bf16x8){l0[0], l0[1], l0[2], l0[3], h0[0], h0[1], h0[2], h0[3]}, o[d0], 0, 0, 0); \
        o[d0] = __builtin_amdgcn_mfma_f32_32x32x16_bf16(pa1, (bf16x8){l1[0], l1[1], l1[2], l1[3], h1[0], h1[1], h1[2], h1[3]}, o[d0], 0, 0, 0); \
        o[d0] = __builtin_amdgcn_mfma_f32_32x32x16_bf16(pa2, (bf16x8){l2[0], l2[1], l2[2], l2[3], h2[0], h2[1], h2[2], h2[3]}, o[d0], 0, 0, 0); \
        o[d0] = __builtin_amdgcn_mfma_f32_32x32x16_bf16(pa3, (bf16x8){l3[0], l3[1], l3[2], l3[3], h3[0], h3[1], h3[2], h3[3]}, o[d0], 0, 0, 0); } while (0)
    PV_D0(0); PV_D0(1); PV_D0(2); PV_D0(3);
#undef PV_D0
#undef TRRD
}
__device__ __forceinline__ void attn_unit(const bf16_t* Qg, const bf16_t* Kg, const bf16_t* Vg, bf16_t* Og, int P0, float lam, const float* subln, char* lds) {
    int tid = threadIdx.x; asm volatile("" : "+v"(tid));
    const int wid = __builtin_amdgcn_readfirstlane(tid >> 6), lane = tid & 63, r32 = lane & 31, hi = lane >> 5;
    const int comp = wid & 1, rg = wid >> 1;
    const int NT = (P0 + QB - 1) / KVBLK + 1;
    const int qlo = P0 + rg * QBLK, qm = qlo + r32 - 4 * hi;
    char* V_lds = lds; char* K_lds = lds + 2 * SHM_V;
    float* wsf = (float*)(lds + OFF_WS) + wid * 64; float* li_l = wsf, * al_l = wsf + 32;
    float* exch = (float*)(lds + OFF_EX) + rg * (32 * 128);
    float m_reg = -1e30f, l_reg = 0; f32x16 o[4] = {};
    const int sr = tid >> 4, sc = (tid & 15) * 8, vst0 = v_st(sr, sc), vst1 = v_st(32 + sr, sc), kws = KSWZ(sr, sc * 2);
    const int vb0 = (int)(uintptr_t)V_lds + v_rd_base(lane);
    bf16x8 st_v0, st_v1, st_k0, st_k1;
#define ROW(p, k0, rr) ((p) + (size_t)((k0) + (rr)) * PITCH + sc)
#define LD8(p) (*reinterpret_cast<const bf16x8*>(p))
#define SLOAD_H(k0) do { st_v0 = LD8(ROW(Vg, k0, sr)); st_v1 = LD8(ROW(Vg, k0, 32 + sr)); st_k0 = LD8(ROW(Kg, k0, sr)); st_k1 = LD8(ROW(Kg, k0, 32 + sr)); } while (0)
#define SWRITE_HK(bf) do { *(bf16x8*)(K_lds + (bf) * SHM_K + kws) = st_k0; *(bf16x8*)(K_lds + (bf) * SHM_K + kws + 32 * 256) = st_k1; } while (0)
#define SWRITE_HV(bf) do { *(bf16x8*)(V_lds + (bf) * SHM_V + vst0) = st_v0; *(bf16x8*)(V_lds + (bf) * SHM_V + vst1) = st_v1; } while (0)
#define VMW() asm volatile("s_waitcnt vmcnt(0)" ::: "memory")
    bf16x8 qr[4];
#pragma unroll
    for (int dd = 0; dd < 4; ++dd) qr[dd] = LD8(Qg + (size_t)(qlo + r32) * PITCH + comp * 64 + dd * 16 + hi * 8);
    SLOAD_H(0); VMW(); SWRITE_HK(0); SWRITE_HV(0); SBAR();
    SLOAD_H(KVBLK);
    __syncthreads();
#define RESC(a) do { if (__any((a) < 1.f)) { if (hi == 0) al_l[r32] = (a); asm volatile("s_waitcnt lgkmcnt(0)" ::: "memory"); \
                     _Pragma("unroll") for (int d_ = 0; d_ < 4; ++d_) _Pragma("unroll") for (int r = 0; r < 16; ++r) o[d_][r] *= al_l[crow(r, hi)]; } } while (0)
#define KBASE(t) ((t) * KVBLK)
#define MASKT(P0_, P1_, t) do { const int kb_ = KBASE(t); if (kb_ + KVBLK - 1 > qlo) mask_tile(P0_, P1_, qm - kb_); } while (0)
    f32x16 pA0, pA1, pB0, pB1; float mnA, mnB, alA, alB; bf16x8 pa0, pa1, pa2, pa3;
    SBAR(); qkt<0>(pA0, pA1, K_lds, r32, hi, comp, qr);
    MASKT(pA0, pA1, 0); partialSM(pA0, pA1, m_reg, mnA, alA);
    VMW(); SWRITE_HK(1); SWRITE_HV(1);
    __syncthreads();
#define HALF_STEP(PX0, PX1, mnX, alX, PY0, PY1, alY, t, KB, VB, SB) do { \
        SBAR(); qkt<KB>(PX0, PX1, K_lds, r32, hi, comp, qr); \
        finishSM(PY0, PY1, alY, l_reg, pa0, pa1, pa2, pa3); SBAR(); \
        if ((t) + 1 < NT) { SLOAD_H(KBASE((t) + 1)); SBAR(); } \
        pv_tile<VB>(o, vb0, pa0, pa1, pa2, pa3); MASKT(PX0, PX1, (t)); partialSM(PX0, PX1, m_reg, mnX, alX); \
        __syncthreads(); \
        if ((t) + 1 < NT) { VMW(); SWRITE_HK(SB); SWRITE_HV(SB); } \
        RESC(alX); __syncthreads(); } while (0)
    for (int t = 1; t + 1 < NT; t += 2) {
        HALF_STEP(pB0, pB1, mnB, alB, pA0, pA1, alA, t, 1, 0, 0);
        HALF_STEP(pA0, pA1, mnA, alA, pB0, pB1, alB, t + 1, 0, 1, 1);
    }
    SBAR(); qkt<1>(pB0, pB1, K_lds, r32, hi, comp, qr); SBAR();
    finishSM(pA0, pA1, alA, l_reg, pa0, pa1, pa2, pa3); SBAR();
    pv_tile<0>(o, vb0, pa0, pa1, pa2, pa3);
    MASKT(pB0, pB1, NT - 1); partialSM(pB0, pB1, m_reg, mnB, alB); __syncthreads(); RESC(alB);
    finishSM(pB0, pB1, alB, l_reg, pa0, pa1, pa2, pa3); SBAR(); pv_tile<1>(o, vb0, pa0, pa1, pa2, pa3);
    if (hi == 0) li_l[r32] = l_reg; asm volatile("s_waitcnt lgkmcnt(0)" ::: "memory");
    float rli[16];
#pragma unroll
    for (int r = 0; r < 16; ++r) rli[r] = __builtin_amdgcn_rcpf(li_l[crow(r, hi)]);
    if (comp == 1) {
#pragma unroll
        for (int r = 0; r < 16; ++r) { const float f = rli[r] * lam;
#pragma unroll
            for (int d0 = 0; d0 < 4; ++d0) exch[crow(r, hi) * 128 + d0 * 32 + r32] = o[d0][r] * f; }
    }
    __syncthreads();
    if (comp == 0) {
        float gsc[4];
#pragma unroll
        for (int d0 = 0; d0 < 4; ++d0) gsc[d0] = subln[d0 * 32 + r32] * (1.f - LAMBDA_INIT);
#pragma unroll
        for (int r = 0; r < 16; ++r) { const int orow = crow(r, hi); float v[4]; float s = 0.f;
#pragma unroll
            for (int d0 = 0; d0 < 4; ++d0) { v[d0] = o[d0][r] * rli[r] - exch[orow * 128 + d0 * 32 + r32]; s += v[d0] * v[d0]; }
            s += __shfl_xor(s, 1); s += __shfl_xor(s, 2); s += __shfl_xor(s, 4); s += __shfl_xor(s, 8); s += __shfl_xor(s, 16);
            const float rs = 1.0f / sqrtf(s * (1.f / 128.f) + EPS);
#pragma unroll
            for (int d0 = 0; d0 < 4; ++d0) { const float w = v[d0] * rs * gsc[d0]; const float wn = __shfl_xor(w, 1);
                if ((r32 & 1) == 0) *(unsigned*)(Og + (size_t)(qlo + orow) * PITCH + d0 * 32 + r32) = cvt_pk_bf16(w, wn); } }
    }
    __syncthreads();
#undef ROW
#undef LD8
#undef SLOAD_H
#undef SWRITE_HK
#undef SWRITE_HV
#undef VMW
#undef RESC
#undef KBASE
#undef MASKT
#undef HALF_STEP
}
#undef KSWZ
#undef SBAR
}

namespace gla {
constexpr int PT = 144;
constexpr int L_QD = 0, L_KI = 9216, L_KIT = 18432, L_VT = 27648, L_SBT = 46080, L_ATT = 64512, L_DEC = 73728, LDS_NEED = 73984;
__device__ __forceinline__ float wave_scan(float x, int lane) {
#pragma unroll
    for (int off = 1; off < 64; off <<= 1) { const float y = __shfl_up(x, off); if (lane >= off) x += y; }
    return x;
}
__device__ __forceinline__ void gla_item(int b, int h, const bf16_t* gq, const bf16_t* gk, const bf16_t* gv, const bf16_t* sr, const float* la, const float* gnorm, bf16_t* oa, LAS unsigned char* lds) {
    int tid = threadIdx.x; asm volatile("" : "+v"(tid));
    const int w = __builtin_amdgcn_readfirstlane(tid >> 6), lane = tid & 63, l15 = lane & 15, lq = lane >> 4;
    const size_t tok0 = (size_t)b * SEQ;
    const bf16_t* qp = gq + (tok0 + lane) * 256 + h * 64 + 8 * w;
    const bf16_t* kp = gk + (tok0 + lane) * 256 + h * 64 + 8 * w;
    const float* lp = la + (tok0 + lane) * 256 + h * 64 + 8 * w;
    const bf16_t* vp = gv + (tok0 + lane) * 512 + h * 128 + 16 * w;
    f32x4 la0 = *(const f32x4*)lp, la1 = *(const f32x4*)(lp + 4);
    v4u q8 = *(const v4u*)qp, k8 = *(const v4u*)kp, v8a = *(const v4u*)vp, v8b = *(const v4u*)(vp + 8);
    f32x4 S[4][2];
#pragma unroll
    for (int i = 0; i < 4; ++i) { S[i][0] = (f32x4){0.f, 0.f, 0.f, 0.f}; S[i][1] = (f32x4){0.f, 0.f, 0.f, 0.f}; }
    const int sw = w - 4;
    for (int n = 0; n < SEQ / 64; ++n) {
        float bb[8] = {la0[0], la0[1], la0[2], la0[3], la1[0], la1[1], la1[2], la1[3]};
        unsigned qd[4], ki[4];
#pragma unroll
        for (int j = 0; j < 8; j += 2) {
            const float b0 = wave_scan(bb[j], lane), b1 = wave_scan(bb[j + 1], lane);
            const float e0 = __builtin_amdgcn_exp2f(b0 * LOG2E), e1 = __builtin_amdgcn_exp2f(b1 * LOG2E);
            const float i0 = __builtin_amdgcn_rcpf(e0), i1 = __builtin_amdgcn_rcpf(e1);
            const unsigned qw = q8[j >> 1], kw = k8[j >> 1];
            qd[j >> 1] = cvt_pk_bf16(bf_lo(qw) * e0, bf_hi(qw) * e1);
            ki[j >> 1] = cvt_pk_bf16(bf_lo(kw) * i0, bf_hi(kw) * i1);
            const float d0 = __shfl(e0, 63), d1 = __shfl(e1, 63);
            if (lane == 0) { *(LAS float*)(lds + L_DEC + (8 * w + j) * 4) = d0; *(LAS float*)(lds + L_DEC + (8 * w + j + 1) * 4) = d1; }
            *(LAS unsigned short*)(lds + L_KIT + (8 * w + j) * PT + lane * 2) = (unsigned short)(ki[j >> 1] & 0xffffu);
            *(LAS unsigned short*)(lds + L_KIT + (8 * w + j + 1) * PT + lane * 2) = (unsigned short)(ki[j >> 1] >> 16);
        }
        *(LAS v4u*)(lds + L_QD + lane * PT + 16 * w) = (v4u){qd[0], qd[1], qd[2], qd[3]};
        *(LAS v4u*)(lds + L_KI + lane * PT + 16 * w) = (v4u){ki[0], ki[1], ki[2], ki[3]};
#pragma unroll
        for (int i = 0; i < 4; ++i) {
            *(LAS unsigned short*)(lds + L_VT + (16 * w + 2 * i) * PT + lane * 2) = (unsigned short)(v8a[i] & 0xffffu);
            *(LAS unsigned short*)(lds + L_VT + (16 * w + 2 * i + 1) * PT + lane * 2) = (unsigned short)(v8a[i] >> 16);
            *(LAS unsigned short*)(lds + L_VT + (16 * w + 8 + 2 * i) * PT + lane * 2) = (unsigned short)(v8b[i] & 0xffffu);
            *(LAS unsigned short*)(lds + L_VT + (16 * w + 8 + 2 * i + 1) * PT + lane * 2) = (unsigned short)(v8b[i] >> 16);
        }
        if (w >= 4) {
#pragma unroll
            for (int db = 0; db < 4; ++db)
#pragma unroll
                for (int vb = 0; vb < 2; ++vb) { v2u o; o.x = cvt_pk_bf16(S[db][vb][0], S[db][vb][1]); o.y = cvt_pk_bf16(S[db][vb][2], S[db][vb][3]);
                    *(LAS v2u*)(lds + L_SBT + (32 * sw + 16 * vb + l15) * PT + (16 * db + 4 * lq) * 2) = o; }
        }
        __syncthreads();
        { const size_t adv = (n + 1 < SEQ / 64) ? (size_t)(n + 1) * 64 : (size_t)n * 64;
          la0 = *(const f32x4*)(lp + adv * 256); la1 = *(const f32x4*)(lp + adv * 256 + 4);
          q8 = *(const v4u*)(qp + adv * 256); k8 = *(const v4u*)(kp + adv * 256); v8a = *(const v4u*)(vp + adv * 512); v8b = *(const v4u*)(vp + adv * 512 + 8); }
        if (w < 4) {
            bf16x8 qf[2];
#pragma unroll
            for (int ks = 0; ks < 2; ++ks) qf[ks] = *(const LAS bf16x8*)(lds + L_QD + (16 * w + l15) * PT + (32 * ks + 8 * lq) * 2);
            const int c = 16 * w + l15;
#pragma unroll
            for (int sb = 0; sb < 4; ++sb) {
                f32x4 a = (f32x4){0.f, 0.f, 0.f, 0.f};
#pragma unroll
                for (int ks = 0; ks < 2; ++ks) { const bf16x8 kf = *(const LAS bf16x8*)(lds + L_KI + (16 * sb + l15) * PT + (32 * ks + 8 * lq) * 2);
                    a = __builtin_amdgcn_mfma_f32_16x16x32_bf16(kf, qf[ks], a, 0, 0, 0); }
#pragma unroll
                for (int r = 0; r < 4; ++r) if (16 * sb + 4 * lq + r > c) a[r] = 0.f;
                v2u o; o.x = cvt_pk_bf16(a[0], a[1]); o.y = cvt_pk_bf16(a[2], a[3]);
                *(LAS v2u*)(lds + L_ATT + w * 2304 + l15 * PT + (16 * sb + 4 * lq) * 2) = o;
            }
            asm volatile("s_waitcnt lgkmcnt(0)" ::: "memory");
            bf16x8 af[2];
#pragma unroll
            for (int ks = 0; ks < 2; ++ks) af[ks] = *(const LAS bf16x8*)(lds + L_ATT + w * 2304 + l15 * PT + (32 * ks + 8 * lq) * 2);
            f32x4 o[8]; float ssq = 0.f;
#pragma unroll
            for (int vb = 0; vb < 8; ++vb) {
                f32x4 a = (f32x4){0.f, 0.f, 0.f, 0.f};
#pragma unroll
                for (int ks = 0; ks < 2; ++ks) { const bf16x8 vf = *(const LAS bf16x8*)(lds + L_VT + (16 * vb + l15) * PT + (32 * ks + 8 * lq) * 2);
                    a = __builtin_amdgcn_mfma_f32_16x16x32_bf16(vf, af[ks], a, 0, 0, 0); }
#pragma unroll
                for (int ks = 0; ks < 2; ++ks) { const bf16x8 sf = *(const LAS bf16x8*)(lds + L_SBT + (16 * vb + l15) * PT + (32 * ks + 8 * lq) * 2);
                    a = __builtin_amdgcn_mfma_f32_16x16x32_bf16(sf, qf[ks], a, 0, 0, 0); }
                o[vb] = a; ssq += (a[0] * a[0] + a[1] * a[1]) + (a[2] * a[2] + a[3] * a[3]);
            }
            ssq += __shfl_xor(ssq, 16); ssq += __shfl_xor(ssq, 32);
            const float rs = 1.0f / sqrtf(ssq * (1.f / 128.f) + EPS);
            const size_t tok = tok0 + (size_t)n * 64 + c;
#pragma unroll
            for (int vb = 0; vb < 8; ++vb) { const int v = 16 * vb + 4 * lq;
                const f32x4 g = *(const f32x4*)(gnorm + v); const v2u r = *(const v2u*)(sr + tok * 512 + h * 128 + v);
                v2u w2; w2.x = cvt_pk_bf16(o[vb][0] * rs * g[0] * bf_lo(r.x), o[vb][1] * rs * g[1] * bf_hi(r.x));
                w2.y = cvt_pk_bf16(o[vb][2] * rs * g[2] * bf_lo(r.y), o[vb][3] * rs * g[3] * bf_hi(r.y));
                *(v2u*)(oa + tok * 512 + h * 128 + v) = w2; }
        } else {
#pragma unroll
            for (int ks = 0; ks < 2; ++ks) {
                bf16x8 vf[2];
#pragma unroll
                for (int vb = 0; vb < 2; ++vb) vf[vb] = *(const LAS bf16x8*)(lds + L_VT + (32 * sw + 16 * vb + l15) * PT + (32 * ks + 8 * lq) * 2);
#pragma unroll
                for (int db = 0; db < 4; ++db) { const bf16x8 kf = *(const LAS bf16x8*)(lds + L_KIT + (16 * db + l15) * PT + (32 * ks + 8 * lq) * 2);
#pragma unroll
                    for (int vb = 0; vb < 2; ++vb) S[db][vb] = __builtin_amdgcn_mfma_f32_16x16x32_bf16(kf, vf[vb], S[db][vb], 0, 0, 0); }
            }
#pragma unroll
            for (int db = 0; db < 4; ++db) { const f32x4 dc = *(const LAS f32x4*)(lds + L_DEC + (16 * db + 4 * lq) * 4); S[db][0] = S[db][0] * dc; S[db][1] = S[db][1] * dc; }
        }
        __syncthreads();
    }
}
}

namespace pg8 {
struct BranchOrder {
    StaticOrder so;
    __device__ __forceinline__ bool next(int i, Unit& u) const { Unit t; if (!so.next(i >> 1, t)) return false; u.pm = t.pm + (i & 1) * 128; u.pn = t.pn + (i & 1) * 4; return true; }
    __device__ __forceinline__ unsigned arow(const Unit&, int) const { return 0u; }
};
struct EpiBranch {
    static constexpr bool PERM = true;
    const bf16_t* gates; bf16_t* mg;
    __device__ __forceinline__ void operator()(const f32x4 (&acc)[2][2][4][2], const Unit& u, int wr, int wc, int fr, int fq) const {
        const bool isb = u.pm >= 128; const int pm = isb ? u.pm - 128 : u.pm, pn = isb ? u.pn - 4 : u.pn;
        const int row0 = pm * BM + wr * 64 + fr, col0 = pn * BM + wc * 32 + 8 * fq;
#pragma unroll
        for (int ai = 0; ai < 2; ++ai)
#pragma unroll
            for (int m = 0; m < 4; ++m) { const int row = row0 + ai * HALF + m * 16;
#pragma unroll
                for (int bj = 0; bj < 2; ++bj) { const int col = col0 + bj * HALF;
                    const v4u g = *(const v4u*)(gates + (size_t)row * 2048 + (isb ? 1024 : 0) + col);
                    const f32x4 a0 = acc[ai][bj][m][0], a1 = acc[ai][bj][m][1];
                    float r0 = a0[0] * bf_lo(g.x), r1 = a0[1] * bf_hi(g.x), r2 = a0[2] * bf_lo(g.y), r3 = a0[3] * bf_hi(g.y);
                    float r4 = a1[0] * bf_lo(g.z), r5 = a1[1] * bf_hi(g.z), r6 = a1[2] * bf_lo(g.w), r7 = a1[3] * bf_hi(g.w);
                    bf16_t* dst = mg + (size_t)row * DM + col;
                    if (isb) { const v4u p = *(const v4u*)dst; r0 += bf_lo(p.x); r1 += bf_hi(p.x); r2 += bf_lo(p.y); r3 += bf_hi(p.y); r4 += bf_lo(p.z); r5 += bf_hi(p.z); r6 += bf_lo(p.w); r7 += bf_hi(p.w); }
                    v4u w; w.x = cvt_pk_bf16(r0, r1); w.y = cvt_pk_bf16(r2, r3); w.z = cvt_pk_bf16(r4, r5); w.w = cvt_pk_bf16(r6, r7);
                    *(v4u*)dst = w; } }
    }
};
struct EpiOut {
    static constexpr bool PERM = true;
    const float* x; bf16_t* hb; float* ss;
    __device__ __forceinline__ void operator()(const f32x4 (&acc)[2][2][4][2], const Unit& u, int wr, int wc, int fr, int fq) const {
        const int row0 = u.pm * BM + wr * 64 + fr, col0 = u.pn * BM + wc * 32 + 8 * fq;
#pragma unroll
        for (int ai = 0; ai < 2; ++ai)
#pragma unroll
            for (int m = 0; m < 4; ++m) { const int row = row0 + ai * HALF + m * 16; float s = 0.f;
#pragma unroll
                for (int bj = 0; bj < 2; ++bj) { const size_t off = (size_t)row * DM + col0 + bj * HALF;
                    const f32x4 v0 = acc[ai][bj][m][0] + *(const f32x4*)(x + off), v1 = acc[ai][bj][m][1] + *(const f32x4*)(x + off + 4);
                    s += (v0[0] * v0[0] + v0[1] * v0[1]) + (v0[2] * v0[2] + v0[3] * v0[3]) + (v1[0] * v1[0] + v1[1] * v1[1]) + (v1[2] * v1[2] + v1[3] * v1[3]);
                    v4u w; w.x = cvt_pk_bf16(v0[0], v0[1]); w.y = cvt_pk_bf16(v0[2], v0[3]); w.z = cvt_pk_bf16(v1[0], v1[1]); w.w = cvt_pk_bf16(v1[2], v1[3]);
                    *(v4u*)(hb + off) = w; }
                s += __shfl_xor(s, 16); s += __shfl_xor(s, 32);
                if (fq == 0) atomicAdd(ss + row, s); }
    }
};
template <int npn> struct MoeOrder {
    const LAS int* ts; const LAS int* cnt; const int* list; int G, c;
    __device__ __forceinline__ int expert_of(int tile) const { int e = 0;
#pragma unroll 1
        for (int i = 1; i < NEXP; ++i) if (ts[i] <= tile) e = i; return e; }
    __device__ __forceinline__ bool next(int i, Unit& u) const {
        const int L = i * G + c, total = ts[NEXP] * npn; if (L >= total) return false;
        const int tile = L / npn, pl = L % npn; u.pm = tile; u.pn = expert_of(tile) * npn + pl; return true; }
    __device__ __forceinline__ int entry(const Unit& u, int r) const { const int e = u.pn / npn, pos = (u.pm - ts[e]) * BM + r; return pos < cnt[e] ? list[(size_t)e * T + pos] : -1; }
    __device__ __forceinline__ unsigned arow(const Unit& u, int r) const { const int en = entry(u, r); return en < 0 ? 0u : (unsigned)(en >> 1); }
};
struct EpiUp {
    static constexpr bool PERM = true;
    MoeOrder<2> mo; const float* ss2; bf16_t* he;
    __device__ __forceinline__ void operator()(const f32x4 (&acc)[2][2][4][2], const Unit& u, int wr, int wc, int fr, int fq) const {
        const int pl = u.pn & 1, col0 = pl * 128 + wc * 32 + 8 * fq;
#pragma unroll
        for (int ai = 0; ai < 2; ++ai)
#pragma unroll
            for (int m = 0; m < 4; ++m) { const int r = ai * HALF + wr * 64 + m * 16 + fr; const int en = mo.entry(u, r);
                const float rs = en < 0 ? 0.f : 1.0f / sqrtf(ss2[en >> 1] * (1.f / DM) + EPS);
                const f32x4 g0 = acc[ai][0][m][0] * rs, g1 = acc[ai][0][m][1] * rs, u0 = acc[ai][1][m][0] * rs, u1 = acc[ai][1][m][1] * rs;
                v4u w; w.x = cvt_pk_bf16(g0[0] * sigmoidf_(g0[0]) * u0[0], g0[1] * sigmoidf_(g0[1]) * u0[1]); w.y = cvt_pk_bf16(g0[2] * sigmoidf_(g0[2]) * u0[2], g0[3] * sigmoidf_(g0[3]) * u0[3]);
                w.z = cvt_pk_bf16(g1[0] * sigmoidf_(g1[0]) * u1[0], g1[1] * sigmoidf_(g1[1]) * u1[1]); w.w = cvt_pk_bf16(g1[2] * sigmoidf_(g1[2]) * u1[2], g1[3] * sigmoidf_(g1[3]) * u1[3]);
                *(v4u*)(he + (size_t)(u.pm * BM + r) * DEXP + col0) = w; }
    }
};
struct EpiDown {
    static constexpr bool PERM = true;
    MoeOrder<4> mo; const float* tokw; bf16_t* yb;
    __device__ __forceinline__ void operator()(const f32x4 (&acc)[2][2][4][2], const Unit& u, int wr, int wc, int fr, int fq) const {
        const int col0 = (u.pn & 3) * BM + wc * 32 + 8 * fq;
#pragma unroll
        for (int ai = 0; ai < 2; ++ai)
#pragma unroll
            for (int m = 0; m < 4; ++m) { const int r = ai * HALF + wr * 64 + m * 16 + fr; const int en = mo.entry(u, r);
                if (en >= 0) { const float wt = tokw[en];
#pragma unroll
                    for (int bj = 0; bj < 2; ++bj) { const f32x4 v0 = acc[ai][bj][m][0] * wt, v1 = acc[ai][bj][m][1] * wt;
                        v4u w; w.x = cvt_pk_bf16(v0[0], v0[1]); w.y = cvt_pk_bf16(v0[2], v0[3]); w.z = cvt_pk_bf16(v1[0], v1[1]); w.w = cvt_pk_bf16(v1[2], v1[3]);
                        *(v4u*)(yb + (size_t)en * DM + col0 + bj * HALF) = w; } } }
    }
};
struct EpiFinal {
    static constexpr bool PERM = true;
    const bf16_t* h2b; const bf16_t* er; const float* sse; const float* gple; float* out; float* ssf;
    __device__ __forceinline__ void operator()(const f32x4 (&acc)[2][2][4][2], const Unit& u, int wr, int wc, int fr, int fq) const {
        const int row0 = u.pm * BM + wr * 64 + fr, col0 = u.pn * BM + wc * 32 + 8 * fq;
#pragma unroll
        for (int ai = 0; ai < 2; ++ai)
#pragma unroll
            for (int m = 0; m < 4; ++m) { const int row = row0 + ai * HALF + m * 16; float s = 0.f; const float re = 1.0f / sqrtf(sse[row] * (1.f / DM) + EPS);
#pragma unroll
                for (int bj = 0; bj < 2; ++bj) { const int col = col0 + bj * HALF; const size_t off = (size_t)row * DM + col;
                    const v4u hh = *(const v4u*)(h2b + off), ee = *(const v4u*)(er + off); const f32x4 g0 = *(const f32x4*)(gple + col) * re, g1 = *(const f32x4*)(gple + col + 4) * re;
                    const f32x4 a0 = acc[ai][bj][m][0], a1 = acc[ai][bj][m][1]; f32x4 v0, v1;
                    v0[0] = bf_lo(hh.x) + sigmoidf_(a0[0]) * bf_lo(ee.x) * g0[0]; v0[1] = bf_hi(hh.x) + sigmoidf_(a0[1]) * bf_hi(ee.x) * g0[1];
                    v0[2] = bf_lo(hh.y) + sigmoidf_(a0[2]) * bf_lo(ee.y) * g0[2]; v0[3] = bf_hi(hh.y) + sigmoidf_(a0[3]) * bf_hi(ee.y) * g0[3];
                    v1[0] = bf_lo(hh.z) + sigmoidf_(a1[0]) * bf_lo(ee.z) * g1[0]; v1[1] = bf_hi(hh.z) + sigmoidf_(a1[1]) * bf_hi(ee.z) * g1[1];
                    v1[2] = bf_lo(hh.w) + sigmoidf_(a1[2]) * bf_lo(ee.w) * g1[2]; v1[3] = bf_hi(hh.w) + sigmoidf_(a1[3]) * bf_hi(ee.w) * g1[3];
                    s += (v0[0] * v0[0] + v0[1] * v0[1]) + (v0[2] * v0[2] + v0[3] * v0[3]) + (v1[0] * v1[0] + v1[1] * v1[1]) + (v1[2] * v1[2] + v1[3] * v1[3]);
                    *(f32x4*)(out + off) = v0; *(f32x4*)(out + off + 4) = v1; }
                s += __shfl_xor(s, 16); s += __shfl_xor(s, 32);
                if (fq == 0) atomicAdd(ssf + row, s); }
    }
};
}

constexpr int WR_PT = 2064;
__device__ __forceinline__ void p4_router(const Frame& F, const Params& P) {
    unsigned char* ws = PWS(); unsigned* ctl = (unsigned*)(ws + WS_CTL);
    const bf16_t* hb = (const bf16_t*)(ws + WS_XB); const bf16_t* Wr = (const bf16_t*)(ws + WS_WR); const float* ss2 = (const float*)(ctl + CW_SS2);
    const float* b_rg = PIN(18); const float* b_re = PIN(20);
    int* toke = (int*)(ws + WS_TOKE); float* tokw = (float*)(ws + WS_TOKW); int* list = (int*)(ws + WS_LIST);
    LAS unsigned char* lds = F.lds; const int lane = F.lane, w = F.wave, l15 = lane & 15, lq = lane >> 4;
    for (int i = F.tid; i < 48 * 128; i += NTHREADS) { const int r = i >> 7, c = i & 127; *(LAS v4u*)(lds + r * WR_PT + c * 16) = *(const v4u*)(Wr + (size_t)r * DM + c * 8); }
    LAS int* lcnt = (LAS int*)(lds + 100352);
    LAS float* lsc = (LAS float*)(lds + 101376) + w * (16 * 49);
    for (int grp = F.vcu * 8 + w; grp < T / 16; grp += F.G * 8) {
        if (F.tid < 64) lcnt[F.tid] = 0;
        __syncthreads();
        const int t0 = grp * 16;
        f32x4 a0 = {0.f, 0.f, 0.f, 0.f}, a1 = a0, a2 = a0;
        const bf16_t* hrow = hb + (size_t)(t0 + l15) * DM + 8 * lq;
#pragma unroll 4
        for (int ks = 0; ks < 32; ++ks) { const bf16x8 hf = *(const bf16x8*)(hrow + 32 * ks);
            const bf16x8 w0 = *(const LAS bf16x8*)(lds + (l15) * WR_PT + (32 * ks + 8 * lq) * 2), w1 = *(const LAS bf16x8*)(lds + (16 + l15) * WR_PT + (32 * ks + 8 * lq) * 2), w2 = *(const LAS bf16x8*)(lds + (32 + l15) * WR_PT + (32 * ks + 8 * lq) * 2);
            a0 = __builtin_amdgcn_mfma_f32_16x16x32_bf16(w0, hf, a0, 0, 0, 0); a1 = __builtin_amdgcn_mfma_f32_16x16x32_bf16(w1, hf, a1, 0, 0, 0); a2 = __builtin_amdgcn_mfma_f32_16x16x32_bf16(w2, hf, a2, 0, 0, 0); }
#pragma unroll
        for (int r = 0; r < 4; ++r) { lsc[l15 * 49 + 4 * lq + r] = a0[r]; lsc[l15 * 49 + 16 + 4 * lq + r] = a1[r]; lsc[l15 * 49 + 32 + 4 * lq + r] = a2[r]; }
        asm volatile("s_waitcnt lgkmcnt(0)" ::: "memory");
        int e0g = 0, e1g = 0, s0 = 0, s1 = 0; float w0 = 0.f, w1 = 0.f;
        if (lane < 16) { const int t = t0 + lane; const float rs = 1.0f / sqrtf(ss2[t] * (1.f / DM) + EPS); const LAS float* lg = lsc + lane * 49;
            int g = 0; float mg = lg[0] * rs + b_rg[0]; float gl[4]; gl[0] = mg;
#pragma unroll
            for (int i = 1; i < 4; ++i) { gl[i] = lg[i] * rs + b_rg[i]; if (gl[i] > mg) { mg = gl[i]; g = i; } }
            float sg = 0.f;
#pragma unroll
            for (int i = 0; i < 4; ++i) sg += __expf(gl[i] - mg);
            const float gp = 1.f / sg;
            float m0 = -INFINITY, m1 = -INFINITY; int i0 = 0, i1 = 0;
            for (int i = 0; i < 8; ++i) { const float v = lg[4 + g * 8 + i] * rs + b_re[g * 8 + i]; if (v > m0) { m1 = m0; i1 = i0; m0 = v; i0 = i; } else if (v > m1) { m1 = v; i1 = i; } }
            const float p1 = __expf(m1 - m0), inv = 1.f / (1.f + p1);
            e0g = g * 8 + i0; e1g = g * 8 + i1; w0 = gp * inv; w1 = gp * p1 * inv;
            s0 = atomicAdd((int*)&lcnt[e0g], 1); s1 = atomicAdd((int*)&lcnt[e1g], 1);
            toke[t * 2] = e0g; toke[t * 2 + 1] = e1g; tokw[t * 2] = w0; tokw[t * 2 + 1] = w1; }
        __syncthreads();
        if (F.tid < 32) { const int c = lcnt[F.tid]; lcnt[32 + F.tid] = c ? atomicAdd((int*)(ctl + CW_CNT + F.tid), c) : 0; }
        __syncthreads();
        if (lane < 16) { const int t = t0 + lane; list[(size_t)e0g * T + lcnt[32 + e0g] + s0] = t * 2; list[(size_t)e1g * T + lcnt[32 + e1g] + s1] = t * 2 + 1; }
        __syncthreads();
    }
}
__device__ __forceinline__ void moe_tables(const Frame& F, const unsigned* ctl) {
    LAS int* ts = (LAS int*)(F.lds + XTRA_OFF); LAS int* cnt = ts + 64;
    if (F.tid == 0) { int acc = 0; for (int e = 0; e < NEXP; ++e) { const int c = (int)__hip_atomic_load(ctl + CW_CNT + e, __ATOMIC_RELAXED, __HIP_MEMORY_SCOPE_AGENT); cnt[e] = c; ts[e] = acc; acc += (c + 255) >> 8; } ts[NEXP] = acc; }
    __syncthreads();
}

#ifndef PM
#define PM 0xfff
#endif
__global__ void __launch_bounds__(NTHREADS, 2) fwd_megakernel(Params P) {
    extern __shared__ __attribute__((aligned(16))) unsigned char lds_raw[];
    cg::grid_group grid = cg::this_grid();
    Frame F;
    F.lds = (LAS unsigned char*)lds_raw;
    F.tid = threadIdx.x; F.lane = F.tid & 63; F.wave = __builtin_amdgcn_readfirstlane(F.tid >> 6);
    F.G = gridDim.x; { const int bx = blockIdx.x; F.vcu = (F.G % 8 == 0) ? (bx % 8) * (F.G / 8) + bx / 8 : bx; }

    if (PM & 1) p0_prologue(F, P);
    grid.sync();

    if (PM & 2) {
        unsigned char* ws = PWS(); bf16_t* gates = (bf16_t*)POUT();
        pg8::Gemm g{(const bf16_t*)(ws + WS_XB), (const bf16_t*)(ws + WS_WP), T, NPROJ, DM}; pg8::StaticOrder S; S.init(T, NPROJ, F.G, (int)blockIdx.x);
        pg8::EpiProj E{ws, gates, (const float*)(ws + WS_RSTD1), PIN(6), (const float*)(ws + WS_COS), (const float*)(ws + WS_SIN)};
        pg8::gemm_phase<pg8::EpiProj, pg8::StaticOrder, true, false>(F.lds, g, S, E);
    }
    if (PM & 4) {
        unsigned char* ws = PWS(); unsigned* ctl = (unsigned*)(ws + WS_CTL);
        pg8::Gemm g{(const bf16_t*)(ws + WS_PB), (const bf16_t*)(ws + WS_WPLE), T, DM, PLE}; pg8::StaticOrder S; S.init(T, DM, F.G, (int)blockIdx.x);
        pg8::EpiPle E{(bf16_t*)(ws + WS_ER), (float*)(ctl + CW_SSE)};
        pg8::gemm_phase<pg8::EpiPle, pg8::StaticOrder, true, false>(F.lds, g, S, E);
    }
    grid.sync();

    if (PM & 8) {
        unsigned char* ws = PWS(); unsigned* ctl = (unsigned*)(ws + WS_CTL);
        float lam;
        { float d1 = 0.f, d2 = 0.f; for (int i = 0; i < 64; ++i) { d1 += PIN(8)[i] * PIN(9)[i]; d2 += PIN(10)[i] * PIN(11)[i]; } lam = expf(d1) - expf(d2) + LAMBDA_INIT; }
        LAS int* qslot = (LAS int*)(F.lds + XTRA_OFF + 4096);
        bf16_t* oab = (bf16_t*)(ws + WS_XB);
        for (;;) {
            __syncthreads();
            if (F.tid == 0) qslot[0] = (int)atomicAdd(ctl + CW_QUEUE, 1u);
            __syncthreads();
            const int item = qslot[0];
            if (item >= 64 + 1024) break;
            if (item < 64) {
                gla::gla_item(item >> 2, item & 3, (const bf16_t*)(ws + WS_GQ), (const bf16_t*)(ws + WS_GK), (const bf16_t*)(ws + WS_GV), (const bf16_t*)(ws + WS_SR),
                              (const float*)(ws + WS_LA), PIN(7), oab, F.lds);
            } else {
                const int j = item - 64, qb = 15 - (j >> 6), bh = j & 63, b = bh >> 2, h = bh & 3;
                const size_t base = (size_t)b * SEQ * 512 + h * 128;
                da::attn_unit((const bf16_t*)(ws + WS_DQ) + base, (const bf16_t*)(ws + WS_DK) + base, (const bf16_t*)(ws + WS_DV) + base,
                              oab + (size_t)T * 512 + base, qb * 128, lam, PIN(12), (char*)lds_raw);
            }
        }
    }
    grid.sync();

    if (PM & 16) {
        unsigned char* ws = PWS(); bf16_t* gates = (bf16_t*)POUT();
        pg8::Gemm g{(const bf16_t*)(ws + WS_XB), (const bf16_t*)(ws + WS_WAB), 2 * T, 2048, 512}; pg8::BranchOrder S; S.so.init(T, DM, F.G, (int)blockIdx.x);
        pg8::EpiBranch E{gates, (bf16_t*)(ws + WS_MG)};
        pg8::gemm_phase<pg8::EpiBranch, pg8::BranchOrder, true, false>(F.lds, g, S, E);
    }
    grid.sync();

    if (PM & 32) {
        unsigned char* ws = PWS(); unsigned* ctl = (unsigned*)(ws + WS_CTL);
        pg8::Gemm g{(const bf16_t*)(ws + WS_MG), (const bf16_t*)(ws + WS_WO), T, DM, DM}; pg8::StaticOrder S; S.init(T, DM, F.G, (int)blockIdx.x);
        pg8::EpiOut E{PIN(0), (bf16_t*)(ws + WS_XB), (float*)(ctl + CW_SS2)};
        pg8::gemm_phase<pg8::EpiOut, pg8::StaticOrder, true, false>(F.lds, g, S, E);
    }
    grid.sync();

    if (PM & 64) p4_router(F, P);
    grid.sync();

    moe_tables(F, (const unsigned*)(PWS() + WS_CTL));
    if (PM & 128) {
        unsigned char* ws = PWS(); unsigned* ctl = (unsigned*)(ws + WS_CTL);
        pg8::MoeOrder<2> mo{(const LAS int*)(F.lds + XTRA_OFF), (const LAS int*)(F.lds + XTRA_OFF) + 64, (const int*)(ws + WS_LIST), F.G, (int)blockIdx.x};
        pg8::Gemm g{(const bf16_t*)(ws + WS_XB), (const bf16_t*)(ws + WS_WGU), T, NEXP * 512, DM};
        pg8::EpiUp E{mo, (const float*)(ctl + CW_SS2), (bf16_t*)(ws + WS_HE)};
        pg8::gemm_phase<pg8::EpiUp, pg8::MoeOrder<2>, true, true>(F.lds, g, mo, E);
    }
    grid.sync();
    if (PM & 256) {
        unsigned char* ws = PWS();
        pg8::MoeOrder<4> mo{(const LAS int*)(F.lds + XTRA_OFF), (const LAS int*)(F.lds + XTRA_OFF) + 64, (const int*)(ws + WS_LIST), F.G, (int)blockIdx.x};
        pg8::Gemm g{(const bf16_t*)(ws + WS_HE), (const bf16_t*)(ws + WS_WD), MOE_ROWS, NEXP * 1024, DEXP};
        pg8::EpiDown E{mo, (const float*)(ws + WS_TOKW), (bf16_t*)(ws + WS_YB)};
        pg8::gemm_phase<pg8::EpiDown, pg8::MoeOrder<4>, true, false>(F.lds, g, mo, E);
    }
    grid.sync();
    if (PM & 512) {
        unsigned char* ws = PWS();
        const bf16_t* hb = (const bf16_t*)(ws + WS_XB); const bf16_t* yb = (const bf16_t*)(ws + WS_YB); bf16_t* h2b = (bf16_t*)(ws + WS_H2B);
        const int gt = F.vcu * NTHREADS + F.tid, NGT = F.G * NTHREADS;
        for (int i = gt; i < T * DM / 8; i += NGT) { const int t = i >> 7, c = (i & 127) * 8;
            const v4u a = *(const v4u*)(hb + (size_t)t * DM + c), y0 = *(const v4u*)(yb + (size_t)(2 * t) * DM + c), y1 = *(const v4u*)(yb + (size_t)(2 * t + 1) * DM + c);
            v4u o; o.x = cvt_pk_bf16(bf_lo(a.x) + bf_lo(y0.x) + bf_lo(y1.x), bf_hi(a.x) + bf_hi(y0.x) + bf_hi(y1.x)); o.y = cvt_pk_bf16(bf_lo(a.y) + bf_lo(y0.y) + bf_lo(y1.y), bf_hi(a.y) + bf_hi(y0.y) + bf_hi(y1.y));
            o.z = cvt_pk_bf16(bf_lo(a.z) + bf_lo(y0.z) + bf_lo(y1.z), bf_hi(a.z) + bf_hi(y0.z) + bf_hi(y1.z)); o.w = cvt_pk_bf16(bf_lo(a.w) + bf_lo(y0.w) + bf_lo(y1.w), bf_hi(a.w) + bf_hi(y0.w) + bf_hi(y1.w));
            *(v4u*)(h2b + (size_t)t * DM + c) = o; }
    }
    grid.sync();
    if (PM & 1024) {
        unsigned char* ws = PWS(); unsigned* ctl = (unsigned*)(ws + WS_CTL);
        pg8::Gemm g{(const bf16_t*)(ws + WS_H2B), (const bf16_t*)(ws + WS_WPG), T, DM, DM}; pg8::StaticOrder S; S.init(T, DM, F.G, (int)blockIdx.x);
        pg8::EpiFinal E{(const bf16_t*)(ws + WS_H2B), (const bf16_t*)(ws + WS_ER), (const float*)(ctl + CW_SSE), PIN(25), POUT(), (float*)(ctl + CW_SSF)};
        pg8::gemm_phase<pg8::EpiFinal, pg8::StaticOrder, true, false>(F.lds, g, S, E);
    }
    grid.sync();
    if (PM & 2048) {
        unsigned char* ws = PWS(); unsigned* ctl = (unsigned*)(ws + WS_CTL);
        const float* ssf = (const float*)(ctl + CW_SSF); const float* gf = PIN(27); float* out = POUT();
        const int gt = F.vcu * NTHREADS + F.tid, NGT = F.G * NTHREADS;
        for (int i = gt; i < T * DM / 4; i += NGT) { const int t = i >> 8, c = (i & 255) * 4; const float rs = 1.0f / sqrtf(ssf[t] * (1.f / DM) + EPS);
            f32x4 v = *(f32x4*)(out + (size_t)t * DM + c); const f32x4 g = *(const f32x4*)(gf + c); v = v * g * rs; *(f32x4*)(out + (size_t)t * DM + c) = v; }
    }
}

extern "C" void kernel_launch(void* const* d_in, const int* in_sizes, int n_in, void* d_out, int out_size, void* d_ws, size_t ws_size, hipStream_t stream) {
    static int grid = 0;
    if (grid == 0) {
        if (n_in != 28 || out_size != T * DM || ws_size < WS_END) { fprintf(stderr, "kernel_launch: unexpected shapes (n_in %d, out %d, ws %zu < %zu)\n", n_in, out_size, ws_size, (size_t)WS_END); grid = -1; return; }
        int dev = 0, cus = 0, per_cu = 0;
        hipGetDevice(&dev); hipDeviceGetAttribute(&cus, hipDeviceAttributeMultiprocessorCount, dev);
        if (hipFuncSetAttribute((const void*)fwd_megakernel, hipFuncAttributeMaxDynamicSharedMemorySize, LDS_BYTES) != hipSuccess) { fprintf(stderr, "kernel_launch: hipFuncSetAttribute failed\n"); grid = -1; return; }
        if (hipOccupancyMaxActiveBlocksPerMultiprocessor(&per_cu, (const void*)fwd_megakernel, NTHREADS, LDS_BYTES) != hipSuccess || per_cu < 1) { fprintf(stderr, "kernel_launch: occupancy query says %d blocks/CU\n", per_cu); grid = -1; return; }
        grid = cus;
        fprintf(stderr, "kernel_launch: cus %d per_cu %d grid %d ws %zu\n", cus, per_cu, grid, ws_size);
    }
    if (grid < 0) return;
    hipMemsetAsync((char*)d_ws + WS_CTL, 0, CTL_ZERO_BYTES, stream);
    Params p{};
    for (int i = 0; i < 28; ++i) p.p[i] = d_in[i];
    p.p[28] = d_out; p.p[29] = d_ws;
    void* args[] = {&p};
    hipError_t e = hipLaunchCooperativeKernel((const void*)fwd_megakernel, dim3(grid), dim3(NTHREADS), args, LDS_BYTES, stream);
    if (e != hipSuccess) fprintf(stderr, "cooperative launch failed: %s (grid %d)\n", hipGetErrorString(e), grid);
}
```

```cpp
#include <hip/hip_runtime.h>
#include <hip/hip_cooperative_groups.h>
#include <hip/hip_bf16.h>
#include <cstdio>
#include <cstdint>
#include <cmath>
namespace cg = cooperative_groups;

constexpr int NB = 16, SEQ = 2048, DM = 1024, T = NB * SEQ, DIN = 5136, NPROJ = 5376, PLE = 256;
constexpr int NEXP = 32, DEXP = 256;
constexpr float EPS = 1e-6f;
constexpr float LOG2E = 1.4426950408889634f;
constexpr float QSCALE2 = 0.125f * LOG2E;
constexpr float LAMBDA_INIT = 0.2f;
constexpr int C_Q = 0, C_K = 256, C_V = 512, C_R = 1024, C_AL = 1536, C_DQ = 1552, C_DK = 2064, C_DV = 2576, C_GA = 3088, C_GB = 4112;
constexpr int P_Q = 0, P_K = 256, P_V = 512, P_R = 1024, P_AL = 1536, P_DQ = 1792, P_DK = 2304, P_DV = 2816, P_GA = 3328, P_GB = 4352;

constexpr size_t MiB = 1u << 20;
constexpr size_t WS_CTL = 0, CTL_ZERO_BYTES = 1 * MiB;
constexpr int CW_CNT = 64;
constexpr int CW_QUEUE = 128;
constexpr int CW_BAR = 4096;
constexpr int CW_SS2 = 65536;
constexpr int CW_SSE = 65536 + 32768;
constexpr int CW_SSF = 65536 + 65536;
static_assert((CW_SSF + 32768) * 4 <= (int)CTL_ZERO_BYTES, "ctl");
constexpr size_t WS_RSTD1 = 1 * MiB;
constexpr size_t WS_TOKE = 1 * MiB + 256 * 1024;
constexpr size_t WS_TOKW = 1 * MiB + 512 * 1024;
constexpr size_t WS_COS = 2 * MiB, WS_SIN = 3 * MiB;
constexpr size_t WS_LIST = 4 * MiB;
constexpr size_t WS_WP = 8 * MiB;
constexpr size_t WS_WGU = 19 * MiB;
constexpr size_t WS_WD = 51 * MiB;
constexpr size_t WS_WAB = 67 * MiB;
constexpr size_t WS_WO = 69 * MiB;
constexpr size_t WS_WPG = 71 * MiB;
constexpr size_t WS_WPLE = 73 * MiB;
constexpr size_t WS_WR = 73 * MiB + 512 * 1024;
constexpr size_t WS_XB = 74 * MiB;
constexpr size_t WS_PB = 138 * MiB;
constexpr size_t WS_ER = 154 * MiB;
constexpr size_t WS_GQ = 218 * MiB, WS_GK = 234 * MiB, WS_GV = 250 * MiB, WS_SR = 282 * MiB, WS_LA = 314 * MiB, WS_DQ = 346 * MiB, WS_DK = 378 * MiB, WS_DV = 410 * MiB;
constexpr size_t WS_MG = 218 * MiB;
constexpr size_t WS_H2B = 282 * MiB;
constexpr size_t WS_YB = 346 * MiB;
constexpr size_t WS_HE = 474 * MiB;
constexpr size_t WS_END = 512 * MiB;
constexpr int MOE_ROWS = 2 * T + NEXP * 256;
static_assert(WS_HE + (size_t)MOE_ROWS * DEXP * 2 <= WS_END, "ws");

constexpr int RING_BYTES = 131072;
constexpr int XTRA_OFF = RING_BYTES;
constexpr int LDS_BYTES = RING_BYTES + 20480;
constexpr int NTHREADS = 512;

#define GAS __attribute__((address_space(1)))
#define LAS __attribute__((address_space(3)))
typedef unsigned short bf16_t;
typedef unsigned v4u __attribute__((ext_vector_type(4)));
typedef unsigned v2u __attribute__((ext_vector_type(2)));
typedef float f32x4 __attribute__((ext_vector_type(4)));
typedef float f32x2 __attribute__((ext_vector_type(2)));
typedef float f32x16 __attribute__((ext_vector_type(16)));
typedef short bf16x8 __attribute__((ext_vector_type(8)));
typedef short s16x4 __attribute__((ext_vector_type(4)));

__device__ __forceinline__ unsigned cvt_pk_bf16(float lo, float hi) { unsigned r; asm volatile("v_cvt_pk_bf16_f32 %0, %1, %2" : "=v"(r) : "v"(lo), "v"(hi)); return r; }
__device__ __forceinline__ float bf_lo(unsigned w) { return __uint_as_float(w << 16); }
__device__ __forceinline__ float bf_hi(unsigned w) { return __uint_as_float(w & 0xffff0000u); }
__device__ __forceinline__ float sigmoidf_(float x) { return __builtin_amdgcn_rcpf(1.f + __builtin_amdgcn_exp2f(-x * LOG2E)); }
__device__ __forceinline__ float wave_sum(float v) {
#pragma unroll
    for (int o = 1; o < 64; o <<= 1) v += __shfl_xor(v, o);
    return v;
}

namespace pg8 {
constexpr int BM = 256, BK = 64, HALF = 128, HTB = HALF * BK * 2, STAGE_BYTES = 8 * HTB, NXCD = 8, WGM = 8;
__host__ __device__ __forceinline__ int lds_byte(int r, int c) { const int st = (r >> 4) * 2 + (c >> 5), rr = r & 15, cc = c & 31, ob = rr * 64 + cc * 2; return st * 1024 + (ob ^ (((ob >> 9) & 1) << 5)); }
__host__ __device__ __forceinline__ void stage_rc(int b, int& R, int& C) { const int st = b / 1024, sb = b % 1024, swz = sb ^ (((sb >> 9) & 1) << 5); R = (st >> 1) * 16 + swz / 64; C = (st & 1) * 32 + (swz % 64) / 2; }
__host__ __device__ __forceinline__ int perm32(int rho) { const int n = rho >> 4, i = rho & 15; return 8 * (i >> 2) + 4 * n + (i & 3); }
struct Unit { int pm, pn; };
struct Gemm { const bf16_t* A; const bf16_t* Bt; int M, N, K; };
struct StaticOrder {
    int nM, nN, nwg, G, c;
    __host__ __device__ void init(int M, int N, int G_, int c_) { nM = M / BM; nN = N / BM; nwg = nM * nN; G = G_; c = c_; }
    __host__ __device__ bool next(int i, Unit& u) const {
        const long L = (long)i * G + c; if (L >= nwg) return false;
        int wgid = (int)L; { const int q = nwg / NXCD, r = nwg % NXCD, xcd = wgid % NXCD, off = wgid / NXCD; wgid = (xcd < r ? xcd * (q + 1) : r * (q + 1) + (xcd - r) * q) + off; }
        const int nig = WGM * nN, gid = wgid / nig, fm = gid * WGM, gsz = (nM - fm) < WGM ? (nM - fm) : WGM;
        u.pm = fm + ((wgid % nig) % gsz); u.pn = (wgid % nig) / gsz; return true;
    }
    __device__ __forceinline__ unsigned arow(const Unit&, int) const { return 0u; }
};

template <class Epi, class Sched, bool ALIGN_EPI, bool GATHER>
__device__ __forceinline__ void gemm_phase(LAS unsigned char* lds, const Gemm g, const Sched& S, const Epi& E) {
    int tid = threadIdx.x; asm volatile("" : "+v"(tid));
    const int wid = __builtin_amdgcn_readfirstlane(tid >> 6), lane = tid & 63, wr = wid >> 2, wc = wid & 3, fr = lane & 15, fq = lane >> 4;
    const int K = g.K, nt = K / BK;
    unsigned voffB[2]; int RA[2], CA[2];
#pragma unroll
    for (int i = 0; i < 2; ++i) { int R, C; stage_rc(tid * 16 + i * 8192, R, C); const int Rb = Epi::PERM ? ((R & ~31) + perm32(R & 31)) : R;
        RA[i] = R; CA[i] = C; voffB[i] = (unsigned)(Rb * K + C) * 2u; }
    const size_t kstep = (size_t)(BK * 2);
    const size_t hstep = (size_t)HALF * K * 2;
    const size_t tstep = 2 * hstep;
    const unsigned ldsw = (unsigned)wid * 1024u;
    const int aoff = lds_byte(wr * 64 + fr, fq * 8), boff = lds_byte(wc * 32 + fr, fq * 8);
#define PG8_SA(b, h) (((b) * 2 + (h)) * HTB)
#define PG8_SB(b, h) ((4 + (b) * 2 + (h)) * HTB)
#define PG8_STAGE(bufoff, gbase, voff) do { _Pragma("unroll") for (int _i = 0; _i < 2; ++_i) \
        __builtin_amdgcn_global_load_lds((const unsigned*)((const char*)(gbase) + (voff)[_i]), (LAS unsigned*)(lds + (bufoff) + ldsw + _i * 8192), 16, 0, 0); } while (0)
#define PG8_STA(bufoff, gbase, v0, v1) do { \
        __builtin_amdgcn_global_load_lds((const unsigned*)((const char*)(gbase) + (v0)), (LAS unsigned*)(lds + (bufoff) + ldsw), 16, 0, 0); \
        __builtin_amdgcn_global_load_lds((const unsigned*)((const char*)(gbase) + (v1)), (LAS unsigned*)(lds + (bufoff) + ldsw + 8192), 16, 0, 0); } while (0)
#define PG8_LDA(dst, b, h) do { _Pragma("unroll") for (int m = 0; m < 4; ++m) _Pragma("unroll") for (int k = 0; k < 2; ++k) dst[m][k] = *(const LAS bf16x8*)(lds + PG8_SA(b, h) + aoff + m * 2048 + k * 1024); } while (0)
#define PG8_LDB(dst, b, h) do { _Pragma("unroll") for (int n = 0; n < 2; ++n) _Pragma("unroll") for (int k = 0; k < 2; ++k) dst[n][k] = *(const LAS bf16x8*)(lds + PG8_SB(b, h) + boff + n * 2048 + k * 1024); } while (0)
#define PG8_MMA(ai, bj, At, Bt) do { __builtin_amdgcn_s_setprio(1); _Pragma("unroll") for (int m = 0; m < 4; ++m) _Pragma("unroll") for (int n = 0; n < 2; ++n) _Pragma("unroll") for (int k = 0; k < 2; ++k) \
        acc[ai][bj][m][n] = __builtin_amdgcn_mfma_f32_16x16x32_bf16(Bt[n][k], At[m][k], acc[ai][bj][m][n], 0, 0, 0); __builtin_amdgcn_s_setprio(0); } while (0)
#define PG8_WAIT_V(n) asm volatile("s_waitcnt vmcnt(" #n ")" ::: "memory")
#define PG8_WAIT_L(n) asm volatile("s_waitcnt lgkmcnt(" #n ")" ::: "memory")
#define PG8_BAR __builtin_amdgcn_s_barrier()
#define PG8_SCHED __builtin_amdgcn_sched_barrier(0)
    Unit cur, nxt; int ui = 0;
    if (!S.next(0, cur)) return;
    f32x4 acc[2][2][4][2];
#pragma unroll
    for (int a = 0; a < 2; ++a)
#pragma unroll
        for (int b = 0; b < 2; ++b)
#pragma unroll
            for (int m = 0; m < 4; ++m)
#pragma unroll
                for (int n = 0; n < 2; ++n) acc[a][b][m][n] = (f32x4){0.f, 0.f, 0.f, 0.f};
    bf16x8 At[4][2], B0[2][2], B1[2][2];
    unsigned vA00, vA01, vA10, vA11, vN00, vN01, vN10, vN11;
#define PG8_AOFF(u, h, i) (GATHER ? (unsigned)(((size_t)S.arow(u, (h) * HALF + RA[i]) * (size_t)K + CA[i]) * 2u) : (unsigned)((h) * hstep + ((size_t)RA[i] * K + CA[i]) * 2u))
    vA00 = PG8_AOFF(cur, 0, 0); vA01 = PG8_AOFF(cur, 0, 1); vA10 = PG8_AOFF(cur, 1, 0); vA11 = PG8_AOFF(cur, 1, 1);
    vN00 = vA00; vN01 = vA01; vN10 = vA10; vN11 = vA11;
    const char* cA = (const char*)g.A + (GATHER ? (size_t)0 : (size_t)cur.pm * tstep); const char* cB = (const char*)g.Bt + (size_t)cur.pn * tstep;
    PG8_STAGE(PG8_SB(0, 0), cB, voffB); PG8_STAGE(PG8_SB(0, 1), cB + hstep, voffB); PG8_STA(PG8_SA(0, 0), cA, vA00, vA01); PG8_STA(PG8_SA(0, 1), cA, vA10, vA11);
    if (wr == 1) PG8_BAR;
    PG8_WAIT_V(2); PG8_BAR;
    PG8_STAGE(PG8_SB(1, 0), cB + kstep, voffB); PG8_STA(PG8_SA(1, 0), cA + kstep, vA00, vA01); PG8_STAGE(PG8_SB(1, 1), cB + hstep + kstep, voffB);
    PG8_WAIT_V(6); PG8_BAR;
#pragma unroll 1
    for (;;) {
        const bool has_next = S.next(ui + 1, nxt);
        const char* nA = has_next ? (const char*)g.A + (GATHER ? (size_t)0 : (size_t)nxt.pm * tstep) : cA; const char* nB = has_next ? (const char*)g.Bt + (size_t)nxt.pn * tstep : cB;
        if constexpr (GATHER) { if (has_next) { vN00 = PG8_AOFF(nxt, 0, 0); vN01 = PG8_AOFF(nxt, 0, 1); vN10 = PG8_AOFF(nxt, 1, 0); vN11 = PG8_AOFF(nxt, 1, 1); } else { vN00 = vA00; vN01 = vA01; vN10 = vA10; vN11 = vA11; } }
#pragma unroll 1
        for (int t = 0; t < nt; t += 2) {
            const bool last = (t == nt - 2);
            const char* a1 = cA + (size_t)(t + 1) * kstep;
            const char* a2 = last ? nA : cA + (size_t)(t + 2) * kstep; const char* b2 = last ? nB : cB + (size_t)(t + 2) * kstep;
            const char* a3 = a2 + kstep; const char* b3 = b2 + kstep;
            unsigned w00 = vA00, w01 = vA01, w10 = vA10, w11 = vA11;
            if constexpr (GATHER) { if (last) { w00 = vN00; w01 = vN01; w10 = vN10; w11 = vN11; } }
            PG8_LDB(B0, 0, 0); PG8_LDB(B1, 0, 1); PG8_SCHED; PG8_LDA(At, 0, 0); PG8_STA(PG8_SA(1, 1), a1, vA10, vA11);
            PG8_WAIT_V(8); PG8_WAIT_L(0); PG8_BAR; PG8_MMA(0, 0, At, B0); PG8_MMA(0, 1, At, B1); PG8_BAR; PG8_SCHED;
            PG8_LDA(At, 0, 1); PG8_STAGE(PG8_SB(0, 0), b2, voffB); PG8_STAGE(PG8_SB(0, 1), b2 + hstep, voffB); PG8_STA(PG8_SA(0, 0), a2, w00, w01);
            PG8_WAIT_V(8); PG8_WAIT_L(0); PG8_BAR; PG8_MMA(1, 0, At, B0); PG8_MMA(1, 1, At, B1); PG8_BAR; PG8_SCHED;
            PG8_LDB(B0, 1, 0); PG8_LDB(B1, 1, 1); PG8_SCHED; PG8_LDA(At, 1, 0); PG8_STA(PG8_SA(0, 1), a2, w10, w11);
            PG8_WAIT_V(8); PG8_WAIT_L(0); PG8_BAR; PG8_MMA(0, 0, At, B0); PG8_MMA(0, 1, At, B1); PG8_BAR; PG8_SCHED;
            PG8_LDA(At, 1, 1); PG8_STAGE(PG8_SB(1, 0), b3, voffB); PG8_STAGE(PG8_SB(1, 1), b3 + hstep, voffB); PG8_STA(PG8_SA(1, 0), a3, w00, w01);
            PG8_WAIT_V(8); PG8_WAIT_L(0); PG8_BAR; PG8_MMA(1, 0, At, B0); PG8_MMA(1, 1, At, B1); PG8_BAR; PG8_SCHED;
        }
        if constexpr (ALIGN_EPI) { if (wr == 0) PG8_BAR; }
        E(acc, cur, wr, wc, fr, fq);
        if (!has_next) break;
#pragma unroll
        for (int a = 0; a < 2; ++a)
#pragma unroll
            for (int b = 0; b < 2; ++b)
#pragma unroll
                for (int m = 0; m < 4; ++m)
#pragma unroll
                    for (int n = 0; n < 2; ++n) acc[a][b][m][n] = (f32x4){0.f, 0.f, 0.f, 0.f};
        cur = nxt; cA = nA; cB = nB; ++ui;
        vA00 = vN00; vA01 = vN01; vA10 = vN10; vA11 = vN11;
        if constexpr (ALIGN_EPI) { if (wr == 1) PG8_BAR; }
    }
    PG8_WAIT_V(0);
    if constexpr (!ALIGN_EPI) { if (wr == 0) PG8_BAR; }
    PG8_BAR;
#undef PG8_AOFF
#undef PG8_SA
#undef PG8_SB
#undef PG8_STAGE
#undef PG8_STA
#undef PG8_LDA
#undef PG8_LDB
#undef PG8_MMA
#undef PG8_WAIT_V
#undef PG8_WAIT_L
#undef PG8_BAR
#undef PG8_SCHED
}
}

struct Params { const void* p[30]; };
__device__ __forceinline__ const void* parg(const Params& P, int i) { asm volatile("" : "+s"(i)); return P.p[i]; }
#define PIN(i) ((const float*)parg(P, (i)))
#define POUT() ((float*)parg(P, 28))
#define PWS() ((unsigned char*)parg(P, 29))
struct Frame {
    LAS unsigned char* lds;
    int tid, lane, wave, vcu, G;
};

#define XB_TMO      128
#define XB_XCNT(j)  (256  + 64 * (j))
#define XB_XSUB(j)  (1280 + 64 * (j))
#define XB_XGEN(j)  (2304 + 64 * (j))
#define XB_TOP      3328
#define XB_TOPGEN   3392
#define XCD_BAR_WORDS 3456
#define XB_SPIN_CAP (1u << 20)
__device__ __forceinline__ unsigned xb_ld(unsigned* p)              { return __hip_atomic_load(p, __ATOMIC_RELAXED, __HIP_MEMORY_SCOPE_AGENT); }
__device__ __forceinline__ unsigned xb_add(unsigned* p, unsigned v) { return __hip_atomic_fetch_add(p, v, __ATOMIC_RELAXED, __HIP_MEMORY_SCOPE_AGENT); }
__device__ __forceinline__ unsigned xb_xcc_id() { return (unsigned)__builtin_amdgcn_s_getreg((3 << 11) | 20) & 0xFu; }
#define XB_SPIN(cond, bar) do { unsigned _sp = 0; while (cond) { __builtin_amdgcn_s_sleep(1); \
    if ((++_sp & 255u) == 0u) { if (xb_ld(&(bar)[XB_TMO])) break; if (_sp > XB_SPIN_CAP) { atomicAdd(&(bar)[XB_TMO], 1u); break; } } } } while (0)
struct XcdBarrier { unsigned* bar; unsigned x; volatile LAS unsigned* st; };
__device__ __forceinline__ XcdBarrier xcd_barrier_post(unsigned* bar, volatile LAS unsigned* st) {
    XcdBarrier b; b.bar = bar; b.x = xb_xcc_id(); b.st = st;
    if (threadIdx.x == 0) (void)xb_add(&bar[XB_XCNT(b.x)], 1u);
    return b;
}
__device__ __forceinline__ void xcd_barrier_complete(unsigned* bar, unsigned x, unsigned& nloc, unsigned& nx) {
    const unsigned G = gridDim.x * gridDim.y * gridDim.z;
    unsigned sum, cnt, mine, sp = 0u;
    for (;;) {
        sum = 0u; cnt = 0u; mine = 0u;
#pragma unroll
        for (unsigned j = 0; j < 16; ++j) { const unsigned c = xb_ld(&bar[XB_XCNT(j)]); sum += c; cnt += (c > 0u) ? 1u : 0u; mine = (j == x) ? c : mine; }
        if (sum == G) break;
        __builtin_amdgcn_s_sleep(1);
        if ((++sp & 255u) == 0u) { if (xb_ld(&bar[XB_TMO])) break; if (sp > XB_SPIN_CAP) { atomicAdd(&bar[XB_TMO], 1u); break; } }
    }
    nloc = mine > 0u ? mine : 1u; nx = cnt > 0u ? cnt : 1u;
}
__device__ __forceinline__ void xcd_barrier(const XcdBarrier& b) {
    asm volatile("s_waitcnt vmcnt(0)" ::: "memory");
    __syncthreads();
    if (threadIdx.x == 0) {
        unsigned* bar = b.bar;
        __builtin_amdgcn_s_waitcnt(0);
        unsigned nloc = b.st[0], nx = b.st[1];
        if (nloc == 0u) { xcd_barrier_complete(bar, b.x, nloc, nx); b.st[0] = nloc; b.st[1] = nx; }
        const unsigned old = xb_add(&bar[XB_XSUB(b.x)], 1u);
        const unsigned gen = old / nloc;
        if (old + 1u == (gen + 1u) * nloc) {
            __builtin_amdgcn_fence(__ATOMIC_RELEASE, "agent");
            asm volatile("s_waitcnt vmcnt(0)" ::: "memory");
            const unsigned og = xb_add(&bar[XB_TOP], 1u);
            const unsigned tg = og / nx;
            if (og + 1u == (tg + 1u) * nx) xb_add(&bar[XB_TOPGEN], 1u);
            else XB_SPIN(xb_ld(&bar[XB_TOPGEN]) == tg, bar);
            __builtin_amdgcn_fence(__ATOMIC_ACQUIRE, "agent");
            xb_add(&bar[XB_XGEN(b.x)], 1u);
            asm volatile("s_waitcnt vmcnt(0)" ::: "memory");
        } else {
            XB_SPIN(xb_ld(&bar[XB_XGEN(b.x)]) == gen, bar);
            __builtin_amdgcn_fence(__ATOMIC_ACQUIRE, "agent");
            asm volatile("s_waitcnt vmcnt(0)" ::: "memory");
        }
    }
    __syncthreads();
}

__device__ __forceinline__ void tr_item(const float* W, int ld, int k0, const float* gain, float scale, bf16_t* dst, int K, LAS float* scr, int lane) {
#pragma unroll 8
    for (int i = 0; i < 32; ++i) { const int kk = 2 * i + (lane >> 5); float v = W[(size_t)(k0 + kk) * ld + (lane & 31)]; if (gain) v *= gain[k0 + kk]; scr[kk * 33 + (lane & 31)] = v * scale; }
    asm volatile("s_waitcnt lgkmcnt(0)" ::: "memory");
    const int c = lane & 7;
#pragma unroll
    for (int j = 0; j < 4; ++j) { const int n = (lane >> 3) + 8 * j; const LAS float* s = scr + (8 * c) * 33 + n;
        v4u o; o.x = cvt_pk_bf16(s[0 * 33], s[1 * 33]); o.y = cvt_pk_bf16(s[2 * 33], s[3 * 33]); o.z = cvt_pk_bf16(s[4 * 33], s[5 * 33]); o.w = cvt_pk_bf16(s[6 * 33], s[7 * 33]);
        *(v4u*)(dst + (size_t)n * K + k0 + 8 * c) = o; }
    asm volatile("s_waitcnt lgkmcnt(0)" ::: "memory");
}

__device__ __forceinline__ void p0_prologue(const Frame& F, const Params& P) {
    unsigned char* ws = PWS();
    const float* x = PIN(0); const float* p = PIN(1); const int* pos = (const int*)PIN(2);
    const float* attn_norm = PIN(3); const float* w_in = PIN(4); const float* w_a2 = PIN(5);
    const float* w_ba = PIN(13); const float* w_bb = PIN(14); const float* w_out = PIN(15); const float* ffn_norm = PIN(16);
    const float* w_rg = PIN(17); const float* w_re = PIN(19);
    const float* w_gate = PIN(21); const float* w_up = PIN(22); const float* w_down = PIN(23); const float* w_ple = PIN(24); const float* w_pg = PIN(26);
    bf16_t* Wp = (bf16_t*)(ws + WS_WP); bf16_t* Wgu = (bf16_t*)(ws + WS_WGU); bf16_t* Wd = (bf16_t*)(ws + WS_WD); bf16_t* Wab = (bf16_t*)(ws + WS_WAB);
    bf16_t* Wo = (bf16_t*)(ws + WS_WO); bf16_t* Wpg = (bf16_t*)(ws + WS_WPG); bf16_t* Wple = (bf16_t*)(ws + WS_WPLE); bf16_t* Wr = (bf16_t*)(ws + WS_WR);
    LAS float* scr = (LAS float*)(F.lds + F.wave * 16384);
    const int gw = F.vcu * 8 + F.wave, NGW = F.G * 8, lane = F.lane;
    constexpr int I0 = 16 * 48, I1 = 16 * 112, I2 = 8 * 32, I3 = 8 * 32, I4 = 16 * 32, I5 = 16 * 32, I6 = 4 * 32, I7 = 32 * 16 * 8, I8 = I7, I9 = 32 * 4 * 32;
    constexpr int NITEMS = I0 + I1 + I2 + I3 + I4 + I5 + I6 + I7 + I8 + I9;
    for (int it = gw; it < NITEMS; it += NGW) {
        int r = it;
        if (r < I0) { const int kb = r / 48, nb = r % 48; tr_item(w_in + nb * 32, DIN, kb * 64, attn_norm, nb < 8 ? 0.125f : 1.f, Wp + (size_t)(nb * 32) * DM, DM, scr, lane); continue; } r -= I0;
        if (r < I1) { const int kb = r / 112, nb = r % 112; tr_item(w_in + C_DQ + nb * 32, DIN, kb * 64, attn_norm, nb < 16 ? QSCALE2 : 1.f, Wp + (size_t)(P_DQ + nb * 32) * DM, DM, scr, lane); continue; } r -= I1;
        if (r < I2) { const int kb = r / 32, nb = r % 32; tr_item(w_ba + nb * 32, DM, kb * 64, nullptr, 1.f, Wab + (size_t)(nb * 32) * 512, 512, scr, lane); continue; } r -= I2;
        if (r < I3) { const int kb = r / 32, nb = r % 32; tr_item(w_bb + nb * 32, DM, kb * 64, nullptr, 1.f, Wab + (size_t)(1024 + nb * 32) * 512, 512, scr, lane); continue; } r -= I3;
        if (r < I4) { const int kb = r / 32, nb = r % 32; tr_item(w_out + nb * 32, DM, kb * 64, nullptr, 1.f, Wo + (size_t)(nb * 32) * DM, DM, scr, lane); continue; } r -= I4;
        if (r < I5) { const int kb = r / 32, nb = r % 32; tr_item(w_pg + nb * 32, DM, kb * 64, nullptr, 1.f, Wpg + (size_t)(nb * 32) * DM, DM, scr, lane); continue; } r -= I5;
        if (r < I6) { const int kb = r / 32, nb = r % 32; tr_item(w_ple + nb * 32, DM, kb * 64, nullptr, 1.f, Wple + (size_t)(nb * 32) * PLE, PLE, scr, lane); continue; } r -= I6;
        if (r < I7 + I8) { const int up = r >= I7; if (up) r -= I7; const int e = r / 128, q = r % 128, kb = q / 8, nb = q % 8;
            const float* src = (up ? w_up : w_gate) + (size_t)e * DM * DEXP + nb * 32;
            tr_item(src, DEXP, kb * 64, ffn_norm, 1.f, Wgu + (size_t)(e * 512 + (nb >> 2) * 256 + up * 128 + (nb & 3) * 32) * DM, DM, scr, lane); continue; } r -= I7 + I8;
        { const int e = r / 128, q = r % 128, kb = q / 32, nb = q % 32;
          tr_item(w_down + (size_t)e * DEXP * DM + nb * 32, DM, kb * 64, nullptr, 1.f, Wd + (size_t)(e * 1024 + nb * 32) * DEXP, DEXP, scr, lane); }
    }
    for (int it = gw; it < 16 * 8; it += NGW) { const int kb = it / 8, jb = it % 8, k = kb * 64 + lane;
        float wv[16];
#pragma unroll
        for (int r = 0; r < 16; ++r) wv[r] = w_in[(size_t)k * DIN + C_AL + r];
        const float g = attn_norm[k];
        for (int jj = 0; jj < 32; ++jj) { const int j = jb * 32 + jj; float s = 0.f;
#pragma unroll
            for (int r = 0; r < 16; ++r) s += wv[r] * w_a2[r * 256 + j];
            Wp[(size_t)(P_AL + j) * DM + k] = (bf16_t)(cvt_pk_bf16(s * g, 0.f) & 0xffffu); } }
    const int gt = F.vcu * NTHREADS + F.tid, NGT = F.G * NTHREADS;
    for (int i = gt; i < 48 * DM; i += NGT) { const int n = i >> 10, k = i & 1023; float v = 0.f;
        if (n < 4) v = w_rg[k * 4 + n] * ffn_norm[k]; else if (n < 36) v = w_re[k * 32 + (n - 4)] * ffn_norm[k];
        Wr[i] = (bf16_t)(cvt_pk_bf16(v, 0.f) & 0xffffu); }
    { bf16_t* xb = (bf16_t*)(ws + WS_XB); float* rstd1 = (float*)(ws + WS_RSTD1);
      for (int m = gw; m < T; m += NGW) { const GAS f32x4* xr = (const GAS f32x4*)(x + (size_t)m * DM) + lane; f32x4 v[4]; float s = 0.f;
#pragma unroll
          for (int j = 0; j < 4; ++j) { v[j] = xr[64 * j]; s += (v[j].x * v[j].x + v[j].y * v[j].y) + (v[j].z * v[j].z + v[j].w * v[j].w); }
          s = wave_sum(s);
          GAS v2u* o8 = (GAS v2u*)(xb + (size_t)m * DM) + lane;
#pragma unroll
          for (int j = 0; j < 4; ++j) { v2u o; o.x = cvt_pk_bf16(v[j].x, v[j].y); o.y = cvt_pk_bf16(v[j].z, v[j].w); o8[64 * j] = o; }
          if (lane == 0) rstd1[m] = 1.0f / sqrtf(s * (1.f / DM) + EPS); } }
    { bf16_t* pb = (bf16_t*)(ws + WS_PB);
      for (int i = gt; i < T * PLE / 8; i += NGT) { const f32x4 a = *(const f32x4*)(p + (size_t)i * 8), b = *(const f32x4*)(p + (size_t)i * 8 + 4);
          v4u o; o.x = cvt_pk_bf16(a.x, a.y); o.y = cvt_pk_bf16(a.z, a.w); o.z = cvt_pk_bf16(b.x, b.y); o.w = cvt_pk_bf16(b.z, b.w); *(v4u*)(pb + (size_t)i * 8) = o; } }
    { float* ct = (float*)(ws + WS_COS); float* st = (float*)(ws + WS_SIN);
      for (int i = gt; i < T * 8; i += NGT) { const int t = i >> 3, j = i & 7; const double ang = (double)pos[t] * exp2(-(double)j * (18.931568569324174 / 8.0));
          ct[i] = (float)cos(ang); st[i] = (float)sin(ang); } }
}

namespace pg8 {
struct EpiProj {
    static constexpr bool PERM = true;
    unsigned char* ws; bf16_t* gates; const float* rstd; const float* b_a; const float* cost; const float* sint;
    __device__ __forceinline__ void operator()(const f32x4 (&acc)[2][2][4][2], const Unit& u, int wr, int wc, int fr, int fq) const {
        const int pn = u.pn, row0 = u.pm * BM + wr * 64 + fr, cl0 = wc * 32 + 8 * fq;
        int mode = 0, pitch = 512, cb = 0; unsigned char* dst = nullptr;
        if (pn == 0) { dst = ws + WS_GQ; pitch = 256; }
        else if (pn == 1) { dst = ws + WS_GK; pitch = 256; }
        else if (pn < 4) { dst = ws + WS_GV; cb = (pn - 2) * 256; }
        else if (pn < 6) { dst = ws + WS_SR; cb = (pn - 4) * 256; mode = 1; }
        else if (pn == 6) { dst = ws + WS_LA; pitch = 256; mode = 2; }
        else if (pn < 9) { dst = ws + WS_DQ; cb = (pn - 7) * 256; mode = 3; }
        else if (pn < 11) { dst = ws + WS_DK; cb = (pn - 9) * 256; mode = 3; }
        else if (pn < 13) { dst = ws + WS_DV; cb = (pn - 11) * 256; }
        else { dst = (unsigned char*)gates; pitch = 2048; cb = (pn - 13) * 256; mode = 4; }
#pragma unroll
        for (int ai = 0; ai < 2; ++ai)
#pragma unroll
            for (int m = 0; m < 4; ++m) {
                const int row = row0 + ai * HALF + m * 16; const float rs = rstd[row];
                f32x4 cs0, cs1, sn0, sn1;
                if (mode == 3) { cs0 = *(const f32x4*)(cost + (size_t)row * 8); cs1 = *(const f32x4*)(cost + (size_t)row * 8 + 4); sn0 = *(const f32x4*)(sint + (size_t)row * 8); sn1 = *(const f32x4*)(sint + (size_t)row * 8 + 4); }
#pragma unroll
                for (int bj = 0; bj < 2; ++bj) {
                    f32x4 v0 = acc[ai][bj][m][0] * rs, v1 = acc[ai][bj][m][1] * rs;
                    const int col = cb + bj * HALF + cl0;
                    if (mode == 2) {
                        const f32x4 b0 = *(const f32x4*)(b_a + col), b1 = *(const f32x4*)(b_a + col + 4);
                        v0 = v0 + b0; v1 = v1 + b1;
#pragma unroll
                        for (int i = 0; i < 4; ++i) { float xx = v0[i]; v0[i] = (fminf(xx, 0.f) - __builtin_amdgcn_logf(1.f + __builtin_amdgcn_exp2f(-fabsf(xx) * LOG2E)) * 0.6931471805599453f) * 0.0625f;
                                                      xx = v1[i]; v1[i] = (fminf(xx, 0.f) - __builtin_amdgcn_logf(1.f + __builtin_amdgcn_exp2f(-fabsf(xx) * LOG2E)) * 0.6931471805599453f) * 0.0625f; }
                        float* o = (float*)dst + (size_t)row * pitch + col; *(f32x4*)o = v0; *(f32x4*)(o + 4) = v1;
                        continue;
                    }
                    if (mode == 1) {
#pragma unroll
                        for (int i = 0; i < 4; ++i) { v0[i] = v0[i] * sigmoidf_(v0[i]); v1[i] = v1[i] * sigmoidf_(v1[i]); }
                    } else if (mode == 4) {
#pragma unroll
                        for (int i = 0; i < 4; ++i) { v0[i] = sigmoidf_(v0[i]); v1[i] = sigmoidf_(v1[i]); }
                    } else if (mode == 3) {
                        if ((wc & 1) == 0) {
                            f32x4 p0, p1;
#pragma unroll
                            for (int i = 0; i < 4; ++i) { p0[i] = __shfl_xor(v0[i], 16); p1[i] = __shfl_xor(v1[i], 16); }
                            if (fq == 0) { v0 = v0 * cs0 - p0 * sn0; v1 = v1 * cs1 - p1 * sn1; }
                            else if (fq == 1) { v0 = v0 * cs0 + p0 * sn0; v1 = v1 * cs1 + p1 * sn1; }
                        }
                    }
                    v4u w; w.x = cvt_pk_bf16(v0[0], v0[1]); w.y = cvt_pk_bf16(v0[2], v0[3]); w.z = cvt_pk_bf16(v1[0], v1[1]); w.w = cvt_pk_bf16(v1[2], v1[3]);
                    *(v4u*)((bf16_t*)dst + (size_t)row * pitch + col) = w;
                }
            }
    }
};
struct EpiPle {
    static constexpr bool PERM = true;
    bf16_t* er; float* sse;
    __device__ __forceinline__ void operator()(const f32x4 (&acc)[2][2][4][2], const Unit& u, int wr, int wc, int fr, int fq) const {
        const int row0 = u.pm * BM + wr * 64 + fr, col0 = u.pn * BM + wc * 32 + 8 * fq;
#pragma unroll
        for (int ai = 0; ai < 2; ++ai)
#pragma unroll
            for (int m = 0; m < 4; ++m) { const int row = row0 + ai * HALF + m * 16; float s = 0.f;
#pragma unroll
                for (int bj = 0; bj < 2; ++bj) { const f32x4 v0 = acc[ai][bj][m][0], v1 = acc[ai][bj][m][1];
                    s += (v0[0] * v0[0] + v0[1] * v0[1]) + (v0[2] * v0[2] + v0[3] * v0[3]) + (v1[0] * v1[0] + v1[1] * v1[1]) + (v1[2] * v1[2] + v1[3] * v1[3]);
                    v4u w; w.x = cvt_pk_bf16(v0[0], v0[1]); w.y = cvt_pk_bf16(v0[2], v0[3]); w.z = cvt_pk_bf16(v1[0], v1[1]); w.w = cvt_pk_bf16(v1[2], v1[3]);
                    *(v4u*)(er + (size_t)row * DM + col0 + bj * HALF) = w; }
                s += __shfl_xor(s, 16); s += __shfl_xor(s, 32);
                if (fq == 0) atomicAdd(sse + row, s); }
    }
};
}

namespace da {
constexpr int NW = 8, QBLK = 32, KVBLK = 64, QB = 128, PITCH = 512;
constexpr int SHM_V = KVBLK * 128 * 2, SHM_K = KVBLK * 128 * 2;
constexpr int OFF_WS = 2 * SHM_V + 2 * SHM_K, OFF_EX = OFF_WS + NW * 64 * 4, LDS_NEED = OFF_EX + 4 * 32 * 128 * 4;
constexpr float THRL = 11.5f;
#define KSWZ(row, colB) ((row) * 256 + ((colB) ^ (((row) & 7) << 4)))
#define SBAR() __builtin_amdgcn_sched_barrier(0)
__device__ __forceinline__ int v_st(int k, int c) { const int kk = (k & ~0xC) | ((k & 4) << 1) | ((k & 8) >> 1); return ((kk >> 3) * 4 + (c >> 5)) * 512 + ((kk & 7) * 32 + (c & 31)) * 2; }
__device__ __forceinline__ int v_rd_base(int lane) { return ((lane & 3) << 3) | (((lane >> 2) & 3) << 6) | (((lane >> 4) & 1) << 5) | (((lane >> 5) & 1) << 8); }
constexpr int v_rd_off(int d0, int ks, int half) { return d0 * 512 + ks * 4096 + half * 2048; }
__device__ __forceinline__ int crow(int r, int hi) { return (r & 3) + 8 * (r >> 2) + 4 * hi; }
__device__ __forceinline__ void mask_tile(f32x16& p0, f32x16& p1, int dq) {
    const float NEG = -__builtin_inff();
#pragma unroll
    for (int r = 0; r < 16; ++r) { const int c = (r & 3) + 8 * (r >> 2); if (dq - c < 0) p0[r] = NEG; if (dq - c - 32 < 0) p1[r] = NEG; }
}
__device__ __forceinline__ void partialSM(f32x16& p0, f32x16& p1, float& m_reg, float& mn, float& alpha) {
    float pmax = p0[0];
#pragma unroll
    for (int r = 1; r < 16; ++r) pmax = fmaxf(pmax, p0[r]);
#pragma unroll
    for (int r = 0; r < 16; ++r) pmax = fmaxf(pmax, p1[r]);
    { auto rr = __builtin_amdgcn_permlane32_swap(__float_as_uint(pmax), __float_as_uint(pmax), false, false); pmax = fmaxf(__uint_as_float(rr[0]), __uint_as_float(rr[1])); }
    if (__builtin_expect(__all((pmax - m_reg) <= THRL), 1)) { mn = m_reg; alpha = 1.f; }
    else { mn = fmaxf(m_reg, pmax); alpha = __builtin_amdgcn_exp2f(m_reg - mn); m_reg = mn; }
#pragma unroll
    for (int r = 0; r < 16; ++r) { p0[r] = p0[r] - mn; p1[r] = p1[r] - mn; }
#pragma unroll
    for (int r = 0; r < 16; ++r) p0[r] = __builtin_amdgcn_exp2f(p0[r]);
}
__device__ __forceinline__ void finishSM(f32x16& p0, f32x16& p1, float alpha, float& l_reg, bf16x8& pa0, bf16x8& pa1, bf16x8& pa2, bf16x8& pa3) {
#pragma unroll
    for (int r = 0; r < 16; ++r) p1[r] = __builtin_amdgcn_exp2f(p1[r]);
    float ps = 0;
#pragma unroll
    for (int r = 0; r < 16; ++r) ps += p0[r];
#pragma unroll
    for (int r = 0; r < 16; ++r) ps += p1[r];
    { auto rr = __builtin_amdgcn_permlane32_swap(__float_as_uint(ps), __float_as_uint(ps), false, false); ps = __uint_as_float(rr[0]) + __uint_as_float(rr[1]); }
    l_reg = l_reg * alpha + ps;
#define PK4(P, B_, OUT) do { unsigned a0 = cvt_pk_bf16(P[B_+0], P[B_+1]), a1 = cvt_pk_bf16(P[B_+2], P[B_+3]); unsigned b0 = cvt_pk_bf16(P[B_+4], P[B_+5]), b1 = cvt_pk_bf16(P[B_+6], P[B_+7]); \
        auto r0 = __builtin_amdgcn_permlane32_swap(a0, b0, false, false); auto r1 = __builtin_amdgcn_permlane32_swap(a1, b1, false, false); \
        v4u w = {r0[0], r1[0], r0[1], r1[1]}; OUT = *reinterpret_cast<bf16x8*>(&w); } while (0)
    PK4(p0, 0, pa0); PK4(p0, 8, pa1); PK4(p1, 0, pa2); PK4(p1, 8, pa3);
#undef PK4
}
template <int KB>
__device__ __forceinline__ void qkt(f32x16& p0, f32x16& p1, const char* K_lds, int r32, int hi, int comp, const bf16x8* qr) {
    p0 = f32x16{}; p1 = f32x16{};
#pragma unroll
    for (int dd = 0; dd < 4; ++dd) { const char* a = K_lds + KB * SHM_K + KSWZ(r32, (dd * 16 + hi * 8) * 2) + comp * 128;
        bf16x8 b0 = *reinterpret_cast<const bf16x8*>(a);
        bf16x8 b1 = *reinterpret_cast<const bf16x8*>(a + 32 * 256);
        p0 = __builtin_amdgcn_mfma_f32_32x32x16_bf16(b0, qr[dd], p0, 0, 0, 0);
        p1 = __builtin_amdgcn_mfma_f32_32x32x16_bf16(b1, qr[dd], p1, 0, 0, 0); }
}
template <int VB>
__device__ __forceinline__ void pv_tile(f32x16* o, int vb0, bf16x8 pa0, bf16x8 pa1, bf16x8 pa2, bf16x8 pa3) {
#define TRRD(dst, off) asm volatile("ds_read_b64_tr_b16 %0, %1 offset:%2" : "=&v"(dst) : "v"(vb0), "i"(off) : "memory")
#define PV_D0(d0) do { s16x4 l0, l1, l2, l3, h0, h1, h2, h3; constexpr int b_ = VB * SHM_V + v_rd_off(d0, 0, 0); \
        TRRD(l0, b_); TRRD(h0, b_ + 2048); TRRD(l1, b_ + 4096); TRRD(h1, b_ + 6144); TRRD(l2, b_ + 8192); TRRD(h2, b_ + 10240); TRRD(l3, b_ + 12288); TRRD(h3, b_ + 14336); \
        asm volatile("s_waitcnt lgkmcnt(0)" ::: "memory"); SBAR(); \
        o[d0] = __builtin_amdgcn_mfma_f32_32x32x16_bf16(pa0, (bf16x8){l0[0], l0[1], l0[2], l0[3], h0[0], h0[1], h0[2], h0[3]}, o[d0], 0, 0, 0); \
        o[d0] = __builtin_amdgcn_mfma_f32_32x32x16_bf16(pa1, (bf16x8){l1[0], l1[1], l1[2], l1[3], h1[0], h1[1], h1[2], h1[3]}, o[d0], 0, 0, 0); \
        o[d0] = __builtin_amdgcn_mfma_f32_32x32x16_bf16(pa2, (bf16x8){l2[0], l2[1], l2[2], l2[3], h2[0], h2[1], h2[2], h2[3]}, o[d0], 0, 0, 0); \
        o[d0] = __builtin_amdgcn_mfma_f32_32x32x16_bf16(pa3, (bf16x8){l3[0], l3[1], l3[2], l3[3], h3[0], h3[1], h3[2], h3[3]}, o[d0], 0, 0, 0); } while (0)
    PV_D0(0); PV_D0(1); PV_D0(2); PV_D0(3);
#undef PV_D0
#undef TRRD
}
__device__ __forceinline__ void attn_unit(const bf16_t* Qg, const bf16_t* Kg, const bf16_t* Vg, bf16_t* Og, int P0, float lam, const float* subln, char* lds) {
    int tid = threadIdx.x; asm volatile("" : "+v"(tid));
    const int wid = __builtin_amdgcn_readfirstlane(tid >> 6), lane = tid & 63, r32 = lane & 31, hi = lane >> 5;
    const int comp = wid & 1, rg = wid >> 1;
    const int NT = (P0 + QB - 1) / KVBLK + 1;
    const int qlo = P0 + rg * QBLK, qm = qlo + r32 - 4 * hi;
    char* V_lds = lds; char* K_lds = lds + 2 * SHM_V;
    float* wsf = (float*)(lds + OFF_WS) + wid * 64; float* li_l = wsf, * al_l = wsf + 32;
    float* exch = (float*)(lds + OFF_EX) + rg * (32 * 128);
    float m_reg = -1e30f, l_reg = 0; f32x16 o[4] = {};
    const int sr = tid >> 4, sc = (tid & 15) * 8, vst0 = v_st(sr, sc), vst1 = v_st(32 + sr, sc), kws = KSWZ(sr, sc * 2);
    const int vb0 = (int)(uintptr_t)V_lds + v_rd_base(lane);
    bf16x8 st_v0, st_v1, st_k0, st_k1;
#define ROW(p, k0, rr) ((p) + (size_t)((k0) + (rr)) * PITCH + sc)
#define LD8(p) (*reinterpret_cast<const bf16x8*>(p))
#define SLOAD_H(k0) do { st_v0 = LD8(ROW(Vg, k0, sr)); st_v1 = LD8(ROW(Vg, k0, 32 + sr)); st_k0 = LD8(ROW(Kg, k0, sr)); st_k1 = LD8(ROW(Kg, k0, 32 + sr)); } while (0)
#define SWRITE_HK(bf) do { *(bf16x8*)(K_lds + (bf) * SHM_K + kws) = st_k0; *(bf16x8*)(K_lds + (bf) * SHM_K + kws + 32 * 256) = st_k1; } while (0)
#define SWRITE_HV(bf) do { *(bf16x8*)(V_lds + (bf) * SHM_V + vst0) = st_v0; *(bf16x8*)(V_lds + (bf) * SHM_V + vst1) = st_v1; } while (0)
#define VMW() asm volatile("s_waitcnt vmcnt(0)" ::: "memory")
    bf16x8 qr[4];
#pragma unroll
    for (int dd = 0; dd < 4; ++dd) qr[dd] = LD8(Qg + (size_t)(qlo + r32) * PITCH + comp * 64 + dd * 16 + hi * 8);
    SLOAD_H(0); VMW(); SWRITE_HK(0); SWRITE_HV(0); SBAR();
    SLOAD_H(KVBLK);
    __syncthreads();
#define RESC(a) do { if (__any((a) < 1.f)) { if (hi == 0) al_l[r32] = (a); asm volatile("s_waitcnt lgkmcnt(0)" ::: "memory"); \
                     _Pragma("unroll") for (int d_ = 0; d_ < 4; ++d_) _Pragma("unroll") for (int r = 0; r < 16; ++r) o[d_][r] *= al_l[crow(r, hi)]; } } while (0)
#define KBASE(t) ((t) * KVBLK)
#define MASKT(P0_, P1_, t) do { const int kb_ = KBASE(t); if (kb_ + KVBLK - 1 > qlo) mask_tile(P0_, P1_, qm - kb_); } while (0)
    f32x16 pA0, pA1, pB0, pB1; float mnA, mnB, alA, alB; bf16x8 pa0, pa1, pa2, pa3;
    SBAR(); qkt<0>(pA0, pA1, K_lds, r32, hi, comp, qr);
    MASKT(pA0, pA1, 0); partialSM(pA0, pA1, m_reg, mnA, alA);
    VMW(); SWRITE_HK(1); SWRITE_HV(1);
    __syncthreads();
#define HALF_STEP(PX0, PX1, mnX, alX, PY0, PY1, alY, t, KB, VB, SB) do { \
        SBAR(); qkt<KB>(PX0, PX1, K_lds, r32, hi, comp, qr); \
        finishSM(PY0, PY1, alY, l_reg, pa0, pa1, pa2, pa3); SBAR(); \
        if ((t) + 1 < NT) { SLOAD_H(KBASE((t) + 1)); SBAR(); } \
        pv_tile<VB>(o, vb0, pa0, pa1, pa2, pa3); MASKT(PX0, PX1, (t)); partialSM(PX0, PX1, m_reg, mnX, alX); \
        __syncthreads(); \
        if ((t) + 1 < NT) { VMW(); SWRITE_HK(SB); SWRITE_HV(SB); } \
        RESC(alX); __syncthreads(); } while (0)
    for (int t = 1; t + 1 < NT; t += 2) {
        HALF_STEP(pB0, pB1, mnB, alB, pA0, pA1, alA, t, 1, 0, 0);
        HALF_STEP(pA0, pA1, mnA, alA, pB0, pB1, alB, t + 1, 0, 1, 1);
    }
    SBAR(); qkt<1>(pB0, pB1, K_lds, r32, hi, comp, qr); SBAR();
    finishSM(pA0, pA1, alA, l_reg, pa0, pa1, pa2, pa3); SBAR();
    pv_tile<0>(o, vb0, pa0, pa1, pa2, pa3);
    MASKT(pB0, pB1, NT - 1); partialSM(pB0, pB1, m_reg, mnB, alB); __syncthreads(); RESC(alB);
    finishSM(pB0, pB1, alB, l_reg, pa0, pa1, pa2, pa3); SBAR(); pv_tile<1>(o, vb0, pa0, pa1, pa2, pa3);
    if (hi == 0) li_l[r32] = l_reg; asm volatile("s_waitcnt lgkmcnt(0)" ::: "memory");
    float rli[16];
#pragma unroll
    for (int r = 0; r < 16; ++r) rli[r] = __builtin_amdgcn_rcpf(li_l[crow(r, hi)]);
    if (comp == 1) {
#pragma unroll
        for (int r = 0; r < 16; ++r) { const float f = rli[r] * lam;
#pragma unroll
            for (int d0 = 0; d0 < 4; ++d0) exch[crow(r, hi) * 128 + d0 * 32 + r32] = o[d0][r] * f; }
    }
    __syncthreads();
    if (comp == 0) {
        float gsc[4];
#pragma unroll
        for (int d0 = 0; d0 < 4; ++d0) gsc[d0] = subln[d0 * 32 + r32] * (1.f - LAMBDA_INIT);
#pragma unroll
        for (int r = 0; r < 16; ++r) { const int orow = crow(r, hi); float v[4]; float s = 0.f;
#pragma unroll
            for (int d0 = 0; d0 < 4; ++d0) { v[d0] = o[d0][r] * rli[r] - exch[orow * 128 + d0 * 32 + r32]; s += v[d0] * v[d0]; }
            s += __shfl_xor(s, 1); s += __shfl_xor(s, 2); s += __shfl_xor(s, 4); s += __shfl_xor(s, 8); s += __shfl_xor(s, 16);
            const float rs = 1.0f / sqrtf(s * (1.f / 128.f) + EPS);
#pragma unroll
            for (int d0 = 0; d0 < 4; ++d0) { const float w = v[d0] * rs * gsc[d0]; const float wn = __shfl_xor(w, 1);
                if ((r32 & 1) == 0) *(unsigned*)(Og + (size_t)(qlo + orow) * PITCH + d0 * 32 + r32) = cvt_pk_bf16(w, wn); } }
    }
    __syncthreads();
#undef ROW
#undef LD8
#undef SLOAD_H
#undef SWRITE_HK
#undef SWRITE_HV
#undef VMW
#undef RESC
#undef KBASE
#undef MASKT
#undef HALF_STEP
}
#undef KSWZ
#undef SBAR
}

namespace gla {
constexpr int PT = 144;
constexpr int L_QD = 0, L_KI = 9216, L_KIT = 18432, L_VT = 27648, L_SBT = 46080, L_ATT = 64512, L_DEC = 73728, LDS_NEED = 73984;
__device__ __forceinline__ float wave_scan(float x, int lane) {
#pragma unroll
    for (int off = 1; off < 64; off <<= 1) { const float y = __shfl_up(x, off); if (lane >= off) x += y; }
    return x;
}
__device__ __forceinline__ void gla_item(int b, int h, const bf16_t* gq, const bf16_t* gk, const bf16_t* gv, const bf16_t* sr, const float* la, const float* gnorm, bf16_t* oa, LAS unsigned char* lds) {
    int tid = threadIdx.x; asm volatile("" : "+v"(tid));
    const int w = __builtin_amdgcn_readfirstlane(tid >> 6), lane = tid & 63, l15 = lane & 15, lq = lane >> 4;
    const size_t tok0 = (size_t)b * SEQ;
    const bf16_t* qp = gq + (tok0 + lane) * 256 + h * 64 + 8 * w;
    const bf16_t* kp = gk + (tok0 + lane) * 256 + h * 64 + 8 * w;
    const float* lp = la + (tok0 + lane) * 256 + h * 64 + 8 * w;
    const bf16_t* vp = gv + (tok0 + lane) * 512 + h * 128 + 16 * w;
    f32x4 la0 = *(const f32x4*)lp, la1 = *(const f32x4*)(lp + 4);
    v4u q8 = *(const v4u*)qp, k8 = *(const v4u*)kp, v8a = *(const v4u*)vp, v8b = *(const v4u*)(vp + 8);
    f32x4 S[4][2];
#pragma unroll
    for (int i = 0; i < 4; ++i) { S[i][0] = (f32x4){0.f, 0.f, 0.f, 0.f}; S[i][1] = (f32x4){0.f, 0.f, 0.f, 0.f}; }
    const int sw = w - 4;
    for (int n = 0; n < SEQ / 64; ++n) {
        float bb[8] = {la0[0], la0[1], la0[2], la0[3], la1[0], la1[1], la1[2], la1[3]};
        unsigned qd[4], ki[4];
#pragma unroll
        for (int j = 0; j < 8; j += 2) {
            const float b0 = wave_scan(bb[j], lane), b1 = wave_scan(bb[j + 1], lane);
            const float e0 = __builtin_amdgcn_exp2f(b0 * LOG2E), e1 = __builtin_amdgcn_exp2f(b1 * LOG2E);
            const float i0 = __builtin_amdgcn_rcpf(e0), i1 = __builtin_amdgcn_rcpf(e1);
            const unsigned qw = q8[j >> 1], kw = k8[j >> 1];
            qd[j >> 1] = cvt_pk_bf16(bf_lo(qw) * e0, bf_hi(qw) * e1);
            ki[j >> 1] = cvt_pk_bf16(bf_lo(kw) * i0, bf_hi(kw) * i1);
            const float d0 = __shfl(e0, 63), d1 = __shfl(e1, 63);
            if (lane == 0) { *(LAS float*)(lds + L_DEC + (8 * w + j) * 4) = d0; *(LAS float*)(lds + L_DEC + (8 * w + j + 1) * 4) = d1; }
            *(LAS unsigned short*)(lds + L_KIT + (8 * w + j) * PT + lane * 2) = (unsigned short)(ki[j >> 1] & 0xffffu);
            *(LAS unsigned short*)(lds + L_KIT + (8 * w + j + 1) * PT + lane * 2) = (unsigned short)(ki[j >> 1] >> 16);
        }
        *(LAS v4u*)(lds + L_QD + lane * PT + 16 * w) = (v4u){qd[0], qd[1], qd[2], qd[3]};
        *(LAS v4u*)(lds + L_KI + lane * PT + 16 * w) = (v4u){ki[0], ki[1], ki[2], ki[3]};
#pragma unroll
        for (int i = 0; i < 4; ++i) {
            *(LAS unsigned short*)(lds + L_VT + (16 * w + 2 * i) * PT + lane * 2) = (unsigned short)(v8a[i] & 0xffffu);
            *(LAS unsigned short*)(lds + L_VT + (16 * w + 2 * i + 1) * PT + lane * 2) = (unsigned short)(v8a[i] >> 16);
            *(LAS unsigned short*)(lds + L_VT + (16 * w + 8 + 2 * i) * PT + lane * 2) = (unsigned short)(v8b[i] & 0xffffu);
            *(LAS unsigned short*)(lds + L_VT + (16 * w + 8 + 2 * i + 1) * PT + lane * 2) = (unsigned short)(v8b[i] >> 16);
        }
        if (w >= 4) {
#pragma unroll
            for (int db = 0; db < 4; ++db)
#pragma unroll
                for (int vb = 0; vb < 2; ++vb) { v2u o; o.x = cvt_pk_bf16(S[db][vb][0], S[db][vb][1]); o.y = cvt_pk_bf16(S[db][vb][2], S[db][vb][3]);
                    *(LAS v2u*)(lds + L_SBT + (32 * sw + 16 * vb + l15) * PT + (16 * db + 4 * lq) * 2) = o; }
        }
        __syncthreads();
        { const size_t adv = (n + 1 < SEQ / 64) ? (size_t)(n + 1) * 64 : (size_t)n * 64;
          la0 = *(const f32x4*)(lp + adv * 256); la1 = *(const f32x4*)(lp + adv * 256 + 4);
          q8 = *(const v4u*)(qp + adv * 256); k8 = *(const v4u*)(kp + adv * 256); v8a = *(const v4u*)(vp + adv * 512); v8b = *(const v4u*)(vp + adv * 512 + 8); }
        if (w < 4) {
            bf16x8 qf[2];
#pragma unroll
            for (int ks = 0; ks < 2; ++ks) qf[ks] = *(const LAS bf16x8*)(lds + L_QD + (16 * w + l15) * PT + (32 * ks + 8 * lq) * 2);
            const int c = 16 * w + l15;
#pragma unroll
            for (int sb = 0; sb < 4; ++sb) {
                f32x4 a = (f32x4){0.f, 0.f, 0.f, 0.f};
#pragma unroll
                for (int ks = 0; ks < 2; ++ks) { const bf16x8 kf = *(const LAS bf16x8*)(lds + L_KI + (16 * sb + l15) * PT + (32 * ks + 8 * lq) * 2);
                    a = __builtin_amdgcn_mfma_f32_16x16x32_bf16(kf, qf[ks], a, 0, 0, 0); }
#pragma unroll
                for (int r = 0; r < 4; ++r) if (16 * sb + 4 * lq + r > c) a[r] = 0.f;
                v2u o; o.x = cvt_pk_bf16(a[0], a[1]); o.y = cvt_pk_bf16(a[2], a[3]);
                *(LAS v2u*)(lds + L_ATT + w * 2304 + l15 * PT + (16 * sb + 4 * lq) * 2) = o;
            }
            asm volatile("s_waitcnt lgkmcnt(0)" ::: "memory");
            bf16x8 af[2];
#pragma unroll
            for (int ks = 0; ks < 2; ++ks) af[ks] = *(const LAS bf16x8*)(lds + L_ATT + w * 2304 + l15 * PT + (32 * ks + 8 * lq) * 2);
            f32x4 o[8]; float ssq = 0.f;
#pragma unroll
            for (int vb = 0; vb < 8; ++vb) {
                f32x4 a = (f32x4){0.f, 0.f, 0.f, 0.f};
#pragma unroll
                for (int ks = 0; ks < 2; ++ks) { const bf16x8 vf = *(const LAS bf16x8*)(lds + L_VT + (16 * vb + l15) * PT + (32 * ks + 8 * lq) * 2);
                    a = __builtin_amdgcn_mfma_f32_16x16x32_bf16(vf, af[ks], a, 0, 0, 0); }
#pragma unroll
                for (int ks = 0; ks < 2; ++ks) { const bf16x8 sf = *(const LAS bf16x8*)(lds + L_SBT + (16 * vb + l15) * PT + (32 * ks + 8 * lq) * 2);
                    a = __builtin_amdgcn_mfma_f32_16x16x32_bf16(sf, qf[ks], a, 0, 0, 0); }
                o[vb] = a; ssq += (a[0] * a[0] + a[1] * a[1]) + (a[2] * a[2] + a[3] * a[3]);
            }
            ssq += __shfl_xor(ssq, 16); ssq += __shfl_xor(ssq, 32);
            const float rs = 1.0f / sqrtf(ssq * (1.f / 128.f) + EPS);
            const size_t tok = tok0 + (size_t)n * 64 + c;
#pragma unroll
            for (int vb = 0; vb < 8; ++vb) { const int v = 16 * vb + 4 * lq;
                const f32x4 g = *(const f32x4*)(gnorm + v); const v2u r = *(const v2u*)(sr + tok * 512 + h * 128 + v);
                v2u w2; w2.x = cvt_pk_bf16(o[vb][0] * rs * g[0] * bf_lo(r.x), o[vb][1] * rs * g[1] * bf_hi(r.x));
                w2.y = cvt_pk_bf16(o[vb][2] * rs * g[2] * bf_lo(r.y), o[vb][3] * rs * g[3] * bf_hi(r.y));
                *(v2u*)(oa + tok * 512 + h * 128 + v) = w2; }
        } else {
#pragma unroll
            for (int ks = 0; ks < 2; ++ks) {
                bf16x8 vf[2];
#pragma unroll
                for (int vb = 0; vb < 2; ++vb) vf[vb] = *(const LAS bf16x8*)(lds + L_VT + (32 * sw + 16 * vb + l15) * PT + (32 * ks + 8 * lq) * 2);
#pragma unroll
                for (int db = 0; db < 4; ++db) { const bf16x8 kf = *(const LAS bf16x8*)(lds + L_KIT + (16 * db + l15) * PT + (32 * ks + 8 * lq) * 2);
#pragma unroll
                    for (int vb = 0; vb < 2; ++vb) S[db][vb] = __builtin_amdgcn_mfma_f32_16x16x32_bf16(kf, vf[vb], S[db][vb], 0, 0, 0); }
            }
#pragma unroll
            for (int db = 0; db < 4; ++db) { const f32x4 dc = *(const LAS f32x4*)(lds + L_DEC + (16 * db + 4 * lq) * 4); S[db][0] = S[db][0] * dc; S[db][1] = S[db][1] * dc; }
        }
        __syncthreads();
    }
}
}

namespace pg8 {
struct BranchOrder {
    StaticOrder so;
    __device__ __forceinline__ bool next(int i, Unit& u) const { Unit t; if (!so.next(i >> 1, t)) return false; u.pm = t.pm + (i & 1) * 128; u.pn = t.pn + (i & 1) * 4; return true; }
    __device__ __forceinline__ unsigned arow(const Unit&, int) const { return 0u; }
};
struct EpiBranch {
    static constexpr bool PERM = true;
    const bf16_t* gates; bf16_t* mg;
    __device__ __forceinline__ void operator()(const f32x4 (&acc)[2][2][4][2], const Unit& u, int wr, int wc, int fr, int fq) const {
        const bool isb = u.pm >= 128; const int pm = isb ? u.pm - 128 : u.pm, pn = isb ? u.pn - 4 : u.pn;
        const int row0 = pm * BM + wr * 64 + fr, col0 = pn * BM + wc * 32 + 8 * fq;
#pragma unroll
        for (int ai = 0; ai < 2; ++ai)
#pragma unroll
            for (int m = 0; m < 4; ++m) { const int row = row0 + ai * HALF + m * 16;
#pragma unroll
                for (int bj = 0; bj < 2; ++bj) { const int col = col0 + bj * HALF;
                    const v4u g = *(const v4u*)(gates + (size_t)row * 2048 + (isb ? 1024 : 0) + col);
                    const f32x4 a0 = acc[ai][bj][m][0], a1 = acc[ai][bj][m][1];
                    float r0 = a0[0] * bf_lo(g.x), r1 = a0[1] * bf_hi(g.x), r2 = a0[2] * bf_lo(g.y), r3 = a0[3] * bf_hi(g.y);
                    float r4 = a1[0] * bf_lo(g.z), r5 = a1[1] * bf_hi(g.z), r6 = a1[2] * bf_lo(g.w), r7 = a1[3] * bf_hi(g.w);
                    bf16_t* dst = mg + (size_t)row * DM + col;
                    if (isb) { const v4u p = *(const v4u*)dst; r0 += bf_lo(p.x); r1 += bf_hi(p.x); r2 += bf_lo(p.y); r3 += bf_hi(p.y); r4 += bf_lo(p.z); r5 += bf_hi(p.z); r6 += bf_lo(p.w); r7 += bf_hi(p.w); }
                    v4u w; w.x = cvt_pk_bf16(r0, r1); w.y = cvt_pk_bf16(r2, r3); w.z = cvt_pk_bf16(r4, r5); w.w = cvt_pk_bf16(r6, r7);
                    *(v4u*)dst = w; } }
    }
};
struct EpiOut {
    static constexpr bool PERM = true;
    const float* x; bf16_t* hb; float* ss;
    __device__ __forceinline__ void operator()(const f32x4 (&acc)[2][2][4][2], const Unit& u, int wr, int wc, int fr, int fq) const {
        const int row0 = u.pm * BM + wr * 64 + fr, col0 = u.pn * BM + wc * 32 + 8 * fq;
#pragma unroll
        for (int ai = 0; ai < 2; ++ai)
#pragma unroll
            for (int m = 0; m < 4; ++m) { const int row = row0 + ai * HALF + m * 16; float s = 0.f;
#pragma unroll
                for (int bj = 0; bj < 2; ++bj) { const size_t off = (size_t)row * DM + col0 + bj * HALF;
                    const f32x4 v0 = acc[ai][bj][m][0] + *(const f32x4*)(x + off), v1 = acc[ai][bj][m][1] + *(const f32x4*)(x + off + 4);
                    s += (v0[0] * v0[0] + v0[1] * v0[1]) + (v0[2] * v0[2] + v0[3] * v0[3]) + (v1[0] * v1[0] + v1[1] * v1[1]) + (v1[2] * v1[2] + v1[3] * v1[3]);
                    v4u w; w.x = cvt_pk_bf16(v0[0], v0[1]); w.y = cvt_pk_bf16(v0[2], v0[3]); w.z = cvt_pk_bf16(v1[0], v1[1]); w.w = cvt_pk_bf16(v1[2], v1[3]);
                    *(v4u*)(hb + off) = w; }
                s += __shfl_xor(s, 16); s += __shfl_xor(s, 32);
                if (fq == 0) atomicAdd(ss + row, s); }
    }
};
template <int npn> struct MoeOrder {
    const LAS int* ts; const LAS int* cnt; const int* list; int G, c;
    __device__ __forceinline__ int expert_of(int tile) const { int e = 0;
#pragma unroll 1
        for (int i = 1; i < NEXP; ++i) if (ts[i] <= tile) e = i; return e; }
    __device__ __forceinline__ bool next(int i, Unit& u) const {
        const int L = i * G + c, total = ts[NEXP] * npn; if (L >= total) return false;
        const int tile = L / npn, pl = L % npn; u.pm = tile; u.pn = expert_of(tile) * npn + pl; return true; }
    __device__ __forceinline__ int entry(const Unit& u, int r) const { const int e = u.pn / npn, pos = (u.pm - ts[e]) * BM + r; return pos < cnt[e] ? list[(size_t)e * T + pos] : -1; }
    __device__ __forceinline__ unsigned arow(const Unit& u, int r) const { const int en = entry(u, r); return en < 0 ? 0u : (unsigned)(en >> 1); }
};
struct EpiUp {
    static constexpr bool PERM = true;
    MoeOrder<2> mo; const float* ss2; bf16_t* he;
    __device__ __forceinline__ void operator()(const f32x4 (&acc)[2][2][4][2], const Unit& u, int wr, int wc, int fr, int fq) const {
        const int pl = u.pn & 1, col0 = pl * 128 + wc * 32 + 8 * fq;
#pragma unroll
        for (int ai = 0; ai < 2; ++ai)
#pragma unroll
            for (int m = 0; m < 4; ++m) { const int r = ai * HALF + wr * 64 + m * 16 + fr; const int en = mo.entry(u, r);
                const float rs = en < 0 ? 0.f : 1.0f / sqrtf(ss2[en >> 1] * (1.f / DM) + EPS);
                const f32x4 g0 = acc[ai][0][m][0] * rs, g1 = acc[ai][0][m][1] * rs, u0 = acc[ai][1][m][0] * rs, u1 = acc[ai][1][m][1] * rs;
                v4u w; w.x = cvt_pk_bf16(g0[0] * sigmoidf_(g0[0]) * u0[0], g0[1] * sigmoidf_(g0[1]) * u0[1]); w.y = cvt_pk_bf16(g0[2] * sigmoidf_(g0[2]) * u0[2], g0[3] * sigmoidf_(g0[3]) * u0[3]);
                w.z = cvt_pk_bf16(g1[0] * sigmoidf_(g1[0]) * u1[0], g1[1] * sigmoidf_(g1[1]) * u1[1]); w.w = cvt_pk_bf16(g1[2] * sigmoidf_(g1[2]) * u1[2], g1[3] * sigmoidf_(g1[3]) * u1[3]);
                *(v4u*)(he + (size_t)(u.pm * BM + r) * DEXP + col0) = w; }
    }
};
struct EpiDown {
    static constexpr bool PERM = true;
    MoeOrder<4> mo; const float* tokw; bf16_t* yb;
    __device__ __forceinline__ void operator()(const f32x4 (&acc)[2][2][4][2], const Unit& u, int wr, int wc, int fr, int fq) const {
        const int col0 = (u.pn & 3) * BM + wc * 32 + 8 * fq;
#pragma unroll
        for (int ai = 0; ai < 2; ++ai)
#pragma unroll
            for (int m = 0; m < 4; ++m) { const int r = ai * HALF + wr * 64 + m * 16 + fr; const int en = mo.entry(u, r);
                if (en >= 0) { const float wt = tokw[en];
#pragma unroll
                    for (int bj = 0; bj < 2; ++bj) { const f32x4 v0 = acc[ai][bj][m][0] * wt, v1 = acc[ai][bj][m][1] * wt;
                        v4u w; w.x = cvt_pk_bf16(v0[0], v0[1]); w.y = cvt_pk_bf16(v0[2], v0[3]); w.z = cvt_pk_bf16(v1[0], v1[1]); w.w = cvt_pk_bf16(v1[2], v1[3]);
                        *(v4u*)(yb + (size_t)en * DM + col0 + bj * HALF) = w; } } }
    }
};
struct EpiFinal {
    static constexpr bool PERM = true;
    const bf16_t* h2b; const bf16_t* er; const float* sse; const float* gple; float* out; float* ssf;
    __device__ __forceinline__ void operator()(const f32x4 (&acc)[2][2][4][2], const Unit& u, int wr, int wc, int fr, int fq) const {
        const int row0 = u.pm * BM + wr * 64 + fr, col0 = u.pn * BM + wc * 32 + 8 * fq;
#pragma unroll
        for (int ai = 0; ai < 2; ++ai)
#pragma unroll
            for (int m = 0; m < 4; ++m) { const int row = row0 + ai * HALF + m * 16; float s = 0.f; const float re = 1.0f / sqrtf(sse[row] * (1.f / DM) + EPS);
#pragma unroll
                for (int bj = 0; bj < 2; ++bj) { const int col = col0 + bj * HALF; const size_t off = (size_t)row * DM + col;
                    const v4u hh = *(const v4u*)(h2b + off), ee = *(const v4u*)(er + off); const f32x4 g0 = *(const f32x4*)(gple + col) * re, g1 = *(const f32x4*)(gple + col + 4) * re;
                    const f32x4 a0 = acc[ai][bj][m][0], a1 = acc[ai][bj][m][1]; f32x4 v0, v1;
                    v0[0] = bf_lo(hh.x) + sigmoidf_(a0[0]) * bf_lo(ee.x) * g0[0]; v0[1] = bf_hi(hh.x) + sigmoidf_(a0[1]) * bf_hi(ee.x) * g0[1];
                    v0[2] = bf_lo(hh.y) + sigmoidf_(a0[2]) * bf_lo(ee.y) * g0[2]; v0[3] = bf_hi(hh.y) + sigmoidf_(a0[3]) * bf_hi(ee.y) * g0[3];
                    v1[0] = bf_lo(hh.z) + sigmoidf_(a1[0]) * bf_lo(ee.z) * g1[0]; v1[1] = bf_hi(hh.z) + sigmoidf_(a1[1]) * bf_hi(ee.z) * g1[1];
                    v1[2] = bf_lo(hh.w) + sigmoidf_(a1[2]) * bf_lo(ee.w) * g1[2]; v1[3] = bf_hi(hh.w) + sigmoidf_(a1[3]) * bf_hi(ee.w) * g1[3];
                    s += (v0[0] * v0[0] + v0[1] * v0[1]) + (v0[2] * v0[2] + v0[3] * v0[3]) + (v1[0] * v1[0] + v1[1] * v1[1]) + (v1[2] * v1[2] + v1[3] * v1[3]);
                    *(f32x4*)(out + off) = v0; *(f32x4*)(out + off + 4) = v1; }
                s += __shfl_xor(s, 16); s += __shfl_xor(s, 32);
                if (fq == 0) atomicAdd(ssf + row, s); }
    }
};
}

constexpr int WR_PT = 2064;
__device__ __forceinline__ void p4_router(const Frame& F, const Params& P) {
    unsigned char* ws = PWS(); unsigned* ctl = (unsigned*)(ws + WS_CTL);
    const bf16_t* hb = (const bf16_t*)(ws + WS_XB); const bf16_t* Wr = (const bf16_t*)(ws + WS_WR); const float* ss2 = (const float*)(ctl + CW_SS2);
    const float* b_rg = PIN(18); const float* b_re = PIN(20);
    int* toke = (int*)(ws + WS_TOKE); float* tokw = (float*)(ws + WS_TOKW); int* list = (int*)(ws + WS_LIST);
    LAS unsigned char* lds = F.lds; const int lane = F.lane, w = F.wave, l15 = lane & 15, lq = lane >> 4;
    for (int i = F.tid; i < 48 * 128; i += NTHREADS) { const int r = i >> 7, c = i & 127; *(LAS v4u*)(lds + r * WR_PT + c * 16) = *(const v4u*)(Wr + (size_t)r * DM + c * 8); }
    LAS int* lcnt = (LAS int*)(lds + 100352);
    LAS float* lsc = (LAS float*)(lds + 101376) + w * (16 * 49);
    for (int grp = F.vcu * 8 + w; grp < T / 16; grp += F.G * 8) {
        if (F.tid < 64) lcnt[F.tid] = 0;
        __syncthreads();
        const int t0 = grp * 16;
        f32x4 a0 = {0.f, 0.f, 0.f, 0.f}, a1 = a0, a2 = a0;
        const bf16_t* hrow = hb + (size_t)(t0 + l15) * DM + 8 * lq;
#pragma unroll 4
        for (int ks = 0; ks < 32; ++ks) { const bf16x8 hf = *(const bf16x8*)(hrow + 32 * ks);
            const bf16x8 w0 = *(const LAS bf16x8*)(lds + (l15) * WR_PT + (32 * ks + 8 * lq) * 2), w1 = *(const LAS bf16x8*)(lds + (16 + l15) * WR_PT + (32 * ks + 8 * lq) * 2), w2 = *(const LAS bf16x8*)(lds + (32 + l15) * WR_PT + (32 * ks + 8 * lq) * 2);
            a0 = __builtin_amdgcn_mfma_f32_16x16x32_bf16(w0, hf, a0, 0, 0, 0); a1 = __builtin_amdgcn_mfma_f32_16x16x32_bf16(w1, hf, a1, 0, 0, 0); a2 = __builtin_amdgcn_mfma_f32_16x16x32_bf16(w2, hf, a2, 0, 0, 0); }
#pragma unroll
        for (int r = 0; r < 4; ++r) { lsc[l15 * 49 + 4 * lq + r] = a0[r]; lsc[l15 * 49 + 16 + 4 * lq + r] = a1[r]; lsc[l15 * 49 + 32 + 4 * lq + r] = a2[r]; }
        asm volatile("s_waitcnt lgkmcnt(0)" ::: "memory");
        int e0g = 0, e1g = 0, s0 = 0, s1 = 0; float w0 = 0.f, w1 = 0.f;
        if (lane < 16) { const int t = t0 + lane; const float rs = 1.0f / sqrtf(ss2[t] * (1.f / DM) + EPS); const LAS float* lg = lsc + lane * 49;
            int g = 0; float mg = lg[0] * rs + b_rg[0]; float gl[4]; gl[0] = mg;
#pragma unroll
            for (int i = 1; i < 4; ++i) { gl[i] = lg[i] * rs + b_rg[i]; if (gl[i] > mg) { mg = gl[i]; g = i; } }
            float sg = 0.f;
#pragma unroll
            for (int i = 0; i < 4; ++i) sg += __expf(gl[i] - mg);
            const float gp = 1.f / sg;
            float m0 = -INFINITY, m1 = -INFINITY; int i0 = 0, i1 = 0;
            for (int i = 0; i < 8; ++i) { const float v = lg[4 + g * 8 + i] * rs + b_re[g * 8 + i]; if (v > m0) { m1 = m0; i1 = i0; m0 = v; i0 = i; } else if (v > m1) { m1 = v; i1 = i; } }
            const float p1 = __expf(m1 - m0), inv = 1.f / (1.f + p1);
            e0g = g * 8 + i0; e1g = g * 8 + i1; w0 = gp * inv; w1 = gp * p1 * inv;
            s0 = atomicAdd((int*)&lcnt[e0g], 1); s1 = atomicAdd((int*)&lcnt[e1g], 1);
            toke[t * 2] = e0g; toke[t * 2 + 1] = e1g; tokw[t * 2] = w0; tokw[t * 2 + 1] = w1; }
        __syncthreads();
        if (F.tid < 32) { const int c = lcnt[F.tid]; lcnt[32 + F.tid] = c ? atomicAdd((int*)(ctl + CW_CNT + F.tid), c) : 0; }
        __syncthreads();
        if (lane < 16) { const int t = t0 + lane; list[(size_t)e0g * T + lcnt[32 + e0g] + s0] = t * 2; list[(size_t)e1g * T + lcnt[32 + e1g] + s1] = t * 2 + 1; }
        __syncthreads();
    }
}
__device__ __forceinline__ void moe_tables(const Frame& F, const unsigned* ctl) {
    LAS int* ts = (LAS int*)(F.lds + XTRA_OFF); LAS int* cnt = ts + 64;
    if (F.tid == 0) { int acc = 0; for (int e = 0; e < NEXP; ++e) { const int c = (int)__hip_atomic_load(ctl + CW_CNT + e, __ATOMIC_RELAXED, __HIP_MEMORY_SCOPE_AGENT); cnt[e] = c; ts[e] = acc; acc += (c + 255) >> 8; } ts[NEXP] = acc; }
    __syncthreads();
}

#ifndef PM
#define PM 0xfff
#endif
__global__ void __launch_bounds__(NTHREADS, 2) fwd_megakernel(Params P) {
    extern __shared__ __attribute__((aligned(16))) unsigned char lds_raw[];
    Frame F;
    F.lds = (LAS unsigned char*)lds_raw;
    F.tid = threadIdx.x; F.lane = F.tid & 63; F.wave = __builtin_amdgcn_readfirstlane(F.tid >> 6);
    F.G = gridDim.x; { const int bx = blockIdx.x; F.vcu = (F.G % 8 == 0) ? (bx % 8) * (F.G / 8) + bx / 8 : bx; }
    { volatile LAS unsigned* st = (volatile LAS unsigned*)(F.lds + XTRA_OFF + 8192); if (F.tid < 2) st[F.tid] = 0u; }
    __syncthreads();
    const XcdBarrier gbar = xcd_barrier_post((unsigned*)(PWS() + WS_CTL) + CW_BAR, (volatile LAS unsigned*)(F.lds + XTRA_OFF + 8192));
#define GRID_SYNC() xcd_barrier(gbar)

    if (PM & 1) p0_prologue(F, P);
    GRID_SYNC();

    if (PM & 2) {
        unsigned char* ws = PWS(); bf16_t* gates = (bf16_t*)POUT();
        pg8::Gemm g{(const bf16_t*)(ws + WS_XB), (const bf16_t*)(ws + WS_WP), T, NPROJ, DM}; pg8::StaticOrder S; S.init(T, NPROJ, F.G, (int)blockIdx.x);
        pg8::EpiProj E{ws, gates, (const float*)(ws + WS_RSTD1), PIN(6), (const float*)(ws + WS_COS), (const float*)(ws + WS_SIN)};
        pg8::gemm_phase<pg8::EpiProj, pg8::StaticOrder, true, false>(F.lds, g, S, E);
    }
    if (PM & 4) {
        unsigned char* ws = PWS(); unsigned* ctl = (unsigned*)(ws + WS_CTL);
        pg8::Gemm g{(const bf16_t*)(ws + WS_PB), (const bf16_t*)(ws + WS_WPLE), T, DM, PLE}; pg8::StaticOrder S; S.init(T, DM, F.G, (int)blockIdx.x);
        pg8::EpiPle E{(bf16_t*)(ws + WS_ER), (float*)(ctl + CW_SSE)};
        pg8::gemm_phase<pg8::EpiPle, pg8::StaticOrder, true, false>(F.lds, g, S, E);
    }
    GRID_SYNC();

    if (PM & 8) {
        unsigned char* ws = PWS(); unsigned* ctl = (unsigned*)(ws + WS_CTL);
        float lam;
        { float d1 = 0.f, d2 = 0.f; for (int i = 0; i < 64; ++i) { d1 += PIN(8)[i] * PIN(9)[i]; d2 += PIN(10)[i] * PIN(11)[i]; } lam = expf(d1) - expf(d2) + LAMBDA_INIT; }
        LAS int* qslot = (LAS int*)(F.lds + XTRA_OFF + 4096);
        bf16_t* oab = (bf16_t*)(ws + WS_XB);
        for (;;) {
            __syncthreads();
            if (F.tid == 0) qslot[0] = (int)atomicAdd(ctl + CW_QUEUE, 1u);
            __syncthreads();
            const int item = qslot[0];
            if (item >= 64 + 1024) break;
            if (item < 64) {
                gla::gla_item(item >> 2, item & 3, (const bf16_t*)(ws + WS_GQ), (const bf16_t*)(ws + WS_GK), (const bf16_t*)(ws + WS_GV), (const bf16_t*)(ws + WS_SR),
                              (const float*)(ws + WS_LA), PIN(7), oab, F.lds);
            } else {
                const int j = item - 64, qb = 15 - (j >> 6), bh = j & 63, b = bh >> 2, h = bh & 3;
                const size_t base = (size_t)b * SEQ * 512 + h * 128;
                da::attn_unit((const bf16_t*)(ws + WS_DQ) + base, (const bf16_t*)(ws + WS_DK) + base, (const bf16_t*)(ws + WS_DV) + base,
                              oab + (size_t)T * 512 + base, qb * 128, lam, PIN(12), (char*)lds_raw);
            }
        }
    }
    GRID_SYNC();

    if (PM & 16) {
        unsigned char* ws = PWS(); bf16_t* gates = (bf16_t*)POUT();
        pg8::Gemm g{(const bf16_t*)(ws + WS_XB), (const bf16_t*)(ws + WS_WAB), 2 * T, 2048, 512}; pg8::BranchOrder S; S.so.init(T, DM, F.G, (int)blockIdx.x);
        pg8::EpiBranch E{gates, (bf16_t*)(ws + WS_MG)};
        pg8::gemm_phase<pg8::EpiBranch, pg8::BranchOrder, true, false>(F.lds, g, S, E);
    }
    GRID_SYNC();

    if (PM & 32) {
        unsigned char* ws = PWS(); unsigned* ctl = (unsigned*)(ws + WS_CTL);
        pg8::Gemm g{(const bf16_t*)(ws + WS_MG), (const bf16_t*)(ws + WS_WO), T, DM, DM}; pg8::StaticOrder S; S.init(T, DM, F.G, (int)blockIdx.x);
        pg8::EpiOut E{PIN(0), (bf16_t*)(ws + WS_XB), (float*)(ctl + CW_SS2)};
        pg8::gemm_phase<pg8::EpiOut, pg8::StaticOrder, true, false>(F.lds, g, S, E);
    }
    GRID_SYNC();

    if (PM & 64) p4_router(F, P);
    GRID_SYNC();

    moe_tables(F, (const unsigned*)(PWS() + WS_CTL));
    if (PM & 128) {
        unsigned char* ws = PWS(); unsigned* ctl = (unsigned*)(ws + WS_CTL);
        pg8::MoeOrder<2> mo{(const LAS int*)(F.lds + XTRA_OFF), (const LAS int*)(F.lds + XTRA_OFF) + 64, (const int*)(ws + WS_LIST), F.G, (int)blockIdx.x};
        pg8::Gemm g{(const bf16_t*)(ws + WS_XB), (const bf16_t*)(ws + WS_WGU), T, NEXP * 512, DM};
        pg8::EpiUp E{mo, (const float*)(ctl + CW_SS2), (bf16_t*)(ws + WS_HE)};
        pg8::gemm_phase<pg8::EpiUp, pg8::MoeOrder<2>, true, true>(F.lds, g, mo, E);
    }
    GRID_SYNC();
    if (PM & 256) {
        unsigned char* ws = PWS();
        pg8::MoeOrder<4> mo{(const LAS int*)(F.lds + XTRA_OFF), (const LAS int*)(F.lds + XTRA_OFF) + 64, (const int*)(ws + WS_LIST), F.G, (int)blockIdx.x};
        pg8::Gemm g{(const bf16_t*)(ws + WS_HE), (const bf16_t*)(ws + WS_WD), MOE_ROWS, NEXP * 1024, DEXP};
        pg8::EpiDown E{mo, (const float*)(ws + WS_TOKW), (bf16_t*)(ws + WS_YB)};
        pg8::gemm_phase<pg8::EpiDown, pg8::MoeOrder<4>, true, false>(F.lds, g, mo, E);
    }
    GRID_SYNC();
    if (PM & 512) {
        unsigned char* ws = PWS();
        const bf16_t* hb = (const bf16_t*)(ws + WS_XB); const bf16_t* yb = (const bf16_t*)(ws + WS_YB); bf16_t* h2b = (bf16_t*)(ws + WS_H2B);
        const int gt = F.vcu * NTHREADS + F.tid, NGT = F.G * NTHREADS;
        for (int i = gt; i < T * DM / 8; i += NGT) { const int t = i >> 7, c = (i & 127) * 8;
            const v4u a = *(const v4u*)(hb + (size_t)t * DM + c), y0 = *(const v4u*)(yb + (size_t)(2 * t) * DM + c), y1 = *(const v4u*)(yb + (size_t)(2 * t + 1) * DM + c);
            v4u o; o.x = cvt_pk_bf16(bf_lo(a.x) + bf_lo(y0.x) + bf_lo(y1.x), bf_hi(a.x) + bf_hi(y0.x) + bf_hi(y1.x)); o.y = cvt_pk_bf16(bf_lo(a.y) + bf_lo(y0.y) + bf_lo(y1.y), bf_hi(a.y) + bf_hi(y0.y) + bf_hi(y1.y));
            o.z = cvt_pk_bf16(bf_lo(a.z) + bf_lo(y0.z) + bf_lo(y1.z), bf_hi(a.z) + bf_hi(y0.z) + bf_hi(y1.z)); o.w = cvt_pk_bf16(bf_lo(a.w) + bf_lo(y0.w) + bf_lo(y1.w), bf_hi(a.w) + bf_hi(y0.w) + bf_hi(y1.w));
            *(v4u*)(h2b + (size_t)t * DM + c) = o; }
    }
    GRID_SYNC();
    if (PM & 1024) {
        unsigned char* ws = PWS(); unsigned* ctl = (unsigned*)(ws + WS_CTL);
        pg8::Gemm g{(const bf16_t*)(ws + WS_H2B), (const bf16_t*)(ws + WS_WPG), T, DM, DM}; pg8::StaticOrder S; S.init(T, DM, F.G, (int)blockIdx.x);
        pg8::EpiFinal E{(const bf16_t*)(ws + WS_H2B), (const bf16_t*)(ws + WS_ER), (const float*)(ctl + CW_SSE), PIN(25), POUT(), (float*)(ctl + CW_SSF)};
        pg8::gemm_phase<pg8::EpiFinal, pg8::StaticOrder, true, false>(F.lds, g, S, E);
    }
    GRID_SYNC();
    if (PM & 2048) {
        unsigned char* ws = PWS(); unsigned* ctl = (unsigned*)(ws + WS_CTL);
        const float* ssf = (const float*)(ctl + CW_SSF); const float* gf = PIN(27); float* out = POUT();
        const int gt = F.vcu * NTHREADS + F.tid, NGT = F.G * NTHREADS;
        for (int i = gt; i < T * DM / 4; i += NGT) { const int t = i >> 8, c = (i & 255) * 4; const float rs = 1.0f / sqrtf(ssf[t] * (1.f / DM) + EPS);
            f32x4 v = *(f32x4*)(out + (size_t)t * DM + c); const f32x4 g = *(const f32x4*)(gf + c); v = v * g * rs; *(f32x4*)(out + (size_t)t * DM + c) = v; }
    }
}

extern "C" void kernel_launch(void* const* d_in, const int* in_sizes, int n_in, void* d_out, int out_size, void* d_ws, size_t ws_size, hipStream_t stream) {
    static int grid = 0;
    if (grid == 0) {
        if (n_in != 28 || out_size != T * DM || ws_size < WS_END) { fprintf(stderr, "kernel_launch: unexpected shapes (n_in %d, out %d, ws %zu < %zu)\n", n_in, out_size, ws_size, (size_t)WS_END); grid = -1; return; }
        int dev = 0, cus = 0, per_cu = 0;
        hipGetDevice(&dev); hipDeviceGetAttribute(&cus, hipDeviceAttributeMultiprocessorCount, dev);
        if (hipFuncSetAttribute((const void*)fwd_megakernel, hipFuncAttributeMaxDynamicSharedMemorySize, LDS_BYTES) != hipSuccess) { fprintf(stderr, "kernel_launch: hipFuncSetAttribute failed\n"); grid = -1; return; }
        if (hipOccupancyMaxActiveBlocksPerMultiprocessor(&per_cu, (const void*)fwd_megakernel, NTHREADS, LDS_BYTES) != hipSuccess || per_cu < 1) { fprintf(stderr, "kernel_launch: occupancy query says %d blocks/CU\n", per_cu); grid = -1; return; }
        grid = cus;
        fprintf(stderr, "kernel_launch: cus %d per_cu %d grid %d ws %zu\n", cus, per_cu, grid, ws_size);
    }
    if (grid < 0) return;
    hipMemsetAsync((char*)d_ws + WS_CTL, 0, CTL_ZERO_BYTES, stream);
    Params p{};
    for (int i = 0; i < 28; ++i) p.p[i] = d_in[i];
    p.p[28] = d_out; p.p[29] = d_ws;
    void* args[] = {&p};
    hipError_t e = hipLaunchCooperativeKernel((const void*)fwd_megakernel, dim3(grid), dim3(NTHREADS), args, LDS_BYTES, stream);
    if (e != hipSuccess) fprintf(stderr, "cooperative launch failed: %s (grid %d)\n", hipGetErrorString(e), grid);
}
```

```cpp
#include <hip/hip_runtime.h>
#include <hip/hip_cooperative_groups.h>
#include <hip/hip_bf16.h>
#include <cstdio>
#include <cstdint>
#include <cmath>
namespace cg = cooperative_groups;

constexpr int NB = 16, SEQ = 2048, DM = 1024, T = NB * SEQ, DIN = 5136, NPROJ = 5376, PLE = 256;
constexpr int NEXP = 32, DEXP = 256;
constexpr float EPS = 1e-6f;
constexpr float LOG2E = 1.4426950408889634f;
constexpr float QSCALE2 = 0.125f * LOG2E;
constexpr float LAMBDA_INIT = 0.2f;
constexpr int C_Q = 0, C_K = 256, C_V = 512, C_R = 1024, C_AL = 1536, C_DQ = 1552, C_DK = 2064, C_DV = 2576, C_GA = 3088, C_GB = 4112;
constexpr int P_Q = 0, P_K = 256, P_V = 512, P_R = 1024, P_AL = 1536, P_DQ = 1792, P_DK = 2304, P_DV = 2816, P_GA = 3328, P_GB = 4352;

constexpr size_t MiB = 1u << 20;
constexpr size_t WS_CTL = 0, CTL_ZERO_BYTES = 1 * MiB;
constexpr int CW_CNT = 64;
constexpr int CW_QUEUE = 128;
constexpr int CW_BAR = 4096;
constexpr int CW_SS2 = 65536;
constexpr int CW_SSE = 65536 + 32768;
constexpr int CW_SSF = 65536 + 65536;
static_assert((CW_SSF + 32768) * 4 <= (int)CTL_ZERO_BYTES, "ctl");
constexpr size_t WS_RSTD1 = 1 * MiB;
constexpr size_t WS_TOKE = 1 * MiB + 256 * 1024;
constexpr size_t WS_TOKW = 1 * MiB + 512 * 1024;
constexpr size_t WS_COS = 2 * MiB, WS_SIN = 3 * MiB;
constexpr size_t WS_LIST = 4 * MiB;
constexpr size_t WS_LRS = 138 * MiB + 16 * MiB - 8 * MiB;
constexpr size_t WS_LW = WS_LRS + 4 * MiB;
constexpr size_t WS_WP = 8 * MiB;
constexpr size_t WS_WGU = 19 * MiB;
constexpr size_t WS_WD = 51 * MiB;
constexpr size_t WS_WAB = 67 * MiB;
constexpr size_t WS_WO = 69 * MiB;
constexpr size_t WS_WPG = 71 * MiB;
constexpr size_t WS_WPLE = 73 * MiB;
constexpr size_t WS_WR = 73 * MiB + 512 * 1024;
constexpr size_t WS_XB = 74 * MiB;
constexpr size_t WS_PB = 138 * MiB;
constexpr size_t WS_ER = 154 * MiB;
constexpr size_t WS_GQ = 218 * MiB, WS_GK = 234 * MiB, WS_GV = 250 * MiB, WS_SR = 282 * MiB, WS_LA = 314 * MiB, WS_DQ = 346 * MiB, WS_DK = 378 * MiB, WS_DV = 410 * MiB;
constexpr size_t WS_MG = 218 * MiB;
constexpr size_t WS_H2B = 282 * MiB;
constexpr size_t WS_YB = 346 * MiB;
constexpr size_t WS_HE = 474 * MiB;
constexpr size_t WS_END = 512 * MiB;
constexpr int MOE_ROWS = 2 * T + NEXP * 256;
static_assert(WS_HE + (size_t)MOE_ROWS * DEXP * 2 <= WS_END, "ws");

constexpr int RING_BYTES = 131072;
constexpr int XTRA_OFF = RING_BYTES;
constexpr int LDS_BYTES = RING_BYTES + 20480;
constexpr int NTHREADS = 512;

#define GAS __attribute__((address_space(1)))
#define LAS __attribute__((address_space(3)))
typedef unsigned short bf16_t;
typedef unsigned v4u __attribute__((ext_vector_type(4)));
typedef unsigned v2u __attribute__((ext_vector_type(2)));
typedef float f32x4 __attribute__((ext_vector_type(4)));
typedef float f32x2 __attribute__((ext_vector_type(2)));
typedef float f32x16 __attribute__((ext_vector_type(16)));
typedef short bf16x8 __attribute__((ext_vector_type(8)));
typedef short s16x4 __attribute__((ext_vector_type(4)));

__device__ __forceinline__ unsigned cvt_pk_bf16(float lo, float hi) { unsigned r; asm volatile("v_cvt_pk_bf16_f32 %0, %1, %2" : "=v"(r) : "v"(lo), "v"(hi)); return r; }
__device__ __forceinline__ float bf_lo(unsigned w) { return __uint_as_float(w << 16); }
__device__ __forceinline__ float bf_hi(unsigned w) { return __uint_as_float(w & 0xffff0000u); }
__device__ __forceinline__ float sigmoidf_(float x) { return __builtin_amdgcn_rcpf(1.f + __builtin_amdgcn_exp2f(-x * LOG2E)); }
__device__ __forceinline__ float wave_sum(float v) {
#pragma unroll
    for (int o = 1; o < 64; o <<= 1) v += __shfl_xor(v, o);
    return v;
}

namespace pg8 {
constexpr int BM = 256, BK = 64, HALF = 128, HTB = HALF * BK * 2, STAGE_BYTES = 8 * HTB, NXCD = 8, WGM = 8;
__host__ __device__ __forceinline__ int lds_byte(int r, int c) { const int st = (r >> 4) * 2 + (c >> 5), rr = r & 15, cc = c & 31, ob = rr * 64 + cc * 2; return st * 1024 + (ob ^ (((ob >> 9) & 1) << 5)); }
__host__ __device__ __forceinline__ void stage_rc(int b, int& R, int& C) { const int st = b / 1024, sb = b % 1024, swz = sb ^ (((sb >> 9) & 1) << 5); R = (st >> 1) * 16 + swz / 64; C = (st & 1) * 32 + (swz % 64) / 2; }
__host__ __device__ __forceinline__ int perm32(int rho) { const int n = rho >> 4, i = rho & 15; return 8 * (i >> 2) + 4 * n + (i & 3); }
struct Unit { int pm, pn; };
struct Gemm { const bf16_t* A; const bf16_t* Bt; int M, N, K; };
struct StaticOrder {
    int nM, nN, nwg, G, c;
    __host__ __device__ void init(int M, int N, int G_, int c_) { nM = M / BM; nN = N / BM; nwg = nM * nN; G = G_; c = c_; }
    __host__ __device__ bool next(int i, Unit& u) const {
        const long L = (long)i * G + c; if (L >= nwg) return false;
        int wgid = (int)L; { const int q = nwg / NXCD, r = nwg % NXCD, xcd = wgid % NXCD, off = wgid / NXCD; wgid = (xcd < r ? xcd * (q + 1) : r * (q + 1) + (xcd - r) * q) + off; }
        const int nig = WGM * nN, gid = wgid / nig, fm = gid * WGM, gsz = (nM - fm) < WGM ? (nM - fm) : WGM;
        u.pm = fm + ((wgid % nig) % gsz); u.pn = (wgid % nig) / gsz; return true;
    }
    __device__ __forceinline__ unsigned arow(const Unit&, int) const { return 0u; }
};

template <class Epi, class Sched, bool ALIGN_EPI, bool GATHER>
__device__ __forceinline__ void gemm_phase(LAS unsigned char* lds, const Gemm g, const Sched& S, const Epi& E) {
    int tid = threadIdx.x; asm volatile("" : "+v"(tid));
    const int wid = __builtin_amdgcn_readfirstlane(tid >> 6), lane = tid & 63, wr = wid >> 2, wc = wid & 3, fr = lane & 15, fq = lane >> 4;
    const int K = g.K, nt = K / BK;
    unsigned voffB[2]; int RA[2], CA[2];
#pragma unroll
    for (int i = 0; i < 2; ++i) { int R, C; stage_rc(tid * 16 + i * 8192, R, C); const int Rb = Epi::PERM ? ((R & ~31) + perm32(R & 31)) : R;
        RA[i] = R; CA[i] = C; voffB[i] = (unsigned)(Rb * K + C) * 2u; }
    const size_t kstep = (size_t)(BK * 2);
    const size_t hstep = (size_t)HALF * K * 2;
    const size_t tstep = 2 * hstep;
    const unsigned ldsw = (unsigned)wid * 1024u;
    const int aoff = lds_byte(wr * 64 + fr, fq * 8), boff = lds_byte(wc * 32 + fr, fq * 8);
#define PG8_SA(b, h) (((b) * 2 + (h)) * HTB)
#define PG8_SB(b, h) ((4 + (b) * 2 + (h)) * HTB)
#define PG8_STAGE(bufoff, gbase, voff) do { _Pragma("unroll") for (int _i = 0; _i < 2; ++_i) \
        __builtin_amdgcn_global_load_lds((const unsigned*)((const char*)(gbase) + (voff)[_i]), (LAS unsigned*)(lds + (bufoff) + ldsw + _i * 8192), 16, 0, 0); } while (0)
#define PG8_STA(bufoff, gbase, v0, v1) do { \
        __builtin_amdgcn_global_load_lds((const unsigned*)((const char*)(gbase) + (v0)), (LAS unsigned*)(lds + (bufoff) + ldsw), 16, 0, 0); \
        __builtin_amdgcn_global_load_lds((const unsigned*)((const char*)(gbase) + (v1)), (LAS unsigned*)(lds + (bufoff) + ldsw + 8192), 16, 0, 0); } while (0)
#define PG8_LDA(dst, b, h) do { _Pragma("unroll") for (int m = 0; m < 4; ++m) _Pragma("unroll") for (int k = 0; k < 2; ++k) dst[m][k] = *(const LAS bf16x8*)(lds + PG8_SA(b, h) + aoff + m * 2048 + k * 1024); } while (0)
#define PG8_LDB(dst, b, h) do { _Pragma("unroll") for (int n = 0; n < 2; ++n) _Pragma("unroll") for (int k = 0; k < 2; ++k) dst[n][k] = *(const LAS bf16x8*)(lds + PG8_SB(b, h) + boff + n * 2048 + k * 1024); } while (0)
#define PG8_MMA(ai, bj, At, Bt) do { __builtin_amdgcn_s_setprio(1); _Pragma("unroll") for (int m = 0; m < 4; ++m) _Pragma("unroll") for (int n = 0; n < 2; ++n) _Pragma("unroll") for (int k = 0; k < 2; ++k) \
        acc[ai][bj][m][n] = __builtin_amdgcn_mfma_f32_16x16x32_bf16(Bt[n][k], At[m][k], acc[ai][bj][m][n], 0, 0, 0); __builtin_amdgcn_s_setprio(0); } while (0)
#define PG8_WAIT_V(n) asm volatile("s_waitcnt vmcnt(" #n ")" ::: "memory")
#define PG8_WAIT_L(n) asm volatile("s_waitcnt lgkmcnt(" #n ")" ::: "memory")
#define PG8_BAR __builtin_amdgcn_s_barrier()
#define PG8_SCHED __builtin_amdgcn_sched_barrier(0)
    Unit cur, nxt; int ui = 0;
    if (!S.next(0, cur)) return;
    f32x4 acc[2][2][4][2];
#pragma unroll
    for (int a = 0; a < 2; ++a)
#pragma unroll
        for (int b = 0; b < 2; ++b)
#pragma unroll
            for (int m = 0; m < 4; ++m)
#pragma unroll
                for (int n = 0; n < 2; ++n) acc[a][b][m][n] = (f32x4){0.f, 0.f, 0.f, 0.f};
    bf16x8 At[4][2], B0[2][2], B1[2][2];
    unsigned vA00, vA01, vA10, vA11, vN00, vN01, vN10, vN11;
#define PG8_AOFF(u, h, i) (GATHER ? (unsigned)(((size_t)S.arow(u, (h) * HALF + RA[i]) * (size_t)K + CA[i]) * 2u) : (unsigned)((h) * hstep + ((size_t)RA[i] * K + CA[i]) * 2u))
    vA00 = PG8_AOFF(cur, 0, 0); vA01 = PG8_AOFF(cur, 0, 1); vA10 = PG8_AOFF(cur, 1, 0); vA11 = PG8_AOFF(cur, 1, 1);
    vN00 = vA00; vN01 = vA01; vN10 = vA10; vN11 = vA11;
    const char* cA = (const char*)g.A + (GATHER ? (size_t)0 : (size_t)cur.pm * tstep); const char* cB = (const char*)g.Bt + (size_t)cur.pn * tstep;
    PG8_STAGE(PG8_SB(0, 0), cB, voffB); PG8_STAGE(PG8_SB(0, 1), cB + hstep, voffB); PG8_STA(PG8_SA(0, 0), cA, vA00, vA01); PG8_STA(PG8_SA(0, 1), cA, vA10, vA11);
    if (wr == 1) PG8_BAR;
    PG8_WAIT_V(2); PG8_BAR;
    PG8_STAGE(PG8_SB(1, 0), cB + kstep, voffB); PG8_STA(PG8_SA(1, 0), cA + kstep, vA00, vA01); PG8_STAGE(PG8_SB(1, 1), cB + hstep + kstep, voffB);
    PG8_WAIT_V(6); PG8_BAR;
#pragma unroll 1
    for (;;) {
        const bool has_next = S.next(ui + 1, nxt);
        const char* nA = has_next ? (const char*)g.A + (GATHER ? (size_t)0 : (size_t)nxt.pm * tstep) : cA; const char* nB = has_next ? (const char*)g.Bt + (size_t)nxt.pn * tstep : cB;
        if constexpr (GATHER) { if (has_next) { vN00 = PG8_AOFF(nxt, 0, 0); vN01 = PG8_AOFF(nxt, 0, 1); vN10 = PG8_AOFF(nxt, 1, 0); vN11 = PG8_AOFF(nxt, 1, 1); } else { vN00 = vA00; vN01 = vA01; vN10 = vA10; vN11 = vA11; } }
#pragma unroll 1
        for (int t = 0; t < nt; t += 2) {
            const bool last = (t == nt - 2);
            const char* a1 = cA + (size_t)(t + 1) * kstep;
            const char* a2 = last ? nA : cA + (size_t)(t + 2) * kstep; const char* b2 = last ? nB : cB + (size_t)(t + 2) * kstep;
            const char* a3 = a2 + kstep; const char* b3 = b2 + kstep;
            unsigned w00 = vA00, w01 = vA01, w10 = vA10, w11 = vA11;
            if constexpr (GATHER) { if (last) { w00 = vN00; w01 = vN01; w10 = vN10; w11 = vN11; } }
            PG8_LDB(B0, 0, 0); PG8_LDB(B1, 0, 1); PG8_SCHED; PG8_LDA(At, 0, 0); PG8_STA(PG8_SA(1, 1), a1, vA10, vA11);
            PG8_WAIT_V(8); PG8_WAIT_L(0); PG8_BAR; PG8_MMA(0, 0, At, B0); PG8_MMA(0, 1, At, B1); PG8_BAR; PG8_SCHED;
            PG8_LDA(At, 0, 1); PG8_STAGE(PG8_SB(0, 0), b2, voffB); PG8_STAGE(PG8_SB(0, 1), b2 + hstep, voffB); PG8_STA(PG8_SA(0, 0), a2, w00, w01);
            PG8_WAIT_V(8); PG8_WAIT_L(0); PG8_BAR; PG8_MMA(1, 0, At, B0); PG8_MMA(1, 1, At, B1); PG8_BAR; PG8_SCHED;
            PG8_LDB(B0, 1, 0); PG8_LDB(B1, 1, 1); PG8_SCHED; PG8_LDA(At, 1, 0); PG8_STA(PG8_SA(0, 1), a2, w10, w11);
            PG8_WAIT_V(8); PG8_WAIT_L(0); PG8_BAR; PG8_MMA(0, 0, At, B0); PG8_MMA(0, 1, At, B1); PG8_BAR; PG8_SCHED;
            PG8_LDA(At, 1, 1); PG8_STAGE(PG8_SB(1, 0), b3, voffB); PG8_STAGE(PG8_SB(1, 1), b3 + hstep, voffB); PG8_STA(PG8_SA(1, 0), a3, w00, w01);
            PG8_WAIT_V(8); PG8_WAIT_L(0); PG8_BAR; PG8_MMA(1, 0, At, B0); PG8_MMA(1, 1, At, B1); PG8_BAR; PG8_SCHED;
        }
        if constexpr (ALIGN_EPI) { if (wr == 0) PG8_BAR; }
        E(acc, cur, wr, wc, fr, fq);
        if (!has_next) break;
#pragma unroll
        for (int a = 0; a < 2; ++a)
#pragma unroll
            for (int b = 0; b < 2; ++b)
#pragma unroll
                for (int m = 0; m < 4; ++m)
#pragma unroll
                    for (int n = 0; n < 2; ++n) acc[a][b][m][n] = (f32x4){0.f, 0.f, 0.f, 0.f};
        cur = nxt; cA = nA; cB = nB; ++ui;
        vA00 = vN00; vA01 = vN01; vA10 = vN10; vA11 = vN11;
        if constexpr (ALIGN_EPI) { if (wr == 1) PG8_BAR; }
    }
    PG8_WAIT_V(0);
    if constexpr (!ALIGN_EPI) { if (wr == 0) PG8_BAR; }
    PG8_BAR;
#undef PG8_AOFF
#undef PG8_SA
#undef PG8_SB
#undef PG8_STAGE
#undef PG8_STA
#undef PG8_LDA
#undef PG8_LDB
#undef PG8_MMA
#undef PG8_WAIT_V
#undef PG8_WAIT_L
#undef PG8_BAR
#undef PG8_SCHED
}
}

struct Params { const void* p[30]; };
__device__ __forceinline__ const void* parg(const Params& P, int i) { asm volatile("" : "+s"(i)); return P.p[i]; }
#define PIN(i) ((const float*)parg(P, (i)))
#define POUT() ((float*)parg(P, 28))
#define PWS() ((unsigned char*)parg(P, 29))
struct Frame {
    LAS unsigned char* lds;
    int tid, lane, wave, vcu, G;
};

#define XB_TMO      128
#define XB_XCNT(j)  (256  + 64 * (j))
#define XB_XSUB(j)  (1280 + 64 * (j))
#define XB_XGEN(j)  (2304 + 64 * (j))
#define XB_TOP      3328
#define XB_TOPGEN   3392
#define XCD_BAR_WORDS 3456
#define XB_SPIN_CAP (1u << 20)
__device__ __forceinline__ unsigned xb_ld(unsigned* p)              { return __hip_atomic_load(p, __ATOMIC_RELAXED, __HIP_MEMORY_SCOPE_AGENT); }
__device__ __forceinline__ unsigned xb_add(unsigned* p, unsigned v) { return __hip_atomic_fetch_add(p, v, __ATOMIC_RELAXED, __HIP_MEMORY_SCOPE_AGENT); }
__device__ __forceinline__ unsigned xb_xcc_id() { return (unsigned)__builtin_amdgcn_s_getreg((3 << 11) | 20) & 0xFu; }
#define XB_SPIN(cond, bar) do { unsigned _sp = 0; while (cond) { __builtin_amdgcn_s_sleep(1); \
    if ((++_sp & 255u) == 0u) { if (xb_ld(&(bar)[XB_TMO])) break; if (_sp > XB_SPIN_CAP) { atomicAdd(&(bar)[XB_TMO], 1u); break; } } } } while (0)
struct XcdBarrier { unsigned* bar; unsigned x; volatile LAS unsigned* st; };
__device__ __forceinline__ XcdBarrier xcd_barrier_post(unsigned* bar, volatile LAS unsigned* st) {
    XcdBarrier b; b.bar = bar; b.x = xb_xcc_id(); b.st = st;
    if (threadIdx.x == 0) (void)xb_add(&bar[XB_XCNT(b.x)], 1u);
    return b;
}
__device__ __forceinline__ void xcd_barrier_complete(unsigned* bar, unsigned x, unsigned& nloc, unsigned& nx) {
    const unsigned G = gridDim.x * gridDim.y * gridDim.z;
    unsigned sum, cnt, mine, sp = 0u;
    for (;;) {
        sum = 0u; cnt = 0u; mine = 0u;
#pragma unroll
        for (unsigned j = 0; j < 16; ++j) { const unsigned c = xb_ld(&bar[XB_XCNT(j)]); sum += c; cnt += (c > 0u) ? 1u : 0u; mine = (j == x) ? c : mine; }
        if (sum == G) break;
        __builtin_amdgcn_s_sleep(1);
        if ((++sp & 255u) == 0u) { if (xb_ld(&bar[XB_TMO])) break; if (sp > XB_SPIN_CAP) { atomicAdd(&bar[XB_TMO], 1u); break; } }
    }
    nloc = mine > 0u ? mine : 1u; nx = cnt > 0u ? cnt : 1u;
}
__device__ __forceinline__ void xcd_barrier(const XcdBarrier& b) {
    asm volatile("s_waitcnt vmcnt(0)" ::: "memory");
    __syncthreads();
    if (threadIdx.x == 0) {
        unsigned* bar = b.bar;
        __builtin_amdgcn_s_waitcnt(0);
        unsigned nloc = b.st[0], nx = b.st[1];
        if (nloc == 0u) { xcd_barrier_complete(bar, b.x, nloc, nx); b.st[0] = nloc; b.st[1] = nx; }
        const unsigned old = xb_add(&bar[XB_XSUB(b.x)], 1u);
        const unsigned gen = old / nloc;
        if (old + 1u == (gen + 1u) * nloc) {
            __builtin_amdgcn_fence(__ATOMIC_RELEASE, "agent");
            asm volatile("s_waitcnt vmcnt(0)" ::: "memory");
            const unsigned og = xb_add(&bar[XB_TOP], 1u);
            const unsigned tg = og / nx;
            if (og + 1u == (tg + 1u) * nx) xb_add(&bar[XB_TOPGEN], 1u);
            else XB_SPIN(xb_ld(&bar[XB_TOPGEN]) == tg, bar);
            __builtin_amdgcn_fence(__ATOMIC_ACQUIRE, "agent");
            xb_add(&bar[XB_XGEN(b.x)], 1u);
            asm volatile("s_waitcnt vmcnt(0)" ::: "memory");
        } else {
            XB_SPIN(xb_ld(&bar[XB_XGEN(b.x)]) == gen, bar);
            __builtin_amdgcn_fence(__ATOMIC_ACQUIRE, "agent");
            asm volatile("s_waitcnt vmcnt(0)" ::: "memory");
        }
    }
    __syncthreads();
}

struct TrJob { const float* W; int ld, k0; const float* gain; float scale; bf16_t* dst; int K; };
__device__ __forceinline__ void tr_load(const TrJob& j, float (&v)[32], int lane) {
#pragma unroll
    for (int i = 0; i < 32; ++i) { const int kk = 2 * i + (lane >> 5); v[i] = j.W[(size_t)(j.k0 + kk) * j.ld + (lane & 31)]; }
}
__device__ __forceinline__ void tr_finish(const TrJob& j, const float (&v)[32], LAS float* scr, int lane) {
#pragma unroll
    for (int i = 0; i < 32; ++i) { const int kk = 2 * i + (lane >> 5); float x = v[i]; if (j.gain) x *= j.gain[j.k0 + kk]; scr[kk * 33 + (lane & 31)] = x * j.scale; }
    asm volatile("s_waitcnt lgkmcnt(0)" ::: "memory");
    const int c = lane & 7;
#pragma unroll
    for (int jj = 0; jj < 4; ++jj) { const int n = (lane >> 3) + 8 * jj; const LAS float* s = scr + (8 * c) * 33 + n;
        v4u o; o.x = cvt_pk_bf16(s[0 * 33], s[1 * 33]); o.y = cvt_pk_bf16(s[2 * 33], s[3 * 33]); o.z = cvt_pk_bf16(s[4 * 33], s[5 * 33]); o.w = cvt_pk_bf16(s[6 * 33], s[7 * 33]);
        *(v4u*)(j.dst + (size_t)n * j.K + j.k0 + 8 * c) = o; }
    asm volatile("s_waitcnt lgkmcnt(0)" ::: "memory");
}

__device__ __forceinline__ void p0_prologue(const Frame& F, const Params& P) {
    unsigned char* ws = PWS();
    const float* x = PIN(0); const float* p = PIN(1); const int* pos = (const int*)PIN(2);
    const float* attn_norm = PIN(3); const float* w_in = PIN(4); const float* w_a2 = PIN(5);
    const float* w_ba = PIN(13); const float* w_bb = PIN(14); const float* w_out = PIN(15); const float* ffn_norm = PIN(16);
    const float* w_rg = PIN(17); const float* w_re = PIN(19);
    const float* w_gate = PIN(21); const float* w_up = PIN(22); const float* w_down = PIN(23); const float* w_ple = PIN(24); const float* w_pg = PIN(26);
    bf16_t* Wp = (bf16_t*)(ws + WS_WP); bf16_t* Wgu = (bf16_t*)(ws + WS_WGU); bf16_t* Wd = (bf16_t*)(ws + WS_WD); bf16_t* Wab = (bf16_t*)(ws + WS_WAB);
    bf16_t* Wo = (bf16_t*)(ws + WS_WO); bf16_t* Wpg = (bf16_t*)(ws + WS_WPG); bf16_t* Wple = (bf16_t*)(ws + WS_WPLE); bf16_t* Wr = (bf16_t*)(ws + WS_WR);
    LAS float* scr = (LAS float*)(F.lds + F.wave * 16384);
    const int gw = F.vcu * 8 + F.wave, NGW = F.G * 8, lane = F.lane;
    constexpr int I0 = 16 * 48, I1 = 16 * 112, I2 = 8 * 32, I3 = 8 * 32, I4 = 16 * 32, I5 = 16 * 32, I6 = 4 * 32, I7 = 32 * 16 * 8, I8 = I7, I9 = 32 * 4 * 32;
    constexpr int NITEMS = I0 + I1 + I2 + I3 + I4 + I5 + I6 + I7 + I8 + I9;
    auto decode = [&](int it) -> TrJob {
        int r = it; TrJob j;
        if (r < I0) { const int kb = r / 48, nb = r % 48; j = TrJob{w_in + nb * 32, DIN, kb * 64, attn_norm, nb < 8 ? 0.125f : 1.f, Wp + (size_t)(nb * 32) * DM, DM}; return j; } r -= I0;
        if (r < I1) { const int kb = r / 112, nb = r % 112; j = TrJob{w_in + C_DQ + nb * 32, DIN, kb * 64, attn_norm, nb < 16 ? QSCALE2 : 1.f, Wp + (size_t)(P_DQ + nb * 32) * DM, DM}; return j; } r -= I1;
        if (r < I2) { const int kb = r / 32, nb = r % 32; j = TrJob{w_ba + nb * 32, DM, kb * 64, nullptr, 1.f, Wab + (size_t)(nb * 32) * 512, 512}; return j; } r -= I2;
        if (r < I3) { const int kb = r / 32, nb = r % 32; j = TrJob{w_bb + nb * 32, DM, kb * 64, nullptr, 1.f, Wab + (size_t)(1024 + nb * 32) * 512, 512}; return j; } r -= I3;
        if (r < I4) { const int kb = r / 32, nb = r % 32; j = TrJob{w_out + nb * 32, DM, kb * 64, nullptr, 1.f, Wo + (size_t)(nb * 32) * DM, DM}; return j; } r -= I4;
        if (r < I5) { const int kb = r / 32, nb = r % 32; j = TrJob{w_pg + nb * 32, DM, kb * 64, nullptr, 1.f, Wpg + (size_t)(nb * 32) * DM, DM}; return j; } r -= I5;
        if (r < I6) { const int kb = r / 32, nb = r % 32; j = TrJob{w_ple + nb * 32, DM, kb * 64, nullptr, 1.f, Wple + (size_t)(nb * 32) * PLE, PLE}; return j; } r -= I6;
        if (r < I7 + I8) { const int up = r >= I7; if (up) r -= I7; const int e = r / 128, q = r % 128, kb = q / 8, nb = q % 8;
            j = TrJob{(up ? w_up : w_gate) + (size_t)e * DM * DEXP + nb * 32, DEXP, kb * 64, ffn_norm, 1.f, Wgu + (size_t)(e * 512 + (nb >> 2) * 256 + up * 128 + (nb & 3) * 32) * DM, DM}; return j; } r -= I7 + I8;
        { const int e = r / 128, q = r % 128, kb = q / 32, nb = q % 32;
          j = TrJob{w_down + (size_t)e * DEXP * DM + nb * 32, DM, kb * 64, nullptr, 1.f, Wd + (size_t)(e * 1024 + nb * 32) * DEXP, DEXP}; return j; }
    };
    {
        float va[32], vb[32];
        int it = gw;
        if (it < NITEMS) { TrJob ja = decode(it); tr_load(ja, va, lane);
            for (;;) {
                const int itb = it + NGW; TrJob jb = ja;
                if (itb < NITEMS) { jb = decode(itb); tr_load(jb, vb, lane); }
                tr_finish(ja, va, scr, lane);
                if (itb >= NITEMS) break;
                const int itc = itb + NGW;
                if (itc < NITEMS) { ja = decode(itc); tr_load(ja, va, lane); }
                tr_finish(jb, vb, scr, lane);
                if (itc >= NITEMS) break;
                it = itc;
            }
        }
    }
    for (int it = gw; it < 16 * 8; it += NGW) { const int kb = it / 8, jb = it % 8, k = kb * 64 + lane;
        float wv[16];
#pragma unroll
        for (int r = 0; r < 16; ++r) wv[r] = w_in[(size_t)k * DIN + C_AL + r];
        const float g = attn_norm[k];
        for (int jj = 0; jj < 32; ++jj) { const int j = jb * 32 + jj; float s = 0.f;
#pragma unroll
            for (int r = 0; r < 16; ++r) s += wv[r] * w_a2[r * 256 + j];
            Wp[(size_t)(P_AL + j) * DM + k] = (bf16_t)(cvt_pk_bf16(s * g, 0.f) & 0xffffu); } }
    const int gt = F.vcu * NTHREADS + F.tid, NGT = F.G * NTHREADS;
    for (int i = gt; i < 48 * DM; i += NGT) { const int n = i >> 10, k = i & 1023; float v = 0.f;
        if (n < 4) v = w_rg[k * 4 + n] * ffn_norm[k]; else if (n < 36) v = w_re[k * 32 + (n - 4)] * ffn_norm[k];
        Wr[i] = (bf16_t)(cvt_pk_bf16(v, 0.f) & 0xffffu); }
    { bf16_t* xb = (bf16_t*)(ws + WS_XB); float* rstd1 = (float*)(ws + WS_RSTD1);
      for (int m0 = gw * 4; m0 < T; m0 += NGW * 4) { f32x4 v[4][4];
#pragma unroll
          for (int r = 0; r < 4; ++r) { const GAS f32x4* xr = (const GAS f32x4*)(x + (size_t)(m0 + r) * DM) + lane;
#pragma unroll
              for (int j = 0; j < 4; ++j) v[r][j] = xr[64 * j]; }
#pragma unroll
          for (int r = 0; r < 4; ++r) { float s = 0.f;
#pragma unroll
              for (int j = 0; j < 4; ++j) s += (v[r][j].x * v[r][j].x + v[r][j].y * v[r][j].y) + (v[r][j].z * v[r][j].z + v[r][j].w * v[r][j].w);
              s = wave_sum(s);
              GAS v2u* o8 = (GAS v2u*)(xb + (size_t)(m0 + r) * DM) + lane;
#pragma unroll
              for (int j = 0; j < 4; ++j) { v2u o; o.x = cvt_pk_bf16(v[r][j].x, v[r][j].y); o.y = cvt_pk_bf16(v[r][j].z, v[r][j].w); o8[64 * j] = o; }
              if (lane == 0) rstd1[m0 + r] = 1.0f / sqrtf(s * (1.f / DM) + EPS); } } }
    { bf16_t* pb = (bf16_t*)(ws + WS_PB);
      for (int i0 = gt; i0 < T * PLE / 8; i0 += NGT * 4) { f32x4 a[4], b[4];
#pragma unroll
          for (int u = 0; u < 4; ++u) { const int i = i0 + u * NGT; if (i < T * PLE / 8) { a[u] = *(const f32x4*)(p + (size_t)i * 8); b[u] = *(const f32x4*)(p + (size_t)i * 8 + 4); } }
#pragma unroll
          for (int u = 0; u < 4; ++u) { const int i = i0 + u * NGT; if (i < T * PLE / 8) { v4u o; o.x = cvt_pk_bf16(a[u].x, a[u].y); o.y = cvt_pk_bf16(a[u].z, a[u].w); o.z = cvt_pk_bf16(b[u].x, b[u].y); o.w = cvt_pk_bf16(b[u].z, b[u].w); *(v4u*)(pb + (size_t)i * 8) = o; } } } }
    { float* ct = (float*)(ws + WS_COS); float* st = (float*)(ws + WS_SIN);
      for (int i = gt; i < T * 8; i += NGT) { const int t = i >> 3, j = i & 7; const double ang = (double)pos[t] * exp2(-(double)j * (18.931568569324174 / 8.0));
          ct[i] = (float)cos(ang); st[i] = (float)sin(ang); } }
}

namespace pg8 {
__device__ __forceinline__ size_t tp_off(int tile, int slot, int tid) { return ((size_t)tile * 16 + slot) * 8192 + (size_t)tid * 16; }
struct EpiProj {
    static constexpr bool PERM = true;
    unsigned char* ws; bf16_t* gates; const float* rstd; const float* b_a; const float* cost; const float* sint;
    __device__ __forceinline__ void operator()(const f32x4 (&acc)[2][2][4][2], const Unit& u, int wr, int wc, int fr, int fq) const {
        const int pn = u.pn, row0 = u.pm * BM + wr * 64 + fr, cl0 = wc * 32 + 8 * fq;
        int mode = 0, pitch = 512, cb = 0; unsigned char* dst = nullptr;
        if (pn == 0) { dst = ws + WS_GQ; pitch = 256; }
        else if (pn == 1) { dst = ws + WS_GK; pitch = 256; }
        else if (pn < 4) { dst = ws + WS_GV; cb = (pn - 2) * 256; }
        else if (pn < 6) { dst = ws + WS_SR; cb = (pn - 4) * 256; mode = 1; }
        else if (pn == 6) { dst = ws + WS_LA; pitch = 256; mode = 2; }
        else if (pn < 9) { dst = ws + WS_DQ; cb = (pn - 7) * 256; mode = 3; }
        else if (pn < 11) { dst = ws + WS_DK; cb = (pn - 9) * 256; mode = 3; }
        else if (pn < 13) { dst = ws + WS_DV; cb = (pn - 11) * 256; }
        else { dst = (unsigned char*)gates; pitch = 2048; cb = (pn - 13) * 256; mode = 4; }
#pragma unroll
        for (int ai = 0; ai < 2; ++ai)
#pragma unroll
            for (int m = 0; m < 4; ++m) {
                const int row = row0 + ai * HALF + m * 16; const float rs = rstd[row];
                f32x4 cs0, cs1, sn0, sn1;
                if (mode == 3) { cs0 = *(const f32x4*)(cost + (size_t)row * 8); cs1 = *(const f32x4*)(cost + (size_t)row * 8 + 4); sn0 = *(const f32x4*)(sint + (size_t)row * 8); sn1 = *(const f32x4*)(sint + (size_t)row * 8 + 4); }
#pragma unroll
                for (int bj = 0; bj < 2; ++bj) {
                    f32x4 v0 = acc[ai][bj][m][0] * rs, v1 = acc[ai][bj][m][1] * rs;
                    const int col = cb + bj * HALF + cl0;
                    if (mode == 2) {
                        const f32x4 b0 = *(const f32x4*)(b_a + col), b1 = *(const f32x4*)(b_a + col + 4);
                        v0 = v0 + b0; v1 = v1 + b1;
#pragma unroll
                        for (int i = 0; i < 4; ++i) { float xx = v0[i]; v0[i] = (fminf(xx, 0.f) - __builtin_amdgcn_logf(1.f + __builtin_amdgcn_exp2f(-fabsf(xx) * LOG2E)) * 0.6931471805599453f) * 0.0625f;
                                                      xx = v1[i]; v1[i] = (fminf(xx, 0.f) - __builtin_amdgcn_logf(1.f + __builtin_amdgcn_exp2f(-fabsf(xx) * LOG2E)) * 0.6931471805599453f) * 0.0625f; }
                        float* o = (float*)dst + (size_t)row * pitch + col; *(f32x4*)o = v0; *(f32x4*)(o + 4) = v1;
                        continue;
                    }
                    if (mode == 1) {
#pragma unroll
                        for (int i = 0; i < 4; ++i) { v0[i] = v0[i] * sigmoidf_(v0[i]); v1[i] = v1[i] * sigmoidf_(v1[i]); }
                    } else if (mode == 4) {
#pragma unroll
                        for (int i = 0; i < 4; ++i) { v0[i] = sigmoidf_(v0[i]); v1[i] = sigmoidf_(v1[i]); }
                    } else if (mode == 3) {
                        if ((wc & 1) == 0) {
                            f32x4 p0, p1;
#pragma unroll
                            for (int i = 0; i < 4; ++i) { p0[i] = __shfl_xor(v0[i], 16); p1[i] = __shfl_xor(v1[i], 16); }
                            if (fq == 0) { v0 = v0 * cs0 - p0 * sn0; v1 = v1 * cs1 - p1 * sn1; }
                            else if (fq == 1) { v0 = v0 * cs0 + p0 * sn0; v1 = v1 * cs1 + p1 * sn1; }
                        }
                    }
                    v4u w; w.x = cvt_pk_bf16(v0[0], v0[1]); w.y = cvt_pk_bf16(v0[2], v0[3]); w.z = cvt_pk_bf16(v1[0], v1[1]); w.w = cvt_pk_bf16(v1[2], v1[3]);
                    if (mode == 4) { const int pg = pn - 13; *(v4u*)((unsigned char*)gates + tp_off((pg >> 2) * 512 + u.pm * 4 + (pg & 3), (ai * 4 + m) * 2 + bj, (wr * 4 + wc) * 64 + fq * 16 + fr)) = w; }
                    else *(v4u*)((bf16_t*)dst + (size_t)row * pitch + col) = w;
                }
            }
    }
};
struct EpiProjStoreOnly {
    static constexpr bool PERM = true;
    unsigned char* ws; bf16_t* gates; const float* rstd;
    __device__ __forceinline__ void operator()(const f32x4 (&acc)[2][2][4][2], const Unit& u, int wr, int wc, int fr, int fq) const {
        const int pn = u.pn, row0 = u.pm * BM + wr * 64 + fr, cl0 = wc * 32 + 8 * fq;
        int pitch = 512, cb = 0; unsigned char* dst = nullptr; int f32out = 0;
        if (pn == 0) { dst = ws + WS_GQ; pitch = 256; }
        else if (pn == 1) { dst = ws + WS_GK; pitch = 256; }
        else if (pn < 4) { dst = ws + WS_GV; cb = (pn - 2) * 256; }
        else if (pn < 6) { dst = ws + WS_SR; cb = (pn - 4) * 256; }
        else if (pn == 6) { dst = ws + WS_LA; pitch = 256; f32out = 1; }
        else if (pn < 9) { dst = ws + WS_DQ; cb = (pn - 7) * 256; }
        else if (pn < 11) { dst = ws + WS_DK; cb = (pn - 9) * 256; }
        else if (pn < 13) { dst = ws + WS_DV; cb = (pn - 11) * 256; }
        else { dst = (unsigned char*)gates; pitch = 2048; cb = (pn - 13) * 256; }
#pragma unroll
        for (int ai = 0; ai < 2; ++ai)
#pragma unroll
            for (int m = 0; m < 4; ++m) { const int row = row0 + ai * HALF + m * 16; const float rs = rstd[row];
#pragma unroll
                for (int bj = 0; bj < 2; ++bj) { const f32x4 v0 = acc[ai][bj][m][0] * rs, v1 = acc[ai][bj][m][1] * rs; const int col = cb + bj * HALF + cl0;
                    if (f32out) { float* o = (float*)dst + (size_t)row * pitch + col; *(f32x4*)o = v0; *(f32x4*)(o + 4) = v1; }
                    else { v4u w; w.x = cvt_pk_bf16(v0[0], v0[1]); w.y = cvt_pk_bf16(v0[2], v0[3]); w.z = cvt_pk_bf16(v1[0], v1[1]); w.w = cvt_pk_bf16(v1[2], v1[3]);
                        *(v4u*)((bf16_t*)dst + (size_t)row * pitch + col) = w; } } }
    }
};
struct EpiPle {
    static constexpr bool PERM = true;
    bf16_t* er; float* sse;
    __device__ __forceinline__ void operator()(const f32x4 (&acc)[2][2][4][2], const Unit& u, int wr, int wc, int fr, int fq) const {
        const int row0 = u.pm * BM + wr * 64 + fr, col0 = u.pn * BM + wc * 32 + 8 * fq;
#pragma unroll
        for (int ai = 0; ai < 2; ++ai)
#pragma unroll
            for (int m = 0; m < 4; ++m) { const int row = row0 + ai * HALF + m * 16; float s = 0.f;
#pragma unroll
                for (int bj = 0; bj < 2; ++bj) { const f32x4 v0 = acc[ai][bj][m][0], v1 = acc[ai][bj][m][1];
                    s += (v0[0] * v0[0] + v0[1] * v0[1]) + (v0[2] * v0[2] + v0[3] * v0[3]) + (v1[0] * v1[0] + v1[1] * v1[1]) + (v1[2] * v1[2] + v1[3] * v1[3]);
                    v4u w; w.x = cvt_pk_bf16(v0[0], v0[1]); w.y = cvt_pk_bf16(v0[2], v0[3]); w.z = cvt_pk_bf16(v1[0], v1[1]); w.w = cvt_pk_bf16(v1[2], v1[3]);
                    *(v4u*)((unsigned char*)er + tp_off(u.pm * 4 + u.pn, (ai * 4 + m) * 2 + bj, (wr * 4 + wc) * 64 + fq * 16 + fr)) = w; }
                s += __shfl_xor(s, 16); s += __shfl_xor(s, 32);
                if (fq == 0) atomicAdd(sse + row, s); }
    }
};
}

namespace da {
constexpr int NW = 8, QBLK = 32, KVBLK = 64, QB = 128, PITCH = 512;
constexpr int SHM_V = KVBLK * 128 * 2, SHM_K = KVBLK * 128 * 2;
constexpr int OFF_WS = 2 * SHM_V + 2 * SHM_K, OFF_EX = OFF_WS + NW * 64 * 4, LDS_NEED = OFF_EX + 4 * 32 * 128 * 4;
constexpr float THRL = 11.5f;
#define KSWZ(row, colB) ((row) * 256 + ((colB) ^ (((row) & 7) << 4)))
#define SBAR() __builtin_amdgcn_sched_barrier(0)
__device__ __forceinline__ int v_st(int k, int c) { const int kk = (k & ~0xC) | ((k & 4) << 1) | ((k & 8) >> 1); return ((kk >> 3) * 4 + (c >> 5)) * 512 + ((kk & 7) * 32 + (c & 31)) * 2; }
__device__ __forceinline__ int v_rd_base(int lane) { return ((lane & 3) << 3) | (((lane >> 2) & 3) << 6) | (((lane >> 4) & 1) << 5) | (((lane >> 5) & 1) << 8); }
constexpr int v_rd_off(int d0, int ks, int half) { return d0 * 512 + ks * 4096 + half * 2048; }
__device__ __forceinline__ int crow(int r, int hi) { return (r & 3) + 8 * (r >> 2) + 4 * hi; }
__device__ __forceinline__ void mask_tile(f32x16& p0, f32x16& p1, int dq) {
    const float NEG = -__builtin_inff();
#pragma unroll
    for (int r = 0; r < 16; ++r) { const int c = (r & 3) + 8 * (r >> 2); if (dq - c < 0) p0[r] = NEG; if (dq - c - 32 < 0) p1[r] = NEG; }
}
__device__ __forceinline__ void partialSM(f32x16& p0, f32x16& p1, float& m_reg, float& mn, float& alpha) {
    float pmax = p0[0];
#pragma unroll
    for (int r = 1; r < 16; ++r) pmax = fmaxf(pmax, p0[r]);
#pragma unroll
    for (int r = 0; r < 16; ++r) pmax = fmaxf(pmax, p1[r]);
    { auto rr = __builtin_amdgcn_permlane32_swap(__float_as_uint(pmax), __float_as_uint(pmax), false, false); pmax = fmaxf(__uint_as_float(rr[0]), __uint_as_float(rr[1])); }
    if (__builtin_expect(__all((pmax - m_reg) <= THRL), 1)) { mn = m_reg; alpha = 1.f; }
    else { mn = fmaxf(m_reg, pmax); alpha = __builtin_amdgcn_exp2f(m_reg - mn); m_reg = mn; }
#pragma unroll
    for (int r = 0; r < 16; ++r) { p0[r] = p0[r] - mn; p1[r] = p1[r] - mn; }
#pragma unroll
    for (int r = 0; r < 16; ++r) p0[r] = __builtin_amdgcn_exp2f(p0[r]);
}
__device__ __forceinline__ void finishSM(f32x16& p0, f32x16& p1, float alpha, float& l_reg, bf16x8& pa0, bf16x8& pa1, bf16x8& pa2, bf16x8& pa3) {
#pragma unroll
    for (int r = 0; r < 16; ++r) p1[r] = __builtin_amdgcn_exp2f(p1[r]);
    float ps = 0;
#pragma unroll
    for (int r = 0; r < 16; ++r) ps += p0[r];
#pragma unroll
    for (int r = 0; r < 16; ++r) ps += p1[r];
    { auto rr = __builtin_amdgcn_permlane32_swap(__float_as_uint(ps), __float_as_uint(ps), false, false); ps = __uint_as_float(rr[0]) + __uint_as_float(rr[1]); }
    l_reg = l_reg * alpha + ps;
#define PK4(P, B_, OUT) do { unsigned a0 = cvt_pk_bf16(P[B_+0], P[B_+1]), a1 = cvt_pk_bf16(P[B_+2], P[B_+3]); unsigned b0 = cvt_pk_bf16(P[B_+4], P[B_+5]), b1 = cvt_pk_bf16(P[B_+6], P[B_+7]); \
        auto r0 = __builtin_amdgcn_permlane32_swap(a0, b0, false, false); auto r1 = __builtin_amdgcn_permlane32_swap(a1, b1, false, false); \
        v4u w = {r0[0], r1[0], r0[1], r1[1]}; OUT = *reinterpret_cast<bf16x8*>(&w); } while (0)
    PK4(p0, 0, pa0); PK4(p0, 8, pa1); PK4(p1, 0, pa2); PK4(p1, 8, pa3);
#undef PK4
}
template <int KB>
__device__ __forceinline__ void qkt(f32x16& p0, f32x16& p1, const char* K_lds, int r32, int hi, int comp, const bf16x8* qr) {
    p0 = f32x16{}; p1 = f32x16{};
#pragma unroll
    for (int dd = 0; dd < 4; ++dd) { const char* a = K_lds + KB * SHM_K + KSWZ(r32, (dd * 16 + hi * 8) * 2) + comp * 128;
        bf16x8 b0 = *reinterpret_cast<const bf16x8*>(a);
        bf16x8 b1 = *reinterpret_cast<const bf16x8*>(a + 32 * 256);
        p0 = __builtin_amdgcn_mfma_f32_32x32x16_bf16(b0, qr[dd], p0, 0, 0, 0);
        p1 = __builtin_amdgcn_mfma_f32_32x32x16_bf16(b1, qr[dd], p1, 0, 0, 0); }
}
template <int VB>
__device__ __forceinline__ void pv_tile(f32x16* o, int vb0, bf16x8 pa0, bf16x8 pa1, bf16x8 pa2, bf16x8 pa3) {
#define TRRD(dst, off) asm volatile("ds_read_b64_tr_b16 %0, %1 offset:%2" : "=&v"(dst) : "v"(vb0), "i"(off) : "memory")
#define PV_D0(d0) do { s16x4 l0, l1, l2, l3, h0, h1, h2, h3; constexpr int b_ = VB * SHM_V + v_rd_off(d0, 0, 0); \
        TRRD(l0, b_); TRRD(h0, b_ + 2048); TRRD(l1, b_ + 4096); TRRD(h1, b_ + 6144); TRRD(l2, b_ + 8192); TRRD(h2, b_ + 10240); TRRD(l3, b_ + 12288); TRRD(h3, b_ + 14336); \
        asm volatile("s_waitcnt lgkmcnt(0)" ::: "memory"); SBAR(); \
        o[d0] = __builtin_amdgcn_mfma_f32_32x32x16_bf16(pa0, (bf16x8){l0[0], l0[1], l0[2], l0[3], h0[0], h0[1], h0[2], h0[3]}, o[d0], 0, 0, 0); \
        o[d0] = __builtin_amdgcn_mfma_f32_32x32x16_bf16(pa1, (bf16x8){l1[0], l1[1], l1[2], l1[3], h1[0], h1[1], h1[2], h1[3]}, o[d0], 0, 0, 0); \
        o[d0] = __builtin_amdgcn_mfma_f32_32x32x16_bf16(pa2, (bf16x8){l2[0], l2[1], l2[2], l2[3], h2[0], h2[1], h2[2], h2[3]}, o[d0], 0, 0, 0); \
        o[d0] = __builtin_amdgcn_mfma_f32_32x32x16_bf16(pa3, (bf16x8){l3[0], l3[1], l3[2], l3[3], h3[0], h3[1], h3[2], h3[3]}, o[d0], 0, 0, 0); } while (0)
    PV_D0(0); PV_D0(1); PV_D0(2); PV_D0(3);
#undef PV_D0
#undef TRRD
}
__device__ __forceinline__ void attn_unit(const bf16_t* Qg, const bf16_t* Kg, const bf16_t* Vg, bf16_t* Og, int P0, float lam, const float* subln, char* lds) {
    int tid = threadIdx.x; asm volatile("" : "+v"(tid));
    const int wid = __builtin_amdgcn_readfirstlane(tid >> 6), lane = tid & 63, r32 = lane & 31, hi = lane >> 5;
    const int comp = wid & 1, rg = wid >> 1;
    const int NT = (P0 + QB - 1) / KVBLK + 1;
    const int qlo = P0 + rg * QBLK, qm = qlo + r32 - 4 * hi;
    char* V_lds = lds; char* K_lds = lds + 2 * SHM_V;
    float* wsf = (float*)(lds + OFF_WS) + wid * 64; float* li_l = wsf, * al_l = wsf + 32;
    float* exch = (float*)(lds + OFF_EX) + rg * (32 * 128);
    float m_reg = -1e30f, l_reg = 0; f32x16 o[4] = {};
    const int sr = tid >> 4, sc = (tid & 15) * 8, vst0 = v_st(sr, sc), vst1 = v_st(32 + sr, sc), kws = KSWZ(sr, sc * 2);
    const int vb0 = (int)(uintptr_t)V_lds + v_rd_base(lane);
    bf16x8 st_v0, st_v1, st_k0, st_k1;
#define ROW(p, k0, rr) ((p) + (size_t)((k0) + (rr)) * PITCH + sc)
#define LD8(p) (*reinterpret_cast<const bf16x8*>(p))
#define SLOAD_H(k0) do { st_v0 = LD8(ROW(Vg, k0, sr)); st_v1 = LD8(ROW(Vg, k0, 32 + sr)); st_k0 = LD8(ROW(Kg, k0, sr)); st_k1 = LD8(ROW(Kg, k0, 32 + sr)); } while (0)
#define SWRITE_HK(bf) do { *(bf16x8*)(K_lds + (bf) * SHM_K + kws) = st_k0; *(bf16x8*)(K_lds + (bf) * SHM_K + kws + 32 * 256) = st_k1; } while (0)
#define SWRITE_HV(bf) do { *(bf16x8*)(V_lds + (bf) * SHM_V + vst0) = st_v0; *(bf16x8*)(V_lds + (bf) * SHM_V + vst1) = st_v1; } while (0)
#define VMW() asm volatile("s_waitcnt vmcnt(0)" ::: "memory")
    bf16x8 qr[4];
#pragma unroll
    for (int dd = 0; dd < 4; ++dd) qr[dd] = LD8(Qg + (size_t)(qlo + r32) * PITCH + comp * 64 + dd * 16 + hi * 8);
    SLOAD_H(0); VMW(); SWRITE_HK(0); SWRITE_HV(0); SBAR();
    SLOAD_H(KVBLK);
    __syncthreads();
#define RESC(a) do { if (__any((a) < 1.f)) { if (hi == 0) al_l[r32] = (a); asm volatile("s_waitcnt lgkmcnt(0)" ::: "memory"); \
                     _Pragma("unroll") for (int d_ = 0; d_ < 4; ++d_) _Pragma("unroll") for (int r = 0; r < 16; ++r) o[d_][r] *= al_l[crow(r, hi)]; } } while (0)
#define KBASE(t) ((t) * KVBLK)
#define MASKT(P0_, P1_, t) do { const int kb_ = KBASE(t); if (kb_ + KVBLK - 1 > qlo) mask_tile(P0_, P1_, qm - kb_); } while (0)
    f32x16 pA0, pA1, pB0, pB1; float mnA, mnB, alA, alB; bf16x8 pa0, pa1, pa2, pa3;
    SBAR(); qkt<0>(pA0, pA1, K_lds, r32, hi, comp, qr);
    MASKT(pA0, pA1, 0); partialSM(pA0, pA1, m_reg, mnA, alA);
    VMW(); SWRITE_HK(1); SWRITE_HV(1);
    __syncthreads();
#define HALF_STEP(PX0, PX1, mnX, alX, PY0, PY1, alY, t, KB, VB, SB) do { \
        SBAR(); qkt<KB>(PX0, PX1, K_lds, r32, hi, comp, qr); \
        finishSM(PY0, PY1, alY, l_reg, pa0, pa1, pa2, pa3); SBAR(); \
        if ((t) + 1 < NT) { SLOAD_H(KBASE((t) + 1)); SBAR(); } \
        pv_tile<VB>(o, vb0, pa0, pa1, pa2, pa3); MASKT(PX0, PX1, (t)); partialSM(PX0, PX1, m_reg, mnX, alX); \
        __syncthreads(); \
        if ((t) + 1 < NT) { VMW(); SWRITE_HK(SB); SWRITE_HV(SB); } \
        RESC(alX); __syncthreads(); } while (0)
    for (int t = 1; t + 1 < NT; t += 2) {
        HALF_STEP(pB0, pB1, mnB, alB, pA0, pA1, alA, t, 1, 0, 0);
        HALF_STEP(pA0, pA1, mnA, alA, pB0, pB1, alB, t + 1, 0, 1, 1);
    }
    SBAR(); qkt<1>(pB0, pB1, K_lds, r32, hi, comp, qr); SBAR();
    finishSM(pA0, pA1, alA, l_reg, pa0, pa1, pa2, pa3); SBAR();
    pv_tile<0>(o, vb0, pa0, pa1, pa2, pa3);
    MASKT(pB0, pB1, NT - 1); partialSM(pB0, pB1, m_reg, mnB, alB); __syncthreads(); RESC(alB);
    finishSM(pB0, pB1, alB, l_reg, pa0, pa1, pa2, pa3); SBAR(); pv_tile<1>(o, vb0, pa0, pa1, pa2, pa3);
    if (hi == 0) li_l[r32] = l_reg; asm volatile("s_waitcnt lgkmcnt(0)" ::: "memory");
    float rli[16];
#pragma unroll
    for (int r = 0; r < 16; ++r) rli[r] = __builtin_amdgcn_rcpf(li_l[crow(r, hi)]);
    if (comp == 1) {
#pragma unroll
        for (int r = 0; r < 16; ++r) { const float f = rli[r] * lam;
#pragma unroll
            for (int d0 = 0; d0 < 4; ++d0) exch[crow(r, hi) * 128 + d0 * 32 + r32] = o[d0][r] * f; }
    }
    __syncthreads();
    if (comp == 0) {
        float gsc[4];
#pragma unroll
        for (int d0 = 0; d0 < 4; ++d0) gsc[d0] = subln[d0 * 32 + r32] * (1.f - LAMBDA_INIT);
#pragma unroll
        for (int r = 0; r < 16; ++r) { const int orow = crow(r, hi); float v[4]; float s = 0.f;
#pragma unroll
            for (int d0 = 0; d0 < 4; ++d0) { v[d0] = o[d0][r] * rli[r] - exch[orow * 128 + d0 * 32 + r32]; s += v[d0] * v[d0]; }
            s += __shfl_xor(s, 1); s += __shfl_xor(s, 2); s += __shfl_xor(s, 4); s += __shfl_xor(s, 8); s += __shfl_xor(s, 16);
            const float rs = 1.0f / sqrtf(s * (1.f / 128.f) + EPS);
#pragma unroll
            for (int d0 = 0; d0 < 4; ++d0) { const float w = v[d0] * rs * gsc[d0]; const float wn = __shfl_xor(w, 1);
                if ((r32 & 1) == 0) *(unsigned*)(Og + (size_t)(qlo + orow) * PITCH + d0 * 32 + r32) = cvt_pk_bf16(w, wn); } }
    }
    __syncthreads();
#undef ROW
#undef LD8
#undef SLOAD_H
#undef SWRITE_HK
#undef SWRITE_HV
#undef VMW
#undef RESC
#undef KBASE
#undef MASKT
#undef HALF_STEP
}
#undef KSWZ
#undef SBAR
}

namespace gla {
constexpr int PT = 144;
constexpr int L_QD = 0, L_KI = 9216, L_KIT = 18432, L_VT = 27648, L_SBT = 46080, L_ATT = 64512, L_DEC = 73728, LDS_NEED = 73984;
__device__ __forceinline__ float wave_scan(float x, int lane) {
#pragma unroll
    for (int off = 1; off < 64; off <<= 1) { const float y = __shfl_up(x, off); if (lane >= off) x += y; }
    return x;
}
__device__ __forceinline__ void gla_item(int b, int h, const bf16_t* gq, const bf16_t* gk, const bf16_t* gv, const bf16_t* sr, const float* la, const float* gnorm, bf16_t* oa, LAS unsigned char* lds) {
    int tid = threadIdx.x; asm volatile("" : "+v"(tid));
    const int w = __builtin_amdgcn_readfirstlane(tid >> 6), lane = tid & 63, l15 = lane & 15, lq = lane >> 4;
    const size_t tok0 = (size_t)b * SEQ;
    const bf16_t* qp = gq + (tok0 + lane) * 256 + h * 64 + 8 * w;
    const bf16_t* kp = gk + (tok0 + lane) * 256 + h * 64 + 8 * w;
    const float* lp = la + (tok0 + lane) * 256 + h * 64 + 8 * w;
    const bf16_t* vp = gv + (tok0 + lane) * 512 + h * 128 + 16 * w;
    f32x4 la0 = *(const f32x4*)lp, la1 = *(const f32x4*)(lp + 4);
    v4u q8 = *(const v4u*)qp, k8 = *(const v4u*)kp, v8a = *(const v4u*)vp, v8b = *(const v4u*)(vp + 8);
    f32x4 S[4][2];
#pragma unroll
    for (int i = 0; i < 4; ++i) { S[i][0] = (f32x4){0.f, 0.f, 0.f, 0.f}; S[i][1] = (f32x4){0.f, 0.f, 0.f, 0.f}; }
    const int sw = w - 4;
    for (int n = 0; n < SEQ / 64; ++n) {
        float bb[8] = {la0[0], la0[1], la0[2], la0[3], la1[0], la1[1], la1[2], la1[3]};
        unsigned qd[4], ki[4];
#pragma unroll
        for (int j = 0; j < 8; j += 2) {
            const float b0 = wave_scan(bb[j], lane), b1 = wave_scan(bb[j + 1], lane);
            const float e0 = __builtin_amdgcn_exp2f(b0 * LOG2E), e1 = __builtin_amdgcn_exp2f(b1 * LOG2E);
            const float i0 = __builtin_amdgcn_rcpf(e0), i1 = __builtin_amdgcn_rcpf(e1);
            const unsigned qw = q8[j >> 1], kw = k8[j >> 1];
            qd[j >> 1] = cvt_pk_bf16(bf_lo(qw) * e0, bf_hi(qw) * e1);
            ki[j >> 1] = cvt_pk_bf16(bf_lo(kw) * i0, bf_hi(kw) * i1);
            const float d0 = __shfl(e0, 63), d1 = __shfl(e1, 63);
            if (lane == 0) { *(LAS float*)(lds + L_DEC + (8 * w + j) * 4) = d0; *(LAS float*)(lds + L_DEC + (8 * w + j + 1) * 4) = d1; }
            *(LAS unsigned short*)(lds + L_KIT + (8 * w + j) * PT + lane * 2) = (unsigned short)(ki[j >> 1] & 0xffffu);
            *(LAS unsigned short*)(lds + L_KIT + (8 * w + j + 1) * PT + lane * 2) = (unsigned short)(ki[j >> 1] >> 16);
        }
        *(LAS v4u*)(lds + L_QD + lane * PT + 16 * w) = (v4u){qd[0], qd[1], qd[2], qd[3]};
        *(LAS v4u*)(lds + L_KI + lane * PT + 16 * w) = (v4u){ki[0], ki[1], ki[2], ki[3]};
#pragma unroll
        for (int i = 0; i < 4; ++i) {
            *(LAS unsigned short*)(lds + L_VT + (16 * w + 2 * i) * PT + lane * 2) = (unsigned short)(v8a[i] & 0xffffu);
            *(LAS unsigned short*)(lds + L_VT + (16 * w + 2 * i + 1) * PT + lane * 2) = (unsigned short)(v8a[i] >> 16);
            *(LAS unsigned short*)(lds + L_VT + (16 * w + 8 + 2 * i) * PT + lane * 2) = (unsigned short)(v8b[i] & 0xffffu);
            *(LAS unsigned short*)(lds + L_VT + (16 * w + 8 + 2 * i + 1) * PT + lane * 2) = (unsigned short)(v8b[i] >> 16);
        }
        if (w >= 4) {
#pragma unroll
            for (int db = 0; db < 4; ++db)
#pragma unroll
                for (int vb = 0; vb < 2; ++vb) { v2u o; o.x = cvt_pk_bf16(S[db][vb][0], S[db][vb][1]); o.y = cvt_pk_bf16(S[db][vb][2], S[db][vb][3]);
                    *(LAS v2u*)(lds + L_SBT + (32 * sw + 16 * vb + l15) * PT + (16 * db + 4 * lq) * 2) = o; }
        }
        __syncthreads();
        { const size_t adv = (n + 1 < SEQ / 64) ? (size_t)(n + 1) * 64 : (size_t)n * 64;
          la0 = *(const f32x4*)(lp + adv * 256); la1 = *(const f32x4*)(lp + adv * 256 + 4);
          q8 = *(const v4u*)(qp + adv * 256); k8 = *(const v4u*)(kp + adv * 256); v8a = *(const v4u*)(vp + adv * 512); v8b = *(const v4u*)(vp + adv * 512 + 8); }
        if (w < 4) {
            bf16x8 qf[2];
#pragma unroll
            for (int ks = 0; ks < 2; ++ks) qf[ks] = *(const LAS bf16x8*)(lds + L_QD + (16 * w + l15) * PT + (32 * ks + 8 * lq) * 2);
            const int c = 16 * w + l15;
#pragma unroll
            for (int sb = 0; sb < 4; ++sb) {
                f32x4 a = (f32x4){0.f, 0.f, 0.f, 0.f};
#pragma unroll
                for (int ks = 0; ks < 2; ++ks) { const bf16x8 kf = *(const LAS bf16x8*)(lds + L_KI + (16 * sb + l15) * PT + (32 * ks + 8 * lq) * 2);
                    a = __builtin_amdgcn_mfma_f32_16x16x32_bf16(kf, qf[ks], a, 0, 0, 0); }
#pragma unroll
                for (int r = 0; r < 4; ++r) if (16 * sb + 4 * lq + r > c) a[r] = 0.f;
                v2u o; o.x = cvt_pk_bf16(a[0], a[1]); o.y = cvt_pk_bf16(a[2], a[3]);
                *(LAS v2u*)(lds + L_ATT + w * 2304 + l15 * PT + (16 * sb + 4 * lq) * 2) = o;
            }
            asm volatile("s_waitcnt lgkmcnt(0)" ::: "memory");
            bf16x8 af[2];
#pragma unroll
            for (int ks = 0; ks < 2; ++ks) af[ks] = *(const LAS bf16x8*)(lds + L_ATT + w * 2304 + l15 * PT + (32 * ks + 8 * lq) * 2);
            f32x4 o[8]; float ssq = 0.f;
#pragma unroll
            for (int vb = 0; vb < 8; ++vb) {
                f32x4 a = (f32x4){0.f, 0.f, 0.f, 0.f};
#pragma unroll
                for (int ks = 0; ks < 2; ++ks) { const bf16x8 vf = *(const LAS bf16x8*)(lds + L_VT + (16 * vb + l15) * PT + (32 * ks + 8 * lq) * 2);
                    a = __builtin_amdgcn_mfma_f32_16x16x32_bf16(vf, af[ks], a, 0, 0, 0); }
#pragma unroll
                for (int ks = 0; ks < 2; ++ks) { const bf16x8 sf = *(const LAS bf16x8*)(lds + L_SBT + (16 * vb + l15) * PT + (32 * ks + 8 * lq) * 2);
                    a = __builtin_amdgcn_mfma_f32_16x16x32_bf16(sf, qf[ks], a, 0, 0, 0); }
                o[vb] = a; ssq += (a[0] * a[0] + a[1] * a[1]) + (a[2] * a[2] + a[3] * a[3]);
            }
            ssq += __shfl_xor(ssq, 16); ssq += __shfl_xor(ssq, 32);
            const float rs = 1.0f / sqrtf(ssq * (1.f / 128.f) + EPS);
            const size_t tok = tok0 + (size_t)n * 64 + c;
#pragma unroll
            for (int vb = 0; vb < 8; ++vb) { const int v = 16 * vb + 4 * lq;
                const f32x4 g = *(const f32x4*)(gnorm + v); const v2u r = *(const v2u*)(sr + tok * 512 + h * 128 + v);
                v2u w2; w2.x = cvt_pk_bf16(o[vb][0] * rs * g[0] * bf_lo(r.x), o[vb][1] * rs * g[1] * bf_hi(r.x));
                w2.y = cvt_pk_bf16(o[vb][2] * rs * g[2] * bf_lo(r.y), o[vb][3] * rs * g[3] * bf_hi(r.y));
                *(v2u*)(oa + tok * 512 + h * 128 + v) = w2; }
        } else {
#pragma unroll
            for (int ks = 0; ks < 2; ++ks) {
                bf16x8 vf[2];
#pragma unroll
                for (int vb = 0; vb < 2; ++vb) vf[vb] = *(const LAS bf16x8*)(lds + L_VT + (32 * sw + 16 * vb + l15) * PT + (32 * ks + 8 * lq) * 2);
#pragma unroll
                for (int db = 0; db < 4; ++db) { const bf16x8 kf = *(const LAS bf16x8*)(lds + L_KIT + (16 * db + l15) * PT + (32 * ks + 8 * lq) * 2);
#pragma unroll
                    for (int vb = 0; vb < 2; ++vb) S[db][vb] = __builtin_amdgcn_mfma_f32_16x16x32_bf16(kf, vf[vb], S[db][vb], 0, 0, 0); }
            }
#pragma unroll
            for (int db = 0; db < 4; ++db) { const f32x4 dc = *(const LAS f32x4*)(lds + L_DEC + (16 * db + 4 * lq) * 4); S[db][0] = S[db][0] * dc; S[db][1] = S[db][1] * dc; }
        }
        __syncthreads();
    }
}
}

namespace pg8 {
struct BranchOrder {
    StaticOrder so;
    __device__ __forceinline__ bool next(int i, Unit& u) const { Unit t; if (!so.next(i >> 1, t)) return false; u.pm = t.pm + (i & 1) * 128; u.pn = t.pn + (i & 1) * 4; return true; }
    __device__ __forceinline__ unsigned arow(const Unit&, int) const { return 0u; }
};
struct EpiBranch {
    static constexpr bool PERM = true;
    const bf16_t* gates; bf16_t* m1; bf16_t* mg;
    __device__ __forceinline__ void operator()(const f32x4 (&acc)[2][2][4][2], const Unit& u, int wr, int wc, int fr, int fq) const {
        const bool isb = u.pm >= 128; const int pm = isb ? u.pm - 128 : u.pm, pn = isb ? u.pn - 4 : u.pn;
        const int row0 = pm * BM + wr * 64 + fr, col0 = pn * BM + wc * 32 + 8 * fq, tid = (wr * 4 + wc) * 64 + fq * 16 + fr, tile = pm * 4 + pn;
        const unsigned char* gp = (const unsigned char*)gates + tp_off((isb ? 512 : 0) + tile, 0, tid); unsigned char* m1p = (unsigned char*)m1 + tp_off(tile, 0, tid);
        bf16_t* mp = mg + (size_t)row0 * DM + col0;
#pragma unroll
        for (int ai = 0; ai < 2; ++ai) {
            v4u G[4][2], Pm[4][2];
#pragma unroll
            for (int m = 0; m < 4; ++m)
#pragma unroll
                for (int bj = 0; bj < 2; ++bj) G[m][bj] = *(const v4u*)(gp + (size_t)((ai * 4 + m) * 2 + bj) * 8192);
            if (isb) {
#pragma unroll
                for (int m = 0; m < 4; ++m)
#pragma unroll
                    for (int bj = 0; bj < 2; ++bj) Pm[m][bj] = *(const v4u*)(m1p + (size_t)((ai * 4 + m) * 2 + bj) * 8192);
            } else {
#pragma unroll
                for (int m = 0; m < 4; ++m)
#pragma unroll
                    for (int bj = 0; bj < 2; ++bj) Pm[m][bj] = (v4u){0u, 0u, 0u, 0u};
            }
#pragma unroll
            for (int m = 0; m < 4; ++m)
#pragma unroll
                for (int bj = 0; bj < 2; ++bj) { const v4u g = G[m][bj], p = Pm[m][bj];
                    const f32x4 a0 = acc[ai][bj][m][0], a1 = acc[ai][bj][m][1];
                    const float r0 = a0[0] * bf_lo(g.x) + bf_lo(p.x), r1 = a0[1] * bf_hi(g.x) + bf_hi(p.x), r2 = a0[2] * bf_lo(g.y) + bf_lo(p.y), r3 = a0[3] * bf_hi(g.y) + bf_hi(p.y);
                    const float r4 = a1[0] * bf_lo(g.z) + bf_lo(p.z), r5 = a1[1] * bf_hi(g.z) + bf_hi(p.z), r6 = a1[2] * bf_lo(g.w) + bf_lo(p.w), r7 = a1[3] * bf_hi(g.w) + bf_hi(p.w);
                    v4u w; w.x = cvt_pk_bf16(r0, r1); w.y = cvt_pk_bf16(r2, r3); w.z = cvt_pk_bf16(r4, r5); w.w = cvt_pk_bf16(r6, r7);
                    if (isb) *(v4u*)(mp + (size_t)(ai * HALF + m * 16) * DM + bj * HALF) = w;
                    else *(v4u*)(m1p + (size_t)((ai * 4 + m) * 2 + bj) * 8192) = w; }
        }
    }
};
template <bool LOADS, bool STORES> struct EpiBranchProbe {
    static constexpr bool PERM = true;
    const bf16_t* gates; bf16_t* m1; bf16_t* mg;
    __device__ __forceinline__ void operator()(const f32x4 (&acc)[2][2][4][2], const Unit& u, int wr, int wc, int fr, int fq) const {
        const bool isb = u.pm >= 128; const int pm = isb ? u.pm - 128 : u.pm, pn = isb ? u.pn - 4 : u.pn;
        const int row0 = pm * BM + wr * 64 + fr, col0 = pn * BM + wc * 32 + 8 * fq, tid = (wr * 4 + wc) * 64 + fq * 16 + fr, tile = pm * 4 + pn;
        const unsigned char* gp = (const unsigned char*)gates + tp_off((isb ? 512 : 0) + tile, 0, tid); unsigned char* m1p = (unsigned char*)m1 + tp_off(tile, 0, tid);
        bf16_t* mp = mg + (size_t)row0 * DM + col0;
#pragma unroll
        for (int ai = 0; ai < 2; ++ai) {
            v4u G[4][2], Pm[4][2];
#pragma unroll
            for (int m = 0; m < 4; ++m)
#pragma unroll
                for (int bj = 0; bj < 2; ++bj) G[m][bj] = LOADS ? *(const v4u*)(gp + (size_t)((ai * 4 + m) * 2 + bj) * 8192) : (v4u){0x3f803f80u, 0x3f803f80u, 0x3f803f80u, 0x3f803f80u};
            if (isb && LOADS) {
#pragma unroll
                for (int m = 0; m < 4; ++m)
#pragma unroll
                    for (int bj = 0; bj < 2; ++bj) Pm[m][bj] = *(const v4u*)(m1p + (size_t)((ai * 4 + m) * 2 + bj) * 8192);
            } else {
#pragma unroll
                for (int m = 0; m < 4; ++m)
#pragma unroll
                    for (int bj = 0; bj < 2; ++bj) Pm[m][bj] = (v4u){0u, 0u, 0u, 0u};
            }
#pragma unroll
            for (int m = 0; m < 4; ++m)
#pragma unroll
                for (int bj = 0; bj < 2; ++bj) { const v4u g = G[m][bj], p = Pm[m][bj];
                    const f32x4 a0 = acc[ai][bj][m][0], a1 = acc[ai][bj][m][1];
                    const float r0 = a0[0] * bf_lo(g.x) + bf_lo(p.x), r1 = a0[1] * bf_hi(g.x) + bf_hi(p.x), r2 = a0[2] * bf_lo(g.y) + bf_lo(p.y), r3 = a0[3] * bf_hi(g.y) + bf_hi(p.y);
                    const float r4 = a1[0] * bf_lo(g.z) + bf_lo(p.z), r5 = a1[1] * bf_hi(g.z) + bf_hi(p.z), r6 = a1[2] * bf_lo(g.w) + bf_lo(p.w), r7 = a1[3] * bf_hi(g.w) + bf_hi(p.w);
                    v4u w; w.x = cvt_pk_bf16(r0, r1); w.y = cvt_pk_bf16(r2, r3); w.z = cvt_pk_bf16(r4, r5); w.w = cvt_pk_bf16(r6, r7);
                    if (STORES) { if (isb) *(v4u*)(mp + (size_t)(ai * HALF + m * 16) * DM + bj * HALF) = w;
                    else *(v4u*)(m1p + (size_t)((ai * 4 + m) * 2 + bj) * 8192) = w; }
                    else if (w.x == 0x12345678u && w.y == 0x9abcdef0u) *(v4u*)(m1p) = w; }
        }
    }
};
struct EpiNull { static constexpr bool PERM = true; float* sink;
    __device__ __forceinline__ void operator()(const f32x4 (&acc)[2][2][4][2], const Unit& u, int wr, int wc, int fr, int fq) const {
        float s = 0.f;
#pragma unroll
        for (int ai = 0; ai < 2; ++ai)
#pragma unroll
            for (int bj = 0; bj < 2; ++bj)
#pragma unroll
                for (int m = 0; m < 4; ++m)
#pragma unroll
                    for (int n = 0; n < 2; ++n) s += acc[ai][bj][m][n][0] + acc[ai][bj][m][n][1] + acc[ai][bj][m][n][2] + acc[ai][bj][m][n][3];
        if (s == 1.2345e-30f) *sink = s; } };
struct EpiOut {
    static constexpr bool PERM = true;
    const float* x; bf16_t* hb; float* ss;
    __device__ __forceinline__ void operator()(const f32x4 (&acc)[2][2][4][2], const Unit& u, int wr, int wc, int fr, int fq) const {
        const int row0 = u.pm * BM + wr * 64 + fr, col0 = u.pn * BM + wc * 32 + 8 * fq;
        const float* xp = x + (size_t)row0 * DM + col0; bf16_t* hp = hb + (size_t)row0 * DM + col0;
#pragma unroll
        for (int ai = 0; ai < 2; ++ai) {
            f32x4 X[4][2][2];
#pragma unroll
            for (int m = 0; m < 4; ++m)
#pragma unroll
                for (int bj = 0; bj < 2; ++bj) { const float* q = xp + (size_t)(ai * HALF + m * 16) * DM + bj * HALF; X[m][bj][0] = *(const f32x4*)q; X[m][bj][1] = *(const f32x4*)(q + 4); }
#pragma unroll
            for (int m = 0; m < 4; ++m) { float s = 0.f;
#pragma unroll
                for (int bj = 0; bj < 2; ++bj) { const f32x4 v0 = acc[ai][bj][m][0] + X[m][bj][0], v1 = acc[ai][bj][m][1] + X[m][bj][1];
                    s += (v0[0] * v0[0] + v0[1] * v0[1]) + (v0[2] * v0[2] + v0[3] * v0[3]) + (v1[0] * v1[0] + v1[1] * v1[1]) + (v1[2] * v1[2] + v1[3] * v1[3]);
                    v4u w; w.x = cvt_pk_bf16(v0[0], v0[1]); w.y = cvt_pk_bf16(v0[2], v0[3]); w.z = cvt_pk_bf16(v1[0], v1[1]); w.w = cvt_pk_bf16(v1[2], v1[3]);
                    *(v4u*)(hp + (size_t)(ai * HALF + m * 16) * DM + bj * HALF) = w; }
                s += __shfl_xor(s, 16); s += __shfl_xor(s, 32);
                if (fq == 0) atomicAdd(ss + row0 + ai * HALF + m * 16, s); }
        }
    }
};
template <int npn> struct MoeOrder {
    const LAS int* ts; const LAS int* cnt; const int* list; const float* lval; int G, c;
    __device__ __forceinline__ int expert_of(int tile) const { int e = 0;
#pragma unroll 1
        for (int i = 1; i < NEXP; ++i) if (ts[i] <= tile) e = i; return e; }
    __device__ __forceinline__ bool next(int i, Unit& u) const {
        const int L = i * G + c, total = ts[NEXP] * npn; if (L >= total) return false;
        const int tile = L / npn, pl = L % npn; u.pm = tile; u.pn = expert_of(tile) * npn + pl; return true; }
    __device__ __forceinline__ int entry(const Unit& u, int r) const { const int e = u.pn / npn, pos = (u.pm - ts[e]) * BM + r; return pos < cnt[e] ? list[(size_t)e * T + pos] : -1; }
    __device__ __forceinline__ unsigned arow(const Unit& u, int r) const { const int en = entry(u, r); return en < 0 ? 0u : (unsigned)(en >> 1); }
    __device__ __forceinline__ size_t lpos(const Unit& u, int r, bool& valid) const { const int e = u.pn / npn, pos = (u.pm - ts[e]) * BM + r; valid = pos < cnt[e]; return (size_t)e * T + (valid ? pos : 0); }
};
struct EpiUp {
    static constexpr bool PERM = true;
    MoeOrder<2> mo; bf16_t* he;
    __device__ __forceinline__ void operator()(const f32x4 (&acc)[2][2][4][2], const Unit& u, int wr, int wc, int fr, int fq) const {
        const int pl = u.pn & 1, col0 = pl * 128 + wc * 32 + 8 * fq;
        float rsv[2][4];
#pragma unroll
        for (int ai = 0; ai < 2; ++ai)
#pragma unroll
            for (int m = 0; m < 4; ++m) { bool valid; const size_t lp = mo.lpos(u, ai * HALF + wr * 64 + m * 16 + fr, valid); const float v = mo.lval[lp]; rsv[ai][m] = valid ? v : 0.f; }
#pragma unroll
        for (int ai = 0; ai < 2; ++ai)
#pragma unroll
            for (int m = 0; m < 4; ++m) { const int r = ai * HALF + wr * 64 + m * 16 + fr; const float rs = rsv[ai][m];
                const f32x4 g0 = acc[ai][0][m][0] * rs, g1 = acc[ai][0][m][1] * rs, u0 = acc[ai][1][m][0] * rs, u1 = acc[ai][1][m][1] * rs;
                v4u w; w.x = cvt_pk_bf16(g0[0] * sigmoidf_(g0[0]) * u0[0], g0[1] * sigmoidf_(g0[1]) * u0[1]); w.y = cvt_pk_bf16(g0[2] * sigmoidf_(g0[2]) * u0[2], g0[3] * sigmoidf_(g0[3]) * u0[3]);
                w.z = cvt_pk_bf16(g1[0] * sigmoidf_(g1[0]) * u1[0], g1[1] * sigmoidf_(g1[1]) * u1[1]); w.w = cvt_pk_bf16(g1[2] * sigmoidf_(g1[2]) * u1[2], g1[3] * sigmoidf_(g1[3]) * u1[3]);
                *(v4u*)(he + (size_t)(u.pm * BM + r) * DEXP + col0) = w; }
    }
};
struct EpiDown {
    static constexpr bool PERM = true;
    MoeOrder<4> mo; bf16_t* yb;
    __device__ __forceinline__ void operator()(const f32x4 (&acc)[2][2][4][2], const Unit& u, int wr, int wc, int fr, int fq) const {
        const int col0 = (u.pn & 3) * BM + wc * 32 + 8 * fq;
        float wv[2][4]; int env[2][4];
#pragma unroll
        for (int ai = 0; ai < 2; ++ai)
#pragma unroll
            for (int m = 0; m < 4; ++m) { bool valid; const size_t lp = mo.lpos(u, ai * HALF + wr * 64 + m * 16 + fr, valid); const float v = mo.lval[lp]; const int en = mo.list[lp]; wv[ai][m] = v; env[ai][m] = valid ? en : -1; }
#pragma unroll
        for (int ai = 0; ai < 2; ++ai)
#pragma unroll
            for (int m = 0; m < 4; ++m) { const int en = env[ai][m];
                if (en >= 0) { const float wt = wv[ai][m];
#pragma unroll
                    for (int bj = 0; bj < 2; ++bj) { const f32x4 v0 = acc[ai][bj][m][0] * wt, v1 = acc[ai][bj][m][1] * wt;
                        v4u w; w.x = cvt_pk_bf16(v0[0], v0[1]); w.y = cvt_pk_bf16(v0[2], v0[3]); w.z = cvt_pk_bf16(v1[0], v1[1]); w.w = cvt_pk_bf16(v1[2], v1[3]);
                        *(v4u*)(yb + (size_t)en * DM + col0 + bj * HALF) = w; } } }
    }
};
struct EpiFinal {
    static constexpr bool PERM = true;
    const bf16_t* h2b; const bf16_t* er; const float* sse; const float* gple; float* out; float* ssf;
    __device__ __forceinline__ void operator()(const f32x4 (&acc)[2][2][4][2], const Unit& u, int wr, int wc, int fr, int fq) const {
        const int row0 = u.pm * BM + wr * 64 + fr, col0 = u.pn * BM + wc * 32 + 8 * fq;
#pragma unroll
        for (int ai = 0; ai < 2; ++ai)
#pragma unroll
        for (int mh = 0; mh < 2; ++mh) {
            v4u H[2][2], Ee[2][2]; float rev[2];
#pragma unroll
            for (int mm = 0; mm < 2; ++mm) { const int m = mh * 2 + mm; rev[mm] = sse[row0 + ai * HALF + m * 16];
#pragma unroll
                for (int bj = 0; bj < 2; ++bj) { const size_t off = (size_t)(row0 + ai * HALF + m * 16) * DM + col0 + bj * HALF; H[mm][bj] = *(const v4u*)(h2b + off); Ee[mm][bj] = *(const v4u*)((const unsigned char*)er + tp_off(u.pm * 4 + u.pn, (ai * 4 + m) * 2 + bj, (wr * 4 + wc) * 64 + fq * 16 + fr)); } }
#pragma unroll
            for (int mm = 0; mm < 2; ++mm) { const int m = mh * 2 + mm; const int row = row0 + ai * HALF + m * 16; float s = 0.f; const float re = 1.0f / sqrtf(rev[mm] * (1.f / DM) + EPS);
#pragma unroll
                for (int bj = 0; bj < 2; ++bj) { const size_t off = (size_t)row * DM + col0 + bj * HALF;
                    const v4u hh = H[mm][bj], ee = Ee[mm][bj]; const f32x4 g0 = *(const f32x4*)(gple + col0 + bj * HALF) * re, g1 = *(const f32x4*)(gple + col0 + bj * HALF + 4) * re;
                    const f32x4 a0 = acc[ai][bj][m][0], a1 = acc[ai][bj][m][1]; f32x4 v0, v1;
                    v0[0] = bf_lo(hh.x) + sigmoidf_(a0[0]) * bf_lo(ee.x) * g0[0]; v0[1] = bf_hi(hh.x) + sigmoidf_(a0[1]) * bf_hi(ee.x) * g0[1];
                    v0[2] = bf_lo(hh.y) + sigmoidf_(a0[2]) * bf_lo(ee.y) * g0[2]; v0[3] = bf_hi(hh.y) + sigmoidf_(a0[3]) * bf_hi(ee.y) * g0[3];
                    v1[0] = bf_lo(hh.z) + sigmoidf_(a1[0]) * bf_lo(ee.z) * g1[0]; v1[1] = bf_hi(hh.z) + sigmoidf_(a1[1]) * bf_hi(ee.z) * g1[1];
                    v1[2] = bf_lo(hh.w) + sigmoidf_(a1[2]) * bf_lo(ee.w) * g1[2]; v1[3] = bf_hi(hh.w) + sigmoidf_(a1[3]) * bf_hi(ee.w) * g1[3];
                    s += (v0[0] * v0[0] + v0[1] * v0[1]) + (v0[2] * v0[2] + v0[3] * v0[3]) + (v1[0] * v1[0] + v1[1] * v1[1]) + (v1[2] * v1[2] + v1[3] * v1[3]);
                    *(f32x4*)(out + off) = v0; *(f32x4*)(out + off + 4) = v1; }
                s += __shfl_xor(s, 16); s += __shfl_xor(s, 32);
                if (fq == 0) atomicAdd(ssf + row, s); }
        }
    }
};
}

constexpr int WR_PT = 2064;
__device__ __forceinline__ void p4_router(const Frame& F, const Params& P) {
    unsigned char* ws = PWS(); unsigned* ctl = (unsigned*)(ws + WS_CTL);
    const bf16_t* hb = (const bf16_t*)(ws + WS_XB); const bf16_t* Wr = (const bf16_t*)(ws + WS_WR); const float* ss2 = (const float*)(ctl + CW_SS2);
    const float* b_rg = PIN(18); const float* b_re = PIN(20);
    int* list = (int*)(ws + WS_LIST); float* lrs = (float*)(ws + WS_LRS); float* lw = (float*)(ws + WS_LW);
    LAS unsigned char* lds = F.lds; const int lane = F.lane, w = F.wave, l15 = lane & 15, lq = lane >> 4;
    for (int i = F.tid; i < 48 * 128; i += NTHREADS) { const int r = i >> 7, c = i & 127; *(LAS v4u*)(lds + r * WR_PT + c * 16) = *(const v4u*)(Wr + (size_t)r * DM + c * 8); }
    LAS int* lcnt = (LAS int*)(lds + 100352);
    LAS float* lsc = (LAS float*)(lds + 101376) + w * (16 * 49);
    for (int grp = F.vcu * 8 + w; grp < T / 16; grp += F.G * 8) {
        if (F.tid < 64) lcnt[F.tid] = 0;
        __syncthreads();
        const int t0 = grp * 16;
        f32x4 a0 = {0.f, 0.f, 0.f, 0.f}, a1 = a0, a2 = a0;
        const bf16_t* hrow = hb + (size_t)(t0 + l15) * DM + 8 * lq;
#pragma unroll 4
        for (int ks = 0; ks < 32; ++ks) { const bf16x8 hf = *(const bf16x8*)(hrow + 32 * ks);
            const bf16x8 w0 = *(const LAS bf16x8*)(lds + (l15) * WR_PT + (32 * ks + 8 * lq) * 2), w1 = *(const LAS bf16x8*)(lds + (16 + l15) * WR_PT + (32 * ks + 8 * lq) * 2), w2 = *(const LAS bf16x8*)(lds + (32 + l15) * WR_PT + (32 * ks + 8 * lq) * 2);
            a0 = __builtin_amdgcn_mfma_f32_16x16x32_bf16(w0, hf, a0, 0, 0, 0); a1 = __builtin_amdgcn_mfma_f32_16x16x32_bf16(w1, hf, a1, 0, 0, 0); a2 = __builtin_amdgcn_mfma_f32_16x16x32_bf16(w2, hf, a2, 0, 0, 0); }
#pragma unroll
        for (int r = 0; r < 4; ++r) { lsc[l15 * 49 + 4 * lq + r] = a0[r]; lsc[l15 * 49 + 16 + 4 * lq + r] = a1[r]; lsc[l15 * 49 + 32 + 4 * lq + r] = a2[r]; }
        asm volatile("s_waitcnt lgkmcnt(0)" ::: "memory");
        int e0g = 0, e1g = 0, s0 = 0, s1 = 0; float w0 = 0.f, w1 = 0.f, rsk = 0.f;
        if (lane < 16) { const int t = t0 + lane; const float rs = 1.0f / sqrtf(ss2[t] * (1.f / DM) + EPS); rsk = rs; const LAS float* lg = lsc + lane * 49;
            int g = 0; float mg = lg[0] * rs + b_rg[0]; float gl[4]; gl[0] = mg;
#pragma unroll
            for (int i = 1; i < 4; ++i) { gl[i] = lg[i] * rs + b_rg[i]; if (gl[i] > mg) { mg = gl[i]; g = i; } }
            float sg = 0.f;
#pragma unroll
            for (int i = 0; i < 4; ++i) sg += __expf(gl[i] - mg);
            const float gp = 1.f / sg;
            float m0 = -INFINITY, m1 = -INFINITY; int i0 = 0, i1 = 0;
            for (int i = 0; i < 8; ++i) { const float v = lg[4 + g * 8 + i] * rs + b_re[g * 8 + i]; if (v > m0) { m1 = m0; i1 = i0; m0 = v; i0 = i; } else if (v > m1) { m1 = v; i1 = i; } }
            const float p1 = __expf(m1 - m0), inv = 1.f / (1.f + p1);
            e0g = g * 8 + i0; e1g = g * 8 + i1; w0 = gp * inv; w1 = gp * p1 * inv;
            s0 = atomicAdd((int*)&lcnt[e0g], 1); s1 = atomicAdd((int*)&lcnt[e1g], 1);
            }
        __syncthreads();
        if (F.tid < 32) { const int c = lcnt[F.tid]; lcnt[32 + F.tid] = c ? atomicAdd((int*)(ctl + CW_CNT + F.tid), c) : 0; }
        __syncthreads();
        if (lane < 16) { const int t = t0 + lane; const size_t p0 = (size_t)e0g * T + lcnt[32 + e0g] + s0, p1 = (size_t)e1g * T + lcnt[32 + e1g] + s1;
            list[p0] = t * 2; list[p1] = t * 2 + 1; lrs[p0] = rsk; lrs[p1] = rsk; lw[p0] = w0; lw[p1] = w1; }
        __syncthreads();
    }
}
__device__ __forceinline__ void moe_tables(const Frame& F, const unsigned* ctl) {
    LAS int* ts = (LAS int*)(F.lds + XTRA_OFF); LAS int* cnt = ts + 64;
    if (F.tid == 0) { int acc = 0; for (int e = 0; e < NEXP; ++e) { const int c = (int)__hip_atomic_load(ctl + CW_CNT + e, __ATOMIC_RELAXED, __HIP_MEMORY_SCOPE_AGENT); cnt[e] = c; ts[e] = acc; acc += (c + 255) >> 8; } ts[NEXP] = acc; }
    __syncthreads();
}

#ifndef PM
#define PM 0xfff
#endif
#ifndef PROBE
#define PROBE 0
#endif
#ifndef P1_ALIGN
#define P1_ALIGN true
#endif
__global__ void __launch_bounds__(NTHREADS, 2) fwd_megakernel(Params P) {
    extern __shared__ __attribute__((aligned(16))) unsigned char lds_raw[];
    Frame F;
    F.lds = (LAS unsigned char*)lds_raw;
    F.tid = threadIdx.x; F.lane = F.tid & 63; F.wave = __builtin_amdgcn_readfirstlane(F.tid >> 6);
    F.G = gridDim.x; { const int bx = blockIdx.x; F.vcu = (F.G % 8 == 0) ? (bx % 8) * (F.G / 8) + bx / 8 : bx; }
    { volatile LAS unsigned* st = (volatile LAS unsigned*)(F.lds + XTRA_OFF + 8192); if (F.tid < 2) st[F.tid] = 0u; }
    __syncthreads();
    const XcdBarrier gbar = xcd_barrier_post((unsigned*)(PWS() + WS_CTL) + CW_BAR, (volatile LAS unsigned*)(F.lds + XTRA_OFF + 8192));
#define GRID_SYNC() xcd_barrier(gbar)

    if (PM & 1) p0_prologue(F, P);
    GRID_SYNC();
#if PROBE == 7
    p0_prologue(F, P);
    GRID_SYNC();
#endif

#if PROBE == 11
    {
        unsigned char* ws = PWS(); bf16_t* gates = (bf16_t*)POUT();
        pg8::Gemm g{(const bf16_t*)(ws + WS_XB), (const bf16_t*)(ws + WS_WP), T, NPROJ, DM}; pg8::StaticOrder S; S.init(T, NPROJ, F.G, (int)blockIdx.x);
        pg8::EpiProjStoreOnly E{ws, gates, (const float*)(ws + WS_RSTD1)};
        pg8::gemm_phase<pg8::EpiProjStoreOnly, pg8::StaticOrder, true, false>(F.lds, g, S, E);
    }
    GRID_SYNC();
#endif
    if (PM & 2) {
        unsigned char* ws = PWS(); bf16_t* gates = (bf16_t*)POUT();
        pg8::Gemm g{(const bf16_t*)(ws + WS_XB), (const bf16_t*)(ws + WS_WP), T, NPROJ, DM}; pg8::StaticOrder S; S.init(T, NPROJ, F.G, (int)blockIdx.x);
        pg8::EpiProj E{ws, gates, (const float*)(ws + WS_RSTD1), PIN(6), (const float*)(ws + WS_COS), (const float*)(ws + WS_SIN)};
#ifdef STAGGER_US
        if ((int)blockIdx.x >= 128) { const unsigned long long t0 = __builtin_amdgcn_s_memrealtime(); while (__builtin_amdgcn_s_memrealtime() - t0 < (unsigned long long)(STAGGER_US * 100)) __builtin_amdgcn_s_sleep(32); }
#endif
        pg8::gemm_phase<pg8::EpiProj, pg8::StaticOrder, P1_ALIGN, false>(F.lds, g, S, E);
    }
#if PROBE == 3
    GRID_SYNC();
    if (PM & 2) {
        unsigned char* ws = PWS(); bf16_t* gates = (bf16_t*)POUT();
        pg8::Gemm g{(const bf16_t*)(ws + WS_XB), (const bf16_t*)(ws + WS_WP), T, NPROJ, DM}; pg8::StaticOrder S; S.init(T, NPROJ, F.G, (int)blockIdx.x);
        pg8::EpiProj E{ws, gates, (const float*)(ws + WS_RSTD1), PIN(6), (const float*)(ws + WS_COS), (const float*)(ws + WS_SIN)};
        pg8::gemm_phase<pg8::EpiProj, pg8::StaticOrder, true, false>(F.lds, g, S, E);
    }
#endif
#if PROBE == 9
    GRID_SYNC();
    {
        unsigned char* ws = PWS();
        pg8::Gemm g{(const bf16_t*)(ws + WS_XB), (const bf16_t*)(ws + WS_WP), T, NPROJ, DM}; pg8::StaticOrder S; S.init(T, NPROJ, F.G, (int)blockIdx.x);
        pg8::EpiNull E{(float*)(ws + WS_RSTD1)};
        pg8::gemm_phase<pg8::EpiNull, pg8::StaticOrder, true, false>(F.lds, g, S, E);
    }
#endif
#if PROBE == 10
    GRID_SYNC();
    {
        unsigned char* ws = PWS();
        pg8::Gemm g{(const bf16_t*)(ws + WS_XB), (const bf16_t*)(ws + WS_WAB), 2 * T, 2048, 512}; pg8::BranchOrder S; S.so.init(T, DM, F.G, (int)blockIdx.x);
        pg8::EpiNull E{(float*)(ws + WS_RSTD1)};
        pg8::gemm_phase<pg8::EpiNull, pg8::BranchOrder, true, false>(F.lds, g, S, E);
    }
#endif
    if (PM & 4) {
        unsigned char* ws = PWS(); unsigned* ctl = (unsigned*)(ws + WS_CTL);
        pg8::Gemm g{(const bf16_t*)(ws + WS_PB), (const bf16_t*)(ws + WS_WPLE), T, DM, PLE}; pg8::StaticOrder S; S.init(T, DM, F.G, (int)blockIdx.x);
        pg8::EpiPle E{(bf16_t*)(ws + WS_ER), (float*)(ctl + CW_SSE)};
        pg8::gemm_phase<pg8::EpiPle, pg8::StaticOrder, true, false>(F.lds, g, S, E);
    }
    GRID_SYNC();

    if (PM & 8) {
        unsigned char* ws = PWS(); unsigned* ctl = (unsigned*)(ws + WS_CTL);
        float lam;
        { float d1 = 0.f, d2 = 0.f; for (int i = 0; i < 64; ++i) { d1 += PIN(8)[i] * PIN(9)[i]; d2 += PIN(10)[i] * PIN(11)[i]; } lam = expf(d1) - expf(d2) + LAMBDA_INIT; }
        LAS int* qslot = (LAS int*)(F.lds + XTRA_OFF + 4096);
        bf16_t* oab = (bf16_t*)(ws + WS_XB);
#define P2_LOOP(QW, FIRST, LAST) \
        for (;;) { \
            __syncthreads(); \
            if (F.tid == 0) qslot[0] = (FIRST) + (int)atomicAdd(ctl + CW_QUEUE + (QW), 1u); \
            __syncthreads(); \
            const int item = qslot[0]; \
            if (item >= (LAST)) break; \
            if (item < 64) { \
                gla::gla_item(item >> 2, item & 3, (const bf16_t*)(ws + WS_GQ), (const bf16_t*)(ws + WS_GK), (const bf16_t*)(ws + WS_GV), (const bf16_t*)(ws + WS_SR), \
                              (const float*)(ws + WS_LA), PIN(7), oab, F.lds); \
            } else { \
                const int j = item - 64, qb = 15 - (j >> 6), bh = j & 63, b = bh >> 2, h = bh & 3; \
                const size_t base = (size_t)b * SEQ * 512 + h * 128; \
                da::attn_unit((const bf16_t*)(ws + WS_DQ) + base, (const bf16_t*)(ws + WS_DK) + base, (const bf16_t*)(ws + WS_DV) + base, \
                              oab + (size_t)T * 512 + base, qb * 128, lam, PIN(12), (char*)lds_raw); \
            } \
        }
#if PROBE == 1
        P2_LOOP(1, 0, 64) GRID_SYNC();
#elif PROBE == 2
        P2_LOOP(1, 64, 64 + 1024) GRID_SYNC();
#endif
        P2_LOOP(0, 0, 64 + 1024)
    }
    GRID_SYNC();

#if PROBE == 12 || PROBE == 13 || PROBE == 14
    {
        unsigned char* ws = PWS(); bf16_t* gates = (bf16_t*)POUT();
        pg8::Gemm g{(const bf16_t*)(ws + WS_XB), (const bf16_t*)(ws + WS_WAB), 2 * T, 2048, 512}; pg8::BranchOrder S; S.so.init(T, DM, F.G, (int)blockIdx.x);
#if PROBE == 12
        typedef pg8::EpiBranchProbe<true, true> EP;
#elif PROBE == 13
        typedef pg8::EpiBranchProbe<false, true> EP;
#else
        typedef pg8::EpiBranchProbe<true, false> EP;
#endif
        EP E{gates, (bf16_t*)(ws + WS_DQ), (bf16_t*)(ws + WS_MG)};
        pg8::gemm_phase<EP, pg8::BranchOrder, true, false>(F.lds, g, S, E);
    }
    GRID_SYNC();
#endif
    if (PM & 16) {
        unsigned char* ws = PWS(); bf16_t* gates = (bf16_t*)POUT();
        pg8::Gemm g{(const bf16_t*)(ws + WS_XB), (const bf16_t*)(ws + WS_WAB), 2 * T, 2048, 512}; pg8::BranchOrder S; S.so.init(T, DM, F.G, (int)blockIdx.x);
        pg8::EpiBranch E{gates, (bf16_t*)(ws + WS_DQ), (bf16_t*)(ws + WS_MG)};
        pg8::gemm_phase<pg8::EpiBranch, pg8::BranchOrder, true, false>(F.lds, g, S, E);
    }
    GRID_SYNC();
#if PROBE == 4
    if (PM & 16) {
        unsigned char* ws = PWS(); bf16_t* gates = (bf16_t*)POUT();
        pg8::Gemm g{(const bf16_t*)(ws + WS_XB), (const bf16_t*)(ws + WS_WAB), 2 * T, 2048, 512}; pg8::BranchOrder S; S.so.init(T, DM, F.G, (int)blockIdx.x);
        pg8::EpiBranch E{gates, (bf16_t*)(ws + WS_DQ), (bf16_t*)(ws + WS_MG)};
        pg8::gemm_phase<pg8::EpiBranch, pg8::BranchOrder, true, false>(F.lds, g, S, E);
    }
    GRID_SYNC();
#endif

    if (PM & 32) {
        unsigned char* ws = PWS(); unsigned* ctl = (unsigned*)(ws + WS_CTL);
        pg8::Gemm g{(const bf16_t*)(ws + WS_MG), (const bf16_t*)(ws + WS_WO), T, DM, DM}; pg8::StaticOrder S; S.init(T, DM, F.G, (int)blockIdx.x);
        pg8::EpiOut E{PIN(0), (bf16_t*)(ws + WS_XB), (float*)(ctl + CW_SS2)};
        pg8::gemm_phase<pg8::EpiOut, pg8::StaticOrder, true, false>(F.lds, g, S, E);
    }
    GRID_SYNC();

    if (PM & 64) p4_router(F, P);
    GRID_SYNC();

    moe_tables(F, (const unsigned*)(PWS() + WS_CTL));
    if (PM & 128) {
        unsigned char* ws = PWS(); unsigned* ctl = (unsigned*)(ws + WS_CTL);
        pg8::MoeOrder<2> mo{(const LAS int*)(F.lds + XTRA_OFF), (const LAS int*)(F.lds + XTRA_OFF) + 64, (const int*)(ws + WS_LIST), (const float*)(ws + WS_LRS), F.G, (int)blockIdx.x};
        pg8::Gemm g{(const bf16_t*)(ws + WS_XB), (const bf16_t*)(ws + WS_WGU), T, NEXP * 512, DM};
        pg8::EpiUp E{mo, (bf16_t*)(ws + WS_HE)};
        pg8::gemm_phase<pg8::EpiUp, pg8::MoeOrder<2>, true, true>(F.lds, g, mo, E);
    }
    GRID_SYNC();
#if PROBE == 5
    if (PM & 128) {
        unsigned char* ws = PWS(); unsigned* ctl = (unsigned*)(ws + WS_CTL);
        pg8::MoeOrder<2> mo{(const LAS int*)(F.lds + XTRA_OFF), (const LAS int*)(F.lds + XTRA_OFF) + 64, (const int*)(ws + WS_LIST), (const float*)(ws + WS_LRS), F.G, (int)blockIdx.x};
        pg8::Gemm g{(const bf16_t*)(ws + WS_XB), (const bf16_t*)(ws + WS_WGU), T, NEXP * 512, DM};
        pg8::EpiUp E{mo, (bf16_t*)(ws + WS_HE)};
        pg8::gemm_phase<pg8::EpiUp, pg8::MoeOrder<2>, true, true>(F.lds, g, mo, E);
    }
    GRID_SYNC();
#endif
    if (PM & 256) {
        unsigned char* ws = PWS();
        pg8::MoeOrder<4> mo{(const LAS int*)(F.lds + XTRA_OFF), (const LAS int*)(F.lds + XTRA_OFF) + 64, (const int*)(ws + WS_LIST), (const float*)(ws + WS_LW), F.G, (int)blockIdx.x};
        pg8::Gemm g{(const bf16_t*)(ws + WS_HE), (const bf16_t*)(ws + WS_WD), MOE_ROWS, NEXP * 1024, DEXP};
        pg8::EpiDown E{mo, (bf16_t*)(ws + WS_YB)};
        pg8::gemm_phase<pg8::EpiDown, pg8::MoeOrder<4>, true, false>(F.lds, g, mo, E);
    }
    GRID_SYNC();
#if PROBE == 6
    if (PM & 256) {
        unsigned char* ws = PWS();
        pg8::MoeOrder<4> mo{(const LAS int*)(F.lds + XTRA_OFF), (const LAS int*)(F.lds + XTRA_OFF) + 64, (const int*)(ws + WS_LIST), (const float*)(ws + WS_LW), F.G, (int)blockIdx.x};
        pg8::Gemm g{(const bf16_t*)(ws + WS_HE), (const bf16_t*)(ws + WS_WD), MOE_ROWS, NEXP * 1024, DEXP};
        pg8::EpiDown E{mo, (bf16_t*)(ws + WS_YB)};
        pg8::gemm_phase<pg8::EpiDown, pg8::MoeOrder<4>, true, false>(F.lds, g, mo, E);
    }
    GRID_SYNC();
#endif
    if (PM & 512) {
        unsigned char* ws = PWS();
        const bf16_t* hb = (const bf16_t*)(ws + WS_XB); const bf16_t* yb = (const bf16_t*)(ws + WS_YB); bf16_t* h2b = (bf16_t*)(ws + WS_H2B);
        const int gt = F.vcu * NTHREADS + F.tid, NGT = F.G * NTHREADS;
        for (int i = gt; i < T * DM / 8; i += NGT) { const int t = i >> 7, c = (i & 127) * 8;
            const v4u a = *(const v4u*)(hb + (size_t)t * DM + c), y0 = *(const v4u*)(yb + (size_t)(2 * t) * DM + c), y1 = *(const v4u*)(yb + (size_t)(2 * t + 1) * DM + c);
            v4u o; o.x = cvt_pk_bf16(bf_lo(a.x) + bf_lo(y0.x) + bf_lo(y1.x), bf_hi(a.x) + bf_hi(y0.x) + bf_hi(y1.x)); o.y = cvt_pk_bf16(bf_lo(a.y) + bf_lo(y0.y) + bf_lo(y1.y), bf_hi(a.y) + bf_hi(y0.y) + bf_hi(y1.y));
            o.z = cvt_pk_bf16(bf_lo(a.z) + bf_lo(y0.z) + bf_lo(y1.z), bf_hi(a.z) + bf_hi(y0.z) + bf_hi(y1.z)); o.w = cvt_pk_bf16(bf_lo(a.w) + bf_lo(y0.w) + bf_lo(y1.w), bf_hi(a.w) + bf_hi(y0.w) + bf_hi(y1.w));
            *(v4u*)(h2b + (size_t)t * DM + c) = o; }
    }
    GRID_SYNC();
#if PROBE == 8
    if (PM & 512) {
        unsigned char* ws = PWS();
        const bf16_t* hb = (const bf16_t*)(ws + WS_XB); const bf16_t* yb = (const bf16_t*)(ws + WS_YB); bf16_t* h2b = (bf16_t*)(ws + WS_H2B);
        const int gt = F.vcu * NTHREADS + F.tid, NGT = F.G * NTHREADS;
        for (int i = gt; i < T * DM / 8; i += NGT) { const int t = i >> 7, c = (i & 127) * 8;
            const v4u a = *(const v4u*)(hb + (size_t)t * DM + c), y0 = *(const v4u*)(yb + (size_t)(2 * t) * DM + c), y1 = *(const v4u*)(yb + (size_t)(2 * t + 1) * DM + c);
            v4u o; o.x = cvt_pk_bf16(bf_lo(a.x) + bf_lo(y0.x) + bf_lo(y1.x), bf_hi(a.x) + bf_hi(y0.x) + bf_hi(y1.x)); o.y = cvt_pk_bf16(bf_lo(a.y) + bf_lo(y0.y) + bf_lo(y1.y), bf_hi(a.y) + bf_hi(y0.y) + bf_hi(y1.y));
            o.z = cvt_pk_bf16(bf_lo(a.z) + bf_lo(y0.z) + bf_lo(y1.z), bf_hi(a.z) + bf_hi(y0.z) + bf_hi(y1.z)); o.w = cvt_pk_bf16(bf_lo(a.w) + bf_lo(y0.w) + bf_lo(y1.w), bf_hi(a.w) + bf_hi(y0.w) + bf_hi(y1.w));
            *(v4u*)(h2b + (size_t)t * DM + c) = o; }
    }
    GRID_SYNC();
#endif
    if (PM & 1024) {
        unsigned char* ws = PWS(); unsigned* ctl = (unsigned*)(ws + WS_CTL);
        pg8::Gemm g{(const bf16_t*)(ws + WS_H2B), (const bf16_t*)(ws + WS_WPG), T, DM, DM}; pg8::StaticOrder S; S.init(T, DM, F.G, (int)blockIdx.x);
        pg8::EpiFinal E{(const bf16_t*)(ws + WS_H2B), (const bf16_t*)(ws + WS_ER), (const float*)(ctl + CW_SSE), PIN(25), POUT(), (float*)(ctl + CW_SSF)};
        pg8::gemm_phase<pg8::EpiFinal, pg8::StaticOrder, true, false>(F.lds, g, S, E);
    }
    GRID_SYNC();
    if (PM & 2048) {
        unsigned char* ws = PWS(); unsigned* ctl = (unsigned*)(ws + WS_CTL);
        const float* ssf = (const float*)(ctl + CW_SSF); const float* gf = PIN(27); float* out = POUT();
        const int gt = F.vcu * NTHREADS + F.tid, NGT = F.G * NTHREADS;
        for (int i = gt; i < T * DM / 4; i += NGT) { const int t = i >> 8, c = (i & 255) * 4; const float rs = 1.0f / sqrtf(ssf[t] * (1.f / DM) + EPS);
            f32x4 v = *(f32x4*)(out + (size_t)t * DM + c); const f32x4 g = *(const f32x4*)(gf + c); v = v * g * rs; *(f32x4*)(out + (size_t)t * DM + c) = v; }
    }
}

extern "C" void kernel_launch(void* const* d_in, const int* in_sizes, int n_in, void* d_out, int out_size, void* d_ws, size_t ws_size, hipStream_t stream) {
    static int grid = 0;
    if (grid == 0) {
        if (n_in != 28 || out_size != T * DM || ws_size < WS_END) { fprintf(stderr, "kernel_launch: unexpected shapes (n_in %d, out %d, ws %zu < %zu)\n", n_in, out_size, ws_size, (size_t)WS_END); grid = -1; return; }
        int dev = 0, cus = 0, per_cu = 0;
        hipGetDevice(&dev); hipDeviceGetAttribute(&cus, hipDeviceAttributeMultiprocessorCount, dev);
        if (hipFuncSetAttribute((const void*)fwd_megakernel, hipFuncAttributeMaxDynamicSharedMemorySize, LDS_BYTES) != hipSuccess) { fprintf(stderr, "kernel_launch: hipFuncSetAttribute failed\n"); grid = -1; return; }
        if (hipOccupancyMaxActiveBlocksPerMultiprocessor(&per_cu, (const void*)fwd_megakernel, NTHREADS, LDS_BYTES) != hipSuccess || per_cu < 1) { fprintf(stderr, "kernel_launch: occupancy query says %d blocks/CU\n", per_cu); grid = -1; return; }
        grid = cus;
        fprintf(stderr, "kernel_launch: cus %d per_cu %d grid %d ws %zu\n", cus, per_cu, grid, ws_size);
    }
    if (grid < 0) return;
    hipMemsetAsync((char*)d_ws + WS_CTL, 0, CTL_ZERO_BYTES, stream);
    Params p{};
    for (int i = 0; i < 28; ++i) p.p[i] = d_in[i];
    p.p[28] = d_out; p.p[29] = d_ws;
    void* args[] = {&p};
    hipError_t e = hipLaunchCooperativeKernel((const void*)fwd_megakernel, dim3(grid), dim3(NTHREADS), args, LDS_BYTES, stream);
    if (e != hipSuccess) fprintf(stderr, "cooperative launch failed: %s (grid %d)\n", hipGetErrorString(e), grid);
}
```

```cpp
#include <hip/hip_runtime.h>
#include <hip/hip_cooperative_groups.h>
#include <hip/hip_bf16.h>
#include <cstdio>
#include <cstdint>
#include <cmath>
namespace cg = cooperative_groups;

constexpr int NB = 16, SEQ = 2048, DM = 1024, T = NB * SEQ, DIN = 5136, NPROJ = 5376, PLE = 256;
constexpr int NEXP = 32, DEXP = 256;
constexpr float EPS = 1e-6f;
constexpr float LOG2E = 1.4426950408889634f;
constexpr float QSCALE2 = 0.125f * LOG2E;
constexpr float LAMBDA_INIT = 0.2f;
constexpr int C_Q = 0, C_K = 256, C_V = 512, C_R = 1024, C_AL = 1536, C_DQ = 1552, C_DK = 2064, C_DV = 2576, C_GA = 3088, C_GB = 4112;
constexpr int P_Q = 0, P_K = 256, P_V = 512, P_R = 1024, P_AL = 1536, P_DQ = 1792, P_DK = 2304, P_DV = 2816, P_GA = 3328, P_GB = 4352;

constexpr size_t MiB = 1u << 20;
constexpr size_t WS_CTL = 0, CTL_ZERO_BYTES = 1 * MiB;
constexpr int CW_CNT = 64;
constexpr int CW_QUEUE = 128;
constexpr int CW_BAR = 4096;
constexpr int CW_SS2 = 65536;
constexpr int CW_SSE = 65536 + 32768;
constexpr int CW_SSF = 65536 + 65536;
static_assert((CW_SSF + 32768) * 4 <= (int)CTL_ZERO_BYTES, "ctl");
constexpr size_t WS_RSTD1 = 1 * MiB;
constexpr size_t WS_TOKE = 1 * MiB + 256 * 1024;
constexpr size_t WS_TOKW = 1 * MiB + 512 * 1024;
constexpr size_t WS_COS = 2 * MiB, WS_SIN = 3 * MiB;
constexpr size_t WS_LIST = 4 * MiB;
constexpr size_t WS_LRS = 138 * MiB + 16 * MiB - 8 * MiB;
constexpr size_t WS_LW = WS_LRS + 4 * MiB;
constexpr size_t WS_WP = 8 * MiB;
constexpr size_t WS_WGU = 19 * MiB;
constexpr size_t WS_WD = 51 * MiB;
constexpr size_t WS_WAB = 67 * MiB;
constexpr size_t WS_WO = 69 * MiB;
constexpr size_t WS_WPG = 71 * MiB;
constexpr size_t WS_WPLE = 73 * MiB;
constexpr size_t WS_WR = 73 * MiB + 512 * 1024;
constexpr size_t WS_XB = 74 * MiB;
constexpr size_t WS_PB = 138 * MiB;
constexpr size_t WS_ER = 154 * MiB;
constexpr size_t WS_GQ = 218 * MiB, WS_GK = 234 * MiB, WS_GV = 250 * MiB, WS_SR = 282 * MiB, WS_LA = 314 * MiB, WS_DQ = 346 * MiB, WS_DK = 378 * MiB, WS_DV = 410 * MiB;
constexpr size_t WS_MG = 218 * MiB;
constexpr size_t WS_H2B = 282 * MiB;
constexpr size_t WS_YB = 346 * MiB;
constexpr size_t WS_HE = 474 * MiB;
constexpr size_t WS_END = 512 * MiB;
constexpr int MOE_ROWS = 2 * T + NEXP * 256;
static_assert(WS_HE + (size_t)MOE_ROWS * DEXP * 2 <= WS_END, "ws");

constexpr int RING_BYTES = 131072;
constexpr int XTRA_OFF = RING_BYTES;
constexpr int LDS_BYTES = RING_BYTES + 20480;
constexpr int NTHREADS = 512;

#define GAS __attribute__((address_space(1)))
#define LAS __attribute__((address_space(3)))
typedef unsigned short bf16_t;
typedef unsigned v4u __attribute__((ext_vector_type(4)));
typedef unsigned v2u __attribute__((ext_vector_type(2)));
typedef float f32x4 __attribute__((ext_vector_type(4)));
typedef float f32x2 __attribute__((ext_vector_type(2)));
typedef float f32x16 __attribute__((ext_vector_type(16)));
typedef short bf16x8 __attribute__((ext_vector_type(8)));
typedef short s16x4 __attribute__((ext_vector_type(4)));

__device__ __forceinline__ unsigned cvt_pk_bf16(float lo, float hi) { unsigned r; asm volatile("v_cvt_pk_bf16_f32 %0, %1, %2" : "=v"(r) : "v"(lo), "v"(hi)); return r; }
__device__ __forceinline__ float bf_lo(unsigned w) { return __uint_as_float(w << 16); }
__device__ __forceinline__ float bf_hi(unsigned w) { return __uint_as_float(w & 0xffff0000u); }
__device__ __forceinline__ float sigmoidf_(float x) { return __builtin_amdgcn_rcpf(1.f + __builtin_amdgcn_exp2f(-x * LOG2E)); }
__device__ __forceinline__ float wave_sum(float v) {
#pragma unroll
    for (int o = 1; o < 64; o <<= 1) v += __shfl_xor(v, o);
    return v;
}

namespace pg8 {
constexpr int BM = 256, BK = 64, HALF = 128, HTB = HALF * BK * 2, STAGE_BYTES = 8 * HTB, NXCD = 8, WGM = 8;
__host__ __device__ __forceinline__ int lds_byte(int r, int c) { const int st = (r >> 4) * 2 + (c >> 5), rr = r & 15, cc = c & 31, ob = rr * 64 + cc * 2; return st * 1024 + (ob ^ (((ob >> 9) & 1) << 5)); }
__host__ __device__ __forceinline__ void stage_rc(int b, int& R, int& C) { const int st = b / 1024, sb = b % 1024, swz = sb ^ (((sb >> 9) & 1) << 5); R = (st >> 1) * 16 + swz / 64; C = (st & 1) * 32 + (swz % 64) / 2; }
__host__ __device__ __forceinline__ int perm32(int rho) { const int n = rho >> 4, i = rho & 15; return 8 * (i >> 2) + 4 * n + (i & 3); }
struct Unit { int pm, pn; };
struct Gemm { const bf16_t* A; const bf16_t* Bt; int M, N, K; };
struct StaticOrder {
    int nM, nN, nwg, G, c;
    __host__ __device__ void init(int M, int N, int G_, int c_) { nM = M / BM; nN = N / BM; nwg = nM * nN; G = G_; c = c_; }
    __host__ __device__ bool next(int i, Unit& u) const {
        const long L = (long)i * G + c; if (L >= nwg) return false;
        int wgid = (int)L; { const int q = nwg / NXCD, r = nwg % NXCD, xcd = wgid % NXCD, off = wgid / NXCD; wgid = (xcd < r ? xcd * (q + 1) : r * (q + 1) + (xcd - r) * q) + off; }
        const int nig = WGM * nN, gid = wgid / nig, fm = gid * WGM, gsz = (nM - fm) < WGM ? (nM - fm) : WGM;
        u.pm = fm + ((wgid % nig) % gsz); u.pn = (wgid % nig) / gsz; return true;
    }
    __device__ __forceinline__ unsigned arow(const Unit&, int) const { return 0u; }
};

template <class Epi, class Sched, bool ALIGN_EPI, bool GATHER>
__device__ __forceinline__ void gemm_phase(LAS unsigned char* lds, const Gemm g, const Sched& S, const Epi& E) {
    int tid = threadIdx.x; asm volatile("" : "+v"(tid));
    const int wid = __builtin_amdgcn_readfirstlane(tid >> 6), lane = tid & 63, wr = wid >> 2, wc = wid & 3, fr = lane & 15, fq = lane >> 4;
    const int K = g.K, nt = K / BK;
    unsigned voffB[2]; int RA[2], CA[2];
#pragma unroll
    for (int i = 0; i < 2; ++i) { int R, C; stage_rc(tid * 16 + i * 8192, R, C); const int Rb = Epi::PERM ? ((R & ~31) + perm32(R & 31)) : R;
        RA[i] = R; CA[i] = C; voffB[i] = (unsigned)(Rb * K + C) * 2u; }
    const size_t kstep = (size_t)(BK * 2);
    const size_t hstep = (size_t)HALF * K * 2;
    const size_t tstep = 2 * hstep;
    const unsigned ldsw = (unsigned)wid * 1024u;
    const int aoff = lds_byte(wr * 64 + fr, fq * 8), boff = lds_byte(wc * 32 + fr, fq * 8);
#define PG8_SA(b, h) (((b) * 2 + (h)) * HTB)
#define PG8_SB(b, h) ((4 + (b) * 2 + (h)) * HTB)
#define PG8_STAGE(bufoff, gbase, voff) do { _Pragma("unroll") for (int _i = 0; _i < 2; ++_i) \
        __builtin_amdgcn_global_load_lds((const unsigned*)((const char*)(gbase) + (voff)[_i]), (LAS unsigned*)(lds + (bufoff) + ldsw + _i * 8192), 16, 0, 0); } while (0)
#define PG8_STA(bufoff, gbase, v0, v1) do { \
        __builtin_amdgcn_global_load_lds((const unsigned*)((const char*)(gbase) + (v0)), (LAS unsigned*)(lds + (bufoff) + ldsw), 16, 0, 0); \
        __builtin_amdgcn_global_load_lds((const unsigned*)((const char*)(gbase) + (v1)), (LAS unsigned*)(lds + (bufoff) + ldsw + 8192), 16, 0, 0); } while (0)
#define PG8_LDA(dst, b, h) do { _Pragma("unroll") for (int m = 0; m < 4; ++m) _Pragma("unroll") for (int k = 0; k < 2; ++k) dst[m][k] = *(const LAS bf16x8*)(lds + PG8_SA(b, h) + aoff + m * 2048 + k * 1024); } while (0)
#define PG8_LDB(dst, b, h) do { _Pragma("unroll") for (int n = 0; n < 2; ++n) _Pragma("unroll") for (int k = 0; k < 2; ++k) dst[n][k] = *(const LAS bf16x8*)(lds + PG8_SB(b, h) + boff + n * 2048 + k * 1024); } while (0)
#define PG8_MMA(ai, bj, At, Bt) do { __builtin_amdgcn_s_setprio(1); _Pragma("unroll") for (int m = 0; m < 4; ++m) _Pragma("unroll") for (int n = 0; n < 2; ++n) _Pragma("unroll") for (int k = 0; k < 2; ++k) \
        acc[ai][bj][m][n] = __builtin_amdgcn_mfma_f32_16x16x32_bf16(Bt[n][k], At[m][k], acc[ai][bj][m][n], 0, 0, 0); __builtin_amdgcn_s_setprio(0); } while (0)
#define PG8_WAIT_V(n) asm volatile("s_waitcnt vmcnt(" #n ")" ::: "memory")
#define PG8_WAIT_L(n) asm volatile("s_waitcnt lgkmcnt(" #n ")" ::: "memory")
#define PG8_BAR __builtin_amdgcn_s_barrier()
#define PG8_SCHED __builtin_amdgcn_sched_barrier(0)
    Unit cur, nxt; int ui = 0;
    if (!S.next(0, cur)) return;
    f32x4 acc[2][2][4][2];
#pragma unroll
    for (int a = 0; a < 2; ++a)
#pragma unroll
        for (int b = 0; b < 2; ++b)
#pragma unroll
            for (int m = 0; m < 4; ++m)
#pragma unroll
                for (int n = 0; n < 2; ++n) acc[a][b][m][n] = (f32x4){0.f, 0.f, 0.f, 0.f};
    bf16x8 At[4][2], B0[2][2], B1[2][2];
    unsigned vA00, vA01, vA10, vA11, vN00, vN01, vN10, vN11;
#define PG8_AOFF(u, h, i) (GATHER ? (unsigned)(((size_t)S.arow(u, (h) * HALF + RA[i]) * (size_t)K + CA[i]) * 2u) : (unsigned)((h) * hstep + ((size_t)RA[i] * K + CA[i]) * 2u))
    vA00 = PG8_AOFF(cur, 0, 0); vA01 = PG8_AOFF(cur, 0, 1); vA10 = PG8_AOFF(cur, 1, 0); vA11 = PG8_AOFF(cur, 1, 1);
    vN00 = vA00; vN01 = vA01; vN10 = vA10; vN11 = vA11;
    const char* cA = (const char*)g.A + (GATHER ? (size_t)0 : (size_t)cur.pm * tstep); const char* cB = (const char*)g.Bt + (size_t)cur.pn * tstep;
    PG8_STAGE(PG8_SB(0, 0), cB, voffB); PG8_STAGE(PG8_SB(0, 1), cB + hstep, voffB); PG8_STA(PG8_SA(0, 0), cA, vA00, vA01); PG8_STA(PG8_SA(0, 1), cA, vA10, vA11);
    if (wr == 1) PG8_BAR;
    PG8_WAIT_V(2); PG8_BAR;
    PG8_STAGE(PG8_SB(1, 0), cB + kstep, voffB); PG8_STA(PG8_SA(1, 0), cA + kstep, vA00, vA01); PG8_STAGE(PG8_SB(1, 1), cB + hstep + kstep, voffB);
    PG8_WAIT_V(6); PG8_BAR;
#pragma unroll 1
    for (;;) {
        const bool has_next = S.next(ui + 1, nxt);
        const char* nA = has_next ? (const char*)g.A + (GATHER ? (size_t)0 : (size_t)nxt.pm * tstep) : cA; const char* nB = has_next ? (const char*)g.Bt + (size_t)nxt.pn * tstep : cB;
        if constexpr (GATHER) { if (has_next) { vN00 = PG8_AOFF(nxt, 0, 0); vN01 = PG8_AOFF(nxt, 0, 1); vN10 = PG8_AOFF(nxt, 1, 0); vN11 = PG8_AOFF(nxt, 1, 1); } else { vN00 = vA00; vN01 = vA01; vN10 = vA10; vN11 = vA11; } }
#pragma unroll 1
        for (int t = 0; t < nt; t += 2) {
            const bool last = (t == nt - 2);
            const char* a1 = cA + (size_t)(t + 1) * kstep;
            const char* a2 = last ? nA : cA + (size_t)(t + 2) * kstep; const char* b2 = last ? nB : cB + (size_t)(t + 2) * kstep;
            const char* a3 = a2 + kstep; const char* b3 = b2 + kstep;
            unsigned w00 = vA00, w01 = vA01, w10 = vA10, w11 = vA11;
            if constexpr (GATHER) { if (last) { w00 = vN00; w01 = vN01; w10 = vN10; w11 = vN11; } }
            PG8_LDB(B0, 0, 0); PG8_LDB(B1, 0, 1); PG8_SCHED; PG8_LDA(At, 0, 0); PG8_STA(PG8_SA(1, 1), a1, vA10, vA11);
            PG8_WAIT_V(8); PG8_WAIT_L(0); PG8_BAR; PG8_MMA(0, 0, At, B0); PG8_MMA(0, 1, At, B1); PG8_BAR; PG8_SCHED;
            PG8_LDA(At, 0, 1); PG8_STAGE(PG8_SB(0, 0), b2, voffB); PG8_STAGE(PG8_SB(0, 1), b2 + hstep, voffB); PG8_STA(PG8_SA(0, 0), a2, w00, w01);
            PG8_WAIT_V(8); PG8_WAIT_L(0); PG8_BAR; PG8_MMA(1, 0, At, B0); PG8_MMA(1, 1, At, B1); PG8_BAR; PG8_SCHED;
            PG8_LDB(B0, 1, 0); PG8_LDB(B1, 1, 1); PG8_SCHED; PG8_LDA(At, 1, 0); PG8_STA(PG8_SA(0, 1), a2, w10, w11);
            PG8_WAIT_V(8); PG8_WAIT_L(0); PG8_BAR; PG8_MMA(0, 0, At, B0); PG8_MMA(0, 1, At, B1); PG8_BAR; PG8_SCHED;
            PG8_LDA(At, 1, 1); PG8_STAGE(PG8_SB(1, 0), b3, voffB); PG8_STAGE(PG8_SB(1, 1), b3 + hstep, voffB); PG8_STA(PG8_SA(1, 0), a3, w00, w01);
            PG8_WAIT_V(8); PG8_WAIT_L(0); PG8_BAR; PG8_MMA(1, 0, At, B0); PG8_MMA(1, 1, At, B1); PG8_BAR; PG8_SCHED;
        }
        if constexpr (ALIGN_EPI) { if (wr == 0) PG8_BAR; }
        E(acc, cur, wr, wc, fr, fq);
        if (!has_next) break;
#pragma unroll
        for (int a = 0; a < 2; ++a)
#pragma unroll
            for (int b = 0; b < 2; ++b)
#pragma unroll
                for (int m = 0; m < 4; ++m)
#pragma unroll
                    for (int n = 0; n < 2; ++n) acc[a][b][m][n] = (f32x4){0.f, 0.f, 0.f, 0.f};
        cur = nxt; cA = nA; cB = nB; ++ui;
        vA00 = vN00; vA01 = vN01; vA10 = vN10; vA11 = vN11;
        if constexpr (ALIGN_EPI) { if (wr == 1) PG8_BAR; }
    }
    PG8_WAIT_V(0);
    if constexpr (!ALIGN_EPI) { if (wr == 0) PG8_BAR; }
    PG8_BAR;
#undef PG8_AOFF
#undef PG8_SA
#undef PG8_SB
#undef PG8_STAGE
#undef PG8_STA
#undef PG8_LDA
#undef PG8_LDB
#undef PG8_MMA
#undef PG8_WAIT_V
#undef PG8_WAIT_L
#undef PG8_BAR
#undef PG8_SCHED
}
}

struct Params { const void* p[30]; };
__device__ __forceinline__ const void* parg(const Params& P, int i) { asm volatile("" : "+s"(i)); return P.p[i]; }
#define PIN(i) ((const float*)parg(P, (i)))
#define POUT() ((float*)parg(P, 28))
#define PWS() ((unsigned char*)parg(P, 29))
struct Frame {
    LAS unsigned char* lds;
    int tid, lane, wave, vcu, G;
};

#define XB_TMO      128
#define XB_XCNT(j)  (256  + 64 * (j))
#define XB_XSUB(j)  (1280 + 64 * (j))
#define XB_XGEN(j)  (2304 + 64 * (j))
#define XB_TOP      3328
#define XB_TOPGEN   3392
#define XCD_BAR_WORDS 3456
#define XB_SPIN_CAP (1u << 20)
__device__ __forceinline__ unsigned xb_ld(unsigned* p)              { return __hip_atomic_load(p, __ATOMIC_RELAXED, __HIP_MEMORY_SCOPE_AGENT); }
__device__ __forceinline__ unsigned xb_add(unsigned* p, unsigned v) { return __hip_atomic_fetch_add(p, v, __ATOMIC_RELAXED, __HIP_MEMORY_SCOPE_AGENT); }
__device__ __forceinline__ unsigned xb_xcc_id() { return (unsigned)__builtin_amdgcn_s_getreg((3 << 11) | 20) & 0xFu; }
#define XB_SPIN(cond, bar) do { unsigned _sp = 0; while (cond) { __builtin_amdgcn_s_sleep(1); \
    if ((++_sp & 255u) == 0u) { if (xb_ld(&(bar)[XB_TMO])) break; if (_sp > XB_SPIN_CAP) { atomicAdd(&(bar)[XB_TMO], 1u); break; } } } } while (0)
struct XcdBarrier { unsigned* bar; unsigned x; volatile LAS unsigned* st; };
__device__ __forceinline__ XcdBarrier xcd_barrier_post(unsigned* bar, volatile LAS unsigned* st) {
    XcdBarrier b; b.bar = bar; b.x = xb_xcc_id(); b.st = st;
    if (threadIdx.x == 0) (void)xb_add(&bar[XB_XCNT(b.x)], 1u);
    return b;
}
__device__ __forceinline__ void xcd_barrier_complete(unsigned* bar, unsigned x, unsigned& nloc, unsigned& nx) {
    const unsigned G = gridDim.x * gridDim.y * gridDim.z;
    unsigned sum, cnt, mine, sp = 0u;
    for (;;) {
        sum = 0u; cnt = 0u; mine = 0u;
#pragma unroll
        for (unsigned j = 0; j < 16; ++j) { const unsigned c = xb_ld(&bar[XB_XCNT(j)]); sum += c; cnt += (c > 0u) ? 1u : 0u; mine = (j == x) ? c : mine; }
        if (sum == G) break;
        __builtin_amdgcn_s_sleep(1);
        if ((++sp & 255u) == 0u) { if (xb_ld(&bar[XB_TMO])) break; if (sp > XB_SPIN_CAP) { atomicAdd(&bar[XB_TMO], 1u); break; } }
    }
    nloc = mine > 0u ? mine : 1u; nx = cnt > 0u ? cnt : 1u;
}
__device__ __forceinline__ void xcd_barrier(const XcdBarrier& b) {
    asm volatile("s_waitcnt vmcnt(0)" ::: "memory");
    __syncthreads();
    if (threadIdx.x == 0) {
        unsigned* bar = b.bar;
        __builtin_amdgcn_s_waitcnt(0);
        unsigned nloc = b.st[0], nx = b.st[1];
        if (nloc == 0u) { xcd_barrier_complete(bar, b.x, nloc, nx); b.st[0] = nloc; b.st[1] = nx; }
        const unsigned old = xb_add(&bar[XB_XSUB(b.x)], 1u);
        const unsigned gen = old / nloc;
        if (old + 1u == (gen + 1u) * nloc) {
            __builtin_amdgcn_fence(__ATOMIC_RELEASE, "agent");
            asm volatile("s_waitcnt vmcnt(0)" ::: "memory");
            const unsigned og = xb_add(&bar[XB_TOP], 1u);
            const unsigned tg = og / nx;
            if (og + 1u == (tg + 1u) * nx) xb_add(&bar[XB_TOPGEN], 1u);
            else XB_SPIN(xb_ld(&bar[XB_TOPGEN]) == tg, bar);
            __builtin_amdgcn_fence(__ATOMIC_ACQUIRE, "agent");
            xb_add(&bar[XB_XGEN(b.x)], 1u);
            asm volatile("s_waitcnt vmcnt(0)" ::: "memory");
        } else {
            XB_SPIN(xb_ld(&bar[XB_XGEN(b.x)]) == gen, bar);
            __builtin_amdgcn_fence(__ATOMIC_ACQUIRE, "agent");
            asm volatile("s_waitcnt vmcnt(0)" ::: "memory");
        }
    }
    __syncthreads();
}

struct TrJob { const float* W; int ld, k0; const float* gain; float scale; bf16_t* dst; int K; };
__device__ __forceinline__ void tr_load(const TrJob& j, float (&v)[32], int lane) {
#pragma unroll
    for (int i = 0; i < 32; ++i) { const int kk = 2 * i + (lane >> 5); v[i] = j.W[(size_t)(j.k0 + kk) * j.ld + (lane & 31)]; }
}
__device__ __forceinline__ void tr_finish(const TrJob& j, const float (&v)[32], LAS float* scr, int lane) {
#pragma unroll
    for (int i = 0; i < 32; ++i) { const int kk = 2 * i + (lane >> 5); float x = v[i]; if (j.gain) x *= j.gain[j.k0 + kk]; scr[kk * 33 + (lane & 31)] = x * j.scale; }
    asm volatile("s_waitcnt lgkmcnt(0)" ::: "memory");
    const int c = lane & 7;
#pragma unroll
    for (int jj = 0; jj < 4; ++jj) { const int n = (lane >> 3) + 8 * jj; const LAS float* s = scr + (8 * c) * 33 + n;
        v4u o; o.x = cvt_pk_bf16(s[0 * 33], s[1 * 33]); o.y = cvt_pk_bf16(s[2 * 33], s[3 * 33]); o.z = cvt_pk_bf16(s[4 * 33], s[5 * 33]); o.w = cvt_pk_bf16(s[6 * 33], s[7 * 33]);
        *(v4u*)(j.dst + (size_t)n * j.K + j.k0 + 8 * c) = o; }
    asm volatile("s_waitcnt lgkmcnt(0)" ::: "memory");
}

__device__ __forceinline__ void p0_prologue(const Frame& F, const Params& P) {
    unsigned char* ws = PWS();
    const float* x = PIN(0); const float* p = PIN(1); const int* pos = (const int*)PIN(2);
    const float* attn_norm = PIN(3); const float* w_in = PIN(4); const float* w_a2 = PIN(5);
    const float* w_ba = PIN(13); const float* w_bb = PIN(14); const float* w_out = PIN(15); const float* ffn_norm = PIN(16);
    const float* w_rg = PIN(17); const float* w_re = PIN(19);
    const float* w_gate = PIN(21); const float* w_up = PIN(22); const float* w_down = PIN(23); const float* w_ple = PIN(24); const float* w_pg = PIN(26);
    bf16_t* Wp = (bf16_t*)(ws + WS_WP); bf16_t* Wgu = (bf16_t*)(ws + WS_WGU); bf16_t* Wd = (bf16_t*)(ws + WS_WD); bf16_t* Wab = (bf16_t*)(ws + WS_WAB);
    bf16_t* Wo = (bf16_t*)(ws + WS_WO); bf16_t* Wpg = (bf16_t*)(ws + WS_WPG); bf16_t* Wple = (bf16_t*)(ws + WS_WPLE); bf16_t* Wr = (bf16_t*)(ws + WS_WR);
    LAS float* scr = (LAS float*)(F.lds + F.wave * 16384);
    const int gw = F.vcu * 8 + F.wave, NGW = F.G * 8, lane = F.lane;
    constexpr int I0 = 16 * 48, I1 = 16 * 112, I2 = 8 * 32, I3 = 8 * 32, I4 = 16 * 32, I5 = 16 * 32, I6 = 4 * 32, I7 = 32 * 16 * 8, I8 = I7, I9 = 32 * 4 * 32;
    constexpr int NITEMS = I0 + I1 + I2 + I3 + I4 + I5 + I6 + I7 + I8 + I9;
    auto decode = [&](int it) -> TrJob {
        int r = it; TrJob j;
        if (r < I0) { const int kb = r / 48, nb = r % 48; j = TrJob{w_in + nb * 32, DIN, kb * 64, attn_norm, nb < 8 ? 0.125f : 1.f, Wp + (size_t)(nb * 32) * DM, DM}; return j; } r -= I0;
        if (r < I1) { const int kb = r / 112, nb = r % 112; j = TrJob{w_in + C_DQ + nb * 32, DIN, kb * 64, attn_norm, nb < 16 ? QSCALE2 : 1.f, Wp + (size_t)(P_DQ + nb * 32) * DM, DM}; return j; } r -= I1;
        if (r < I2) { const int kb = r / 32, nb = r % 32; j = TrJob{w_ba + nb * 32, DM, kb * 64, nullptr, 1.f, Wab + (size_t)(nb * 32) * 512, 512}; return j; } r -= I2;
        if (r < I3) { const int kb = r / 32, nb = r % 32; j = TrJob{w_bb + nb * 32, DM, kb * 64, nullptr, 1.f, Wab + (size_t)(1024 + nb * 32) * 512, 512}; return j; } r -= I3;
        if (r < I4) { const int kb = r / 32, nb = r % 32; j = TrJob{w_out + nb * 32, DM, kb * 64, nullptr, 1.f, Wo + (size_t)(nb * 32) * DM, DM}; return j; } r -= I4;
        if (r < I5) { const int kb = r / 32, nb = r % 32; j = TrJob{w_pg + nb * 32, DM, kb * 64, nullptr, 1.f, Wpg + (size_t)(nb * 32) * DM, DM}; return j; } r -= I5;
        if (r < I6) { const int kb = r / 32, nb = r % 32; j = TrJob{w_ple + nb * 32, DM, kb * 64, nullptr, 1.f, Wple + (size_t)(nb * 32) * PLE, PLE}; return j; } r -= I6;
        if (r < I7 + I8) { const int up = r >= I7; if (up) r -= I7; const int e = r / 128, q = r % 128, kb = q / 8, nb = q % 8;
            j = TrJob{(up ? w_up : w_gate) + (size_t)e * DM * DEXP + nb * 32, DEXP, kb * 64, ffn_norm, 1.f, Wgu + (size_t)(e * 512 + (nb >> 2) * 256 + up * 128 + (nb & 3) * 32) * DM, DM}; return j; } r -= I7 + I8;
        { const int e = r / 128, q = r % 128, kb = q / 32, nb = q % 32;
          j = TrJob{w_down + (size_t)e * DEXP * DM + nb * 32, DM, kb * 64, nullptr, 1.f, Wd + (size_t)(e * 1024 + nb * 32) * DEXP, DEXP}; return j; }
    };
    {
        float va[32], vb[32];
        int it = gw;
        if (it < NITEMS) { TrJob ja = decode(it); tr_load(ja, va, lane);
            for (;;) {
                const int itb = it + NGW; TrJob jb = ja;
                if (itb < NITEMS) { jb = decode(itb); tr_load(jb, vb, lane); }
                tr_finish(ja, va, scr, lane);
                if (itb >= NITEMS) break;
                const int itc = itb + NGW;
                if (itc < NITEMS) { ja = decode(itc); tr_load(ja, va, lane); }
                tr_finish(jb, vb, scr, lane);
                if (itc >= NITEMS) break;
                it = itc;
            }
        }
    }
    for (int it = gw; it < 16 * 8; it += NGW) { const int kb = it / 8, jb = it % 8, k = kb * 64 + lane;
        float wv[16];
#pragma unroll
        for (int r = 0; r < 16; ++r) wv[r] = w_in[(size_t)k * DIN + C_AL + r];
        const float g = attn_norm[k];
        for (int jj = 0; jj < 32; ++jj) { const int j = jb * 32 + jj; float s = 0.f;
#pragma unroll
            for (int r = 0; r < 16; ++r) s += wv[r] * w_a2[r * 256 + j];
            Wp[(size_t)(P_AL + j) * DM + k] = (bf16_t)(cvt_pk_bf16(s * g, 0.f) & 0xffffu); } }
    const int gt = F.vcu * NTHREADS + F.tid, NGT = F.G * NTHREADS;
    for (int i = gt; i < 48 * DM; i += NGT) { const int n = i >> 10, k = i & 1023; float v = 0.f;
        if (n < 4) v = w_rg[k * 4 + n] * ffn_norm[k]; else if (n < 36) v = w_re[k * 32 + (n - 4)] * ffn_norm[k];
        Wr[i] = (bf16_t)(cvt_pk_bf16(v, 0.f) & 0xffffu); }
    { bf16_t* xb = (bf16_t*)(ws + WS_XB); float* rstd1 = (float*)(ws + WS_RSTD1);
      for (int m0 = gw * 4; m0 < T; m0 += NGW * 4) { f32x4 v[4][4];
#pragma unroll
          for (int r = 0; r < 4; ++r) { const GAS f32x4* xr = (const GAS f32x4*)(x + (size_t)(m0 + r) * DM) + lane;
#pragma unroll
              for (int j = 0; j < 4; ++j) v[r][j] = xr[64 * j]; }
#pragma unroll
          for (int r = 0; r < 4; ++r) { float s = 0.f;
#pragma unroll
              for (int j = 0; j < 4; ++j) s += (v[r][j].x * v[r][j].x + v[r][j].y * v[r][j].y) + (v[r][j].z * v[r][j].z + v[r][j].w * v[r][j].w);
              s = wave_sum(s);
              GAS v2u* o8 = (GAS v2u*)(xb + (size_t)(m0 + r) * DM) + lane;
#pragma unroll
              for (int j = 0; j < 4; ++j) { v2u o; o.x = cvt_pk_bf16(v[r][j].x, v[r][j].y); o.y = cvt_pk_bf16(v[r][j].z, v[r][j].w); o8[64 * j] = o; }
              if (lane == 0) rstd1[m0 + r] = 1.0f / sqrtf(s * (1.f / DM) + EPS); } } }
    { bf16_t* pb = (bf16_t*)(ws + WS_PB);
      for (int i0 = gt; i0 < T * PLE / 8; i0 += NGT * 4) { f32x4 a[4], b[4];
#pragma unroll
          for (int u = 0; u < 4; ++u) { const int i = i0 + u * NGT; if (i < T * PLE / 8) { a[u] = *(const f32x4*)(p + (size_t)i * 8); b[u] = *(const f32x4*)(p + (size_t)i * 8 + 4); } }
#pragma unroll
          for (int u = 0; u < 4; ++u) { const int i = i0 + u * NGT; if (i < T * PLE / 8) { v4u o; o.x = cvt_pk_bf16(a[u].x, a[u].y); o.y = cvt_pk_bf16(a[u].z, a[u].w); o.z = cvt_pk_bf16(b[u].x, b[u].y); o.w = cvt_pk_bf16(b[u].z, b[u].w); *(v4u*)(pb + (size_t)i * 8) = o; } } } }
    { float* ct = (float*)(ws + WS_COS); float* st = (float*)(ws + WS_SIN);
      for (int i = gt; i < T * 8; i += NGT) { const int t = i >> 3, j = i & 7; const double ang = (double)pos[t] * exp2(-(double)j * (18.931568569324174 / 8.0));
          ct[i] = (float)cos(ang); st[i] = (float)sin(ang); } }
}

namespace pg8 {
__device__ __forceinline__ size_t tp_off(int tile, int slot, int tid) { return ((size_t)tile * 16 + slot) * 8192 + (size_t)tid * 16; }
struct EpiProj {
    static constexpr bool PERM = true;
    unsigned char* ws; bf16_t* gates; const float* rstd; const float* b_a; const float* cost; const float* sint;
    __device__ __forceinline__ void operator()(const f32x4 (&acc)[2][2][4][2], const Unit& u, int wr, int wc, int fr, int fq) const {
        const int pn = u.pn, row0 = u.pm * BM + wr * 64 + fr, cl0 = wc * 32 + 8 * fq;
        int mode = 0, pitch = 512, cb = 0; unsigned char* dst = nullptr;
        if (pn == 0) { dst = ws + WS_GQ; pitch = 256; }
        else if (pn == 1) { dst = ws + WS_GK; pitch = 256; }
        else if (pn < 4) { dst = ws + WS_GV; cb = (pn - 2) * 256; }
        else if (pn < 6) { dst = ws + WS_SR; cb = (pn - 4) * 256; mode = 1; }
        else if (pn == 6) { dst = ws + WS_LA; pitch = 256; mode = 2; }
        else if (pn < 9) { dst = ws + WS_DQ; cb = (pn - 7) * 256; mode = 3; }
        else if (pn < 11) { dst = ws + WS_DK; cb = (pn - 9) * 256; mode = 3; }
        else if (pn < 13) { dst = ws + WS_DV; cb = (pn - 11) * 256; }
        else { dst = (unsigned char*)gates; pitch = 2048; cb = (pn - 13) * 256; mode = 4; }
#pragma unroll
        for (int ai = 0; ai < 2; ++ai)
#pragma unroll
            for (int m = 0; m < 4; ++m) {
                const int row = row0 + ai * HALF + m * 16; const float rs = rstd[row];
                f32x4 cs0, cs1, sn0, sn1;
                if (mode == 3) { cs0 = *(const f32x4*)(cost + (size_t)row * 8); cs1 = *(const f32x4*)(cost + (size_t)row * 8 + 4); sn0 = *(const f32x4*)(sint + (size_t)row * 8); sn1 = *(const f32x4*)(sint + (size_t)row * 8 + 4); }
#pragma unroll
                for (int bj = 0; bj < 2; ++bj) {
                    f32x4 v0 = acc[ai][bj][m][0] * rs, v1 = acc[ai][bj][m][1] * rs;
                    const int col = cb + bj * HALF + cl0;
                    if (mode == 2) {
                        const f32x4 b0 = *(const f32x4*)(b_a + col), b1 = *(const f32x4*)(b_a + col + 4);
                        v0 = v0 + b0; v1 = v1 + b1;
#pragma unroll
                        for (int i = 0; i < 4; ++i) { float xx = v0[i]; v0[i] = (fminf(xx, 0.f) - __builtin_amdgcn_logf(1.f + __builtin_amdgcn_exp2f(-fabsf(xx) * LOG2E)) * 0.6931471805599453f) * 0.0625f;
                                                      xx = v1[i]; v1[i] = (fminf(xx, 0.f) - __builtin_amdgcn_logf(1.f + __builtin_amdgcn_exp2f(-fabsf(xx) * LOG2E)) * 0.6931471805599453f) * 0.0625f; }
                        float* o = (float*)dst + (size_t)row * pitch + col; *(f32x4*)o = v0; *(f32x4*)(o + 4) = v1;
                        continue;
                    }
                    if (mode == 1) {
#pragma unroll
                        for (int i = 0; i < 4; ++i) { v0[i] = v0[i] * sigmoidf_(v0[i]); v1[i] = v1[i] * sigmoidf_(v1[i]); }
                    } else if (mode == 4) {
#pragma unroll
                        for (int i = 0; i < 4; ++i) { v0[i] = sigmoidf_(v0[i]); v1[i] = sigmoidf_(v1[i]); }
                    } else if (mode == 3) {
                        if ((wc & 1) == 0) {
                            f32x4 p0, p1;
#pragma unroll
                            for (int i = 0; i < 4; ++i) { p0[i] = __shfl_xor(v0[i], 16); p1[i] = __shfl_xor(v1[i], 16); }
                            if (fq == 0) { v0 = v0 * cs0 - p0 * sn0; v1 = v1 * cs1 - p1 * sn1; }
                            else if (fq == 1) { v0 = v0 * cs0 + p0 * sn0; v1 = v1 * cs1 + p1 * sn1; }
                        }
                    }
                    v4u w; w.x = cvt_pk_bf16(v0[0], v0[1]); w.y = cvt_pk_bf16(v0[2], v0[3]); w.z = cvt_pk_bf16(v1[0], v1[1]); w.w = cvt_pk_bf16(v1[2], v1[3]);
                    if (mode == 4) { const int pg = pn - 13; *(v4u*)((unsigned char*)gates + tp_off((pg >> 2) * 512 + u.pm * 4 + (pg & 3), (ai * 4 + m) * 2 + bj, (wr * 4 + wc) * 64 + fq * 16 + fr)) = w; }
                    else *(v4u*)((bf16_t*)dst + (size_t)row * pitch + col) = w;
                }
            }
    }
};
struct EpiProjStoreOnly {
    static constexpr bool PERM = true;
    unsigned char* ws; bf16_t* gates; const float* rstd;
    __device__ __forceinline__ void operator()(const f32x4 (&acc)[2][2][4][2], const Unit& u, int wr, int wc, int fr, int fq) const {
        const int pn = u.pn, row0 = u.pm * BM + wr * 64 + fr, cl0 = wc * 32 + 8 * fq;
        int pitch = 512, cb = 0; unsigned char* dst = nullptr; int f32out = 0;
        if (pn == 0) { dst = ws + WS_GQ; pitch = 256; }
        else if (pn == 1) { dst = ws + WS_GK; pitch = 256; }
        else if (pn < 4) { dst = ws + WS_GV; cb = (pn - 2) * 256; }
        else if (pn < 6) { dst = ws + WS_SR; cb = (pn - 4) * 256; }
        else if (pn == 6) { dst = ws + WS_LA; pitch = 256; f32out = 1; }
        else if (pn < 9) { dst = ws + WS_DQ; cb = (pn - 7) * 256; }
        else if (pn < 11) { dst = ws + WS_DK; cb = (pn - 9) * 256; }
        else if (pn < 13) { dst = ws + WS_DV; cb = (pn - 11) * 256; }
        else { dst = (unsigned char*)gates; pitch = 2048; cb = (pn - 13) * 256; }
#pragma unroll
        for (int ai = 0; ai < 2; ++ai)
#pragma unroll
            for (int m = 0; m < 4; ++m) { const int row = row0 + ai * HALF + m * 16; const float rs = rstd[row];
#pragma unroll
                for (int bj = 0; bj < 2; ++bj) { const f32x4 v0 = acc[ai][bj][m][0] * rs, v1 = acc[ai][bj][m][1] * rs; const int col = cb + bj * HALF + cl0;
                    if (f32out) { float* o = (float*)dst + (size_t)row * pitch + col; *(f32x4*)o = v0; *(f32x4*)(o + 4) = v1; }
                    else { v4u w; w.x = cvt_pk_bf16(v0[0], v0[1]); w.y = cvt_pk_bf16(v0[2], v0[3]); w.z = cvt_pk_bf16(v1[0], v1[1]); w.w = cvt_pk_bf16(v1[2], v1[3]);
                        *(v4u*)((bf16_t*)dst + (size_t)row * pitch + col) = w; } } }
    }
};
struct EpiPle {
    static constexpr bool PERM = true;
    bf16_t* er; float* sse;
    __device__ __forceinline__ void operator()(const f32x4 (&acc)[2][2][4][2], const Unit& u, int wr, int wc, int fr, int fq) const {
        const int row0 = u.pm * BM + wr * 64 + fr, col0 = u.pn * BM + wc * 32 + 8 * fq;
#pragma unroll
        for (int ai = 0; ai < 2; ++ai)
#pragma unroll
            for (int m = 0; m < 4; ++m) { const int row = row0 + ai * HALF + m * 16; float s = 0.f;
#pragma unroll
                for (int bj = 0; bj < 2; ++bj) { const f32x4 v0 = acc[ai][bj][m][0], v1 = acc[ai][bj][m][1];
                    s += (v0[0] * v0[0] + v0[1] * v0[1]) + (v0[2] * v0[2] + v0[3] * v0[3]) + (v1[0] * v1[0] + v1[1] * v1[1]) + (v1[2] * v1[2] + v1[3] * v1[3]);
                    v4u w; w.x = cvt_pk_bf16(v0[0], v0[1]); w.y = cvt_pk_bf16(v0[2], v0[3]); w.z = cvt_pk_bf16(v1[0], v1[1]); w.w = cvt_pk_bf16(v1[2], v1[3]);
                    *(v4u*)((unsigned char*)er + tp_off(u.pm * 4 + u.pn, (ai * 4 + m) * 2 + bj, (wr * 4 + wc) * 64 + fq * 16 + fr)) = w; }
                s += __shfl_xor(s, 16); s += __shfl_xor(s, 32);
                if (fq == 0) atomicAdd(sse + row, s); }
    }
};
}

namespace da {
constexpr int NW = 8, QBLK = 32, KVBLK = 64, QB = 128, PITCH = 512;
constexpr int SHM_V = KVBLK * 128 * 2, SHM_K = KVBLK * 128 * 2;
constexpr int OFF_WS = 2 * SHM_V + 2 * SHM_K, OFF_EX = OFF_WS + NW * 64 * 4, LDS_NEED = OFF_EX + 4 * 32 * 128 * 4;
constexpr float THRL = 11.5f;
#define KSWZ(row, colB) ((row) * 256 + ((colB) ^ (((row) & 7) << 4)))
#define SBAR() __builtin_amdgcn_sched_barrier(0)
__device__ __forceinline__ int v_st(int k, int c) { const int kk = (k & ~0xC) | ((k & 4) << 1) | ((k & 8) >> 1); return ((kk >> 3) * 4 + (c >> 5)) * 512 + ((kk & 7) * 32 + (c & 31)) * 2; }
__device__ __forceinline__ int v_rd_base(int lane) { return ((lane & 3) << 3) | (((lane >> 2) & 3) << 6) | (((lane >> 4) & 1) << 5) | (((lane >> 5) & 1) << 8); }
constexpr int v_rd_off(int d0, int ks, int half) { return d0 * 512 + ks * 4096 + half * 2048; }
__device__ __forceinline__ int crow(int r, int hi) { return (r & 3) + 8 * (r >> 2) + 4 * hi; }
__device__ __forceinline__ void mask_tile(f32x16& p0, f32x16& p1, int dq) {
    const float NEG = -__builtin_inff();
#pragma unroll
    for (int r = 0; r < 16; ++r) { const int c = (r & 3) + 8 * (r >> 2); if (dq - c < 0) p0[r] = NEG; if (dq - c - 32 < 0) p1[r] = NEG; }
}
__device__ __forceinline__ void partialSM(f32x16& p0, f32x16& p1, float& m_reg, float& mn, float& alpha) {
    float pmax = p0[0];
#pragma unroll
    for (int r = 1; r < 16; ++r) pmax = fmaxf(pmax, p0[r]);
#pragma unroll
    for (int r = 0; r < 16; ++r) pmax = fmaxf(pmax, p1[r]);
    { auto rr = __builtin_amdgcn_permlane32_swap(__float_as_uint(pmax), __float_as_uint(pmax), false, false); pmax = fmaxf(__uint_as_float(rr[0]), __uint_as_float(rr[1])); }
    if (__builtin_expect(__all((pmax - m_reg) <= THRL), 1)) { mn = m_reg; alpha = 1.f; }
    else { mn = fmaxf(m_reg, pmax); alpha = __builtin_amdgcn_exp2f(m_reg - mn); m_reg = mn; }
#pragma unroll
    for (int r = 0; r < 16; ++r) { p0[r] = p0[r] - mn; p1[r] = p1[r] - mn; }
#pragma unroll
    for (int r = 0; r < 16; ++r) p0[r] = __builtin_amdgcn_exp2f(p0[r]);
}
__device__ __forceinline__ void finishSM(f32x16& p0, f32x16& p1, float alpha, float& l_reg, bf16x8& pa0, bf16x8& pa1, bf16x8& pa2, bf16x8& pa3) {
#pragma unroll
    for (int r = 0; r < 16; ++r) p1[r] = __builtin_amdgcn_exp2f(p1[r]);
    float ps = 0;
#pragma unroll
    for (int r = 0; r < 16; ++r) ps += p0[r];
#pragma unroll
    for (int r = 0; r < 16; ++r) ps += p1[r];
    { auto rr = __builtin_amdgcn_permlane32_swap(__float_as_uint(ps), __float_as_uint(ps), false, false); ps = __uint_as_float(rr[0]) + __uint_as_float(rr[1]); }
    l_reg = l_reg * alpha + ps;
#define PK4(P, B_, OUT) do { unsigned a0 = cvt_pk_bf16(P[B_+0], P[B_+1]), a1 = cvt_pk_bf16(P[B_+2], P[B_+3]); unsigned b0 = cvt_pk_bf16(P[B_+4], P[B_+5]), b1 = cvt_pk_bf16(P[B_+6], P[B_+7]); \
        auto r0 = __builtin_amdgcn_permlane32_swap(a0, b0, false, false); auto r1 = __builtin_amdgcn_permlane32_swap(a1, b1, false, false); \
        v4u w = {r0[0], r1[0], r0[1], r1[1]}; OUT = *reinterpret_cast<bf16x8*>(&w); } while (0)
    PK4(p0, 0, pa0); PK4(p0, 8, pa1); PK4(p1, 0, pa2); PK4(p1, 8, pa3);
#undef PK4
}
template <int KB>
__device__ __forceinline__ void qkt(f32x16& p0, f32x16& p1, const char* K_lds, int r32, int hi, int comp, const bf16x8* qr) {
    p0 = f32x16{}; p1 = f32x16{};
#pragma unroll
    for (int dd = 0; dd < 4; ++dd) { const char* a = K_lds + KB * SHM_K + KSWZ(r32, (dd * 16 + hi * 8) * 2) + comp * 128;
        bf16x8 b0 = *reinterpret_cast<const bf16x8*>(a);
        bf16x8 b1 = *reinterpret_cast<const bf16x8*>(a + 32 * 256);
        p0 = __builtin_amdgcn_mfma_f32_32x32x16_bf16(b0, qr[dd], p0, 0, 0, 0);
        p1 = __builtin_amdgcn_mfma_f32_32x32x16_bf16(b1, qr[dd], p1, 0, 0, 0); }
}
template <int VB>
__device__ __forceinline__ void pv_tile(f32x16* o, int vb0, bf16x8 pa0, bf16x8 pa1, bf16x8 pa2, bf16x8 pa3) {
#define TRRD(dst, off) asm volatile("ds_read_b64_tr_b16 %0, %1 offset:%2" : "=&v"(dst) : "v"(vb0), "i"(off) : "memory")
#define PV_D0(d0) do { s16x4 l0, l1, l2, l3, h0, h1, h2, h3; constexpr int b_ = VB * SHM_V + v_rd_off(d0, 0, 0); \
        TRRD(l0, b_); TRRD(h0, b_ + 2048); TRRD(l1, b_ + 4096); TRRD(h1, b_ + 6144); TRRD(l2, b_ + 8192); TRRD(h2, b_ + 10240); TRRD(l3, b_ + 12288); TRRD(h3, b_ + 14336); \
        asm volatile("s_waitcnt lgkmcnt(0)" ::: "memory"); SBAR(); \
        o[d0] = __builtin_amdgcn_mfma_f32_32x32x16_bf16(pa0, (bf16x8){l0[0], l0[1], l0[2], l0[3], h0[0], h0[1], h0[2], h0[3]}, o[d0], 0, 0, 0); \
        o[d0] = __builtin_amdgcn_mfma_f32_32x32x16_bf16(pa1, (bf16x8){l1[0], l1[1], l1[2], l1[3], h1[0], h1[1], h1[2], h1[3]}, o[d0], 0, 0, 0); \
        o[d0] = __builtin_amdgcn_mfma_f32_32x32x16_bf16(pa2, (bf16x8){l2[0], l2[1], l2[2], l2[3], h2[0], h2[1], h2[2], h2[3]}, o[d0], 0, 0, 0); \
        o[d0] = __builtin_amdgcn_mfma_f32_32x32x16_bf16(pa3, (bf16x8){l3[0], l3[1], l3[2], l3[3], h3[0], h3[1], h3[2], h3[3]}, o[d0], 0, 0, 0); } while (0)
    PV_D0(0); PV_D0(1); PV_D0(2); PV_D0(3);
#undef PV_D0
#undef TRRD
}
__device__ __forceinline__ void attn_unit(const bf16_t* Qg, const bf16_t* Kg, const bf16_t* Vg, bf16_t* Og, int P0, float lam, const float* subln, char* lds) {
    int tid = threadIdx.x; asm volatile("" : "+v"(tid));
    const int wid = __builtin_amdgcn_readfirstlane(tid >> 6), lane = tid & 63, r32 = lane & 31, hi = lane >> 5;
    const int comp = wid & 1, rg = wid >> 1;
    const int NT = (P0 + QB - 1) / KVBLK + 1;
    const int qlo = P0 + rg * QBLK, qm = qlo + r32 - 4 * hi;
    char* V_lds = lds; char* K_lds = lds + 2 * SHM_V;
    float* wsf = (float*)(lds + OFF_WS) + wid * 64; float* li_l = wsf, * al_l = wsf + 32;
    float* exch = (float*)(lds + OFF_EX) + rg * (32 * 128);
    float m_reg = -1e30f, l_reg = 0; f32x16 o[4] = {};
    const int sr = tid >> 4, sc = (tid & 15) * 8, vst0 = v_st(sr, sc), vst1 = v_st(32 + sr, sc), kws = KSWZ(sr, sc * 2);
    const int vb0 = (int)(uintptr_t)V_lds + v_rd_base(lane);
    bf16x8 st_v0, st_v1, st_k0, st_k1;
#define ROW(p, k0, rr) ((p) + (size_t)((k0) + (rr)) * PITCH + sc)
#define LD8(p) (*reinterpret_cast<const bf16x8*>(p))
#define SLOAD_H(k0) do { st_v0 = LD8(ROW(Vg, k0, sr)); st_v1 = LD8(ROW(Vg, k0, 32 + sr)); st_k0 = LD8(ROW(Kg, k0, sr)); st_k1 = LD8(ROW(Kg, k0, 32 + sr)); } while (0)
#define SWRITE_HK(bf) do { *(bf16x8*)(K_lds + (bf) * SHM_K + kws) = st_k0; *(bf16x8*)(K_lds + (bf) * SHM_K + kws + 32 * 256) = st_k1; } while (0)
#define SWRITE_HV(bf) do { *(bf16x8*)(V_lds + (bf) * SHM_V + vst0) = st_v0; *(bf16x8*)(V_lds + (bf) * SHM_V + vst1) = st_v1; } while (0)
#define VMW() asm volatile("s_waitcnt vmcnt(0)" ::: "memory")
    bf16x8 qr[4];
#pragma unroll
    for (int dd = 0; dd < 4; ++dd) qr[dd] = LD8(Qg + (size_t)(qlo + r32) * PITCH + comp * 64 + dd * 16 + hi * 8);
    SLOAD_H(0); VMW(); SWRITE_HK(0); SWRITE_HV(0); SBAR();
    SLOAD_H(KVBLK);
    __syncthreads();
#define RESC(a) do { if (__any((a) < 1.f)) { if (hi == 0) al_l[r32] = (a); asm volatile("s_waitcnt lgkmcnt(0)" ::: "memory"); \
                     _Pragma("unroll") for (int d_ = 0; d_ < 4; ++d_) _Pragma("unroll") for (int r = 0; r < 16; ++r) o[d_][r] *= al_l[crow(r, hi)]; } } while (0)
#define KBASE(t) ((t) * KVBLK)
#define MASKT(P0_, P1_, t) do { const int kb_ = KBASE(t); if (kb_ + KVBLK - 1 > qlo) mask_tile(P0_, P1_, qm - kb_); } while (0)
    f32x16 pA0, pA1, pB0, pB1; float mnA, mnB, alA, alB; bf16x8 pa0, pa1, pa2, pa3;
    SBAR(); qkt<0>(pA0, pA1, K_lds, r32, hi, comp, qr);
    MASKT(pA0, pA1, 0); partialSM(pA0, pA1, m_reg, mnA, alA);
    VMW(); SWRITE_HK(1); SWRITE_HV(1);
    __syncthreads();
#define HALF_STEP(PX0, PX1, mnX, alX, PY0, PY1, alY, t, KB, VB, SB) do { \
        SBAR(); qkt<KB>(PX0, PX1, K_lds, r32, hi, comp, qr); \
        finishSM(PY0, PY1, alY, l_reg, pa0, pa1, pa2, pa3); SBAR(); \
        if ((t) + 1 < NT) { SLOAD_H(KBASE((t) + 1)); SBAR(); } \
        pv_tile<VB>(o, vb0, pa0, pa1, pa2, pa3); MASKT(PX0, PX1, (t)); partialSM(PX0, PX1, m_reg, mnX, alX); \
        __syncthreads(); \
        if ((t) + 1 < NT) { VMW(); SWRITE_HK(SB); SWRITE_HV(SB); } \
        RESC(alX); __syncthreads(); } while (0)
    for (int t = 1; t + 1 < NT; t += 2) {
        HALF_STEP(pB0, pB1, mnB, alB, pA0, pA1, alA, t, 1, 0, 0);
        HALF_STEP(pA0, pA1, mnA, alA, pB0, pB1, alB, t + 1, 0, 1, 1);
    }
    SBAR(); qkt<1>(pB0, pB1, K_lds, r32, hi, comp, qr); SBAR();
    finishSM(pA0, pA1, alA, l_reg, pa0, pa1, pa2, pa3); SBAR();
    pv_tile<0>(o, vb0, pa0, pa1, pa2, pa3);
    MASKT(pB0, pB1, NT - 1); partialSM(pB0, pB1, m_reg, mnB, alB); __syncthreads(); RESC(alB);
    finishSM(pB0, pB1, alB, l_reg, pa0, pa1, pa2, pa3); SBAR(); pv_tile<1>(o, vb0, pa0, pa1, pa2, pa3);
    if (hi == 0) li_l[r32] = l_reg; asm volatile("s_waitcnt lgkmcnt(0)" ::: "memory");
    float rli[16];
#pragma unroll
    for (int r = 0; r < 16; ++r) rli[r] = __builtin_amdgcn_rcpf(li_l[crow(r, hi)]);
    if (comp == 1) {
#pragma unroll
        for (int r = 0; r < 16; ++r) { const float f = rli[r] * lam;
#pragma unroll
            for (int d0 = 0; d0 < 4; ++d0) exch[crow(r, hi) * 128 + d0 * 32 + r32] = o[d0][r] * f; }
    }
    __syncthreads();
    if (comp == 0) {
        float gsc[4];
#pragma unroll
        for (int d0 = 0; d0 < 4; ++d0) gsc[d0] = subln[d0 * 32 + r32] * (1.f - LAMBDA_INIT);
#pragma unroll
        for (int r = 0; r < 16; ++r) { const int orow = crow(r, hi); float v[4]; float s = 0.f;
#pragma unroll
            for (int d0 = 0; d0 < 4; ++d0) { v[d0] = o[d0][r] * rli[r] - exch[orow * 128 + d0 * 32 + r32]; s += v[d0] * v[d0]; }
            s += __shfl_xor(s, 1); s += __shfl_xor(s, 2); s += __shfl_xor(s, 4); s += __shfl_xor(s, 8); s += __shfl_xor(s, 16);
            const float rs = 1.0f / sqrtf(s * (1.f / 128.f) + EPS);
#pragma unroll
            for (int d0 = 0; d0 < 4; ++d0) { const float w = v[d0] * rs * gsc[d0]; const float wn = __shfl_xor(w, 1);
                if ((r32 & 1) == 0) *(unsigned*)(Og + (size_t)(qlo + orow) * PITCH + d0 * 32 + r32) = cvt_pk_bf16(w, wn); } }
    }
    __syncthreads();
#undef ROW
#undef LD8
#undef SLOAD_H
#undef SWRITE_HK
#undef SWRITE_HV
#undef VMW
#undef RESC
#undef KBASE
#undef MASKT
#undef HALF_STEP
}
#undef KSWZ
#undef SBAR
}

namespace gla {
constexpr int PT = 144, PW = 272;
constexpr int L_QD = 0, L_KI = 9216, L_KIT = 18432, L_VT = 27648, L_SBT = 46080, L_ATT = 64512, L_DEC = 73728;
constexpr int L_QR = 73984, L_KR = L_QR + 9216, L_LR = L_KR + 9216, L_OT = L_LR + 17408, LDS_NEED = L_OT + 17408;
static_assert(LDS_NEED <= RING_BYTES + 4096, "gla lds");
__device__ __forceinline__ float wave_scan(float x) {
#define DPPF(v, ctrl, rmask) __int_as_float(__builtin_amdgcn_update_dpp(0, __float_as_int(v), (ctrl), (rmask), 0xf, false))
    x += DPPF(x, 0x111, 0xf); x += DPPF(x, 0x112, 0xf); x += DPPF(x, 0x114, 0xf); x += DPPF(x, 0x118, 0xf);
    x += DPPF(x, 0x142, 0xa); x += DPPF(x, 0x143, 0xc);
#undef DPPF
    return x;
}
struct Stage { v4u rq, rk, rla0, rla1, rv0, rv1; };
#define GBAR() asm volatile("s_waitcnt lgkmcnt(0)\n\ts_barrier" ::: "memory")
__device__ __forceinline__ void gla_item(int b, int h, const bf16_t* gq, const bf16_t* gk, const bf16_t* gv, const bf16_t* sr, const float* la, const float* gnorm, bf16_t* oa, LAS unsigned char* lds) {
    int tid = threadIdx.x; asm volatile("" : "+v"(tid));
    const int w = __builtin_amdgcn_readfirstlane(tid >> 6), lane = tid & 63, l15 = lane & 15, lq = lane >> 4;
    const size_t tok0 = (size_t)b * SEQ;
    constexpr int NCH = SEQ / 64;
    const int qrow = tid >> 3, qch = tid & 7;
    const int prow0 = tid >> 4, pch = tid & 15;
    const int vrow = 16 * (w & 3) + l15, vch0 = lq + 4 * (w >> 2);
    const bf16_t* qg = gq + (tok0 + qrow) * 256 + h * 64 + qch * 8;
    const bf16_t* kg = gk + (tok0 + qrow) * 256 + h * 64 + qch * 8;
    const float* lg = la + (tok0 + prow0) * 256 + h * 64 + pch * 4;
    const bf16_t* vg = gv + (tok0 + vrow) * 512 + h * 128 + vch0 * 8;
    const bf16_t* sg = sr + (tok0 + prow0) * 512 + h * 128 + pch * 8;
    bf16_t* og = oa + (tok0 + prow0) * 512 + h * 128 + pch * 8;
#define GLA_LOAD(ST, n_) do { const size_t adv_ = (size_t)((n_) < NCH ? (n_) : NCH - 1) * 64; \
        ST.rq = *(const v4u*)(qg + adv_ * 256); ST.rk = *(const v4u*)(kg + adv_ * 256); \
        ST.rla0 = *(const v4u*)(lg + adv_ * 256); ST.rla1 = *(const v4u*)(lg + (adv_ + 32) * 256); \
        ST.rv0 = *(const v4u*)(vg + adv_ * 512); ST.rv1 = *(const v4u*)(vg + adv_ * 512 + 64); } while (0)
#define GLA_RAW(ST) do { *(LAS v4u*)(lds + L_QR + qrow * PT + qch * 16) = ST.rq; *(LAS v4u*)(lds + L_KR + qrow * PT + qch * 16) = ST.rk; \
        *(LAS v4u*)(lds + L_LR + prow0 * PW + pch * 16) = ST.rla0; *(LAS v4u*)(lds + L_LR + (prow0 + 32) * PW + pch * 16) = ST.rla1; } while (0)
#define SR_LOAD(S0, S1, n_) do { const size_t adv_ = (size_t)((n_) < NCH ? (n_) : NCH - 1) * 64; S0 = *(const v4u*)(sg + adv_ * 512); S1 = *(const v4u*)(sg + (adv_ + 32) * 512); } while (0)
#define GLA_OUT(S0, S1, m_) do { const size_t adv_ = (size_t)(m_) * 64; \
        _Pragma("unroll") for (int i_ = 0; i_ < 2; ++i_) { const v4u ov = *(const LAS v4u*)(lds + L_OT + (prow0 + 32 * i_) * PW + pch * 16); const v4u sv = i_ ? S1 : S0; v4u r_; \
            r_.x = cvt_pk_bf16(bf_lo(ov.x) * bf_lo(sv.x), bf_hi(ov.x) * bf_hi(sv.x)); r_.y = cvt_pk_bf16(bf_lo(ov.y) * bf_lo(sv.y), bf_hi(ov.y) * bf_hi(sv.y)); \
            r_.z = cvt_pk_bf16(bf_lo(ov.z) * bf_lo(sv.z), bf_hi(ov.z) * bf_hi(sv.z)); r_.w = cvt_pk_bf16(bf_lo(ov.w) * bf_lo(sv.w), bf_hi(ov.w) * bf_hi(sv.w)); \
            *(v4u*)(og + (adv_ + 32 * i_) * 512) = r_; } } while (0)
    Stage sA, sB; v4u srA0, srA1, srB0 = {0u, 0u, 0u, 0u}, srB1 = {0u, 0u, 0u, 0u};
    GLA_LOAD(sA, 0); SR_LOAD(srA0, srA1, 0); GLA_LOAD(sB, 1);
    GLA_RAW(sA);
    f32x4 S[4][2];
#pragma unroll
    for (int i = 0; i < 4; ++i) { S[i][0] = (f32x4){0.f, 0.f, 0.f, 0.f}; S[i][1] = (f32x4){0.f, 0.f, 0.f, 0.f}; }
    const int sw = w - 4;
    const int c = 16 * w + l15;
    f32x4 gn[8];
#pragma unroll
    for (int vb = 0; vb < 8; ++vb) gn[vb] = *(const f32x4*)(gnorm + 16 * vb + 4 * lq);
    GBAR();
#define GLA_CHUNK(X, Y, SRS0, SRS1, n) do { \
          \
        if ((n) > 0) GLA_OUT(SRS0, SRS1, (n) - 1); \
        { const v4u q8 = *(const LAS v4u*)(lds + L_QR + lane * PT + 16 * w), k8 = *(const LAS v4u*)(lds + L_KR + lane * PT + 16 * w); \
          const f32x4 la0 = *(const LAS f32x4*)(lds + L_LR + lane * PW + 32 * w), la1 = *(const LAS f32x4*)(lds + L_LR + lane * PW + 32 * w + 16); \
          float bb[8] = {la0[0], la0[1], la0[2], la0[3], la1[0], la1[1], la1[2], la1[3]}; \
          unsigned qd[4], ki[4]; \
          _Pragma("unroll") for (int j = 0; j < 8; ++j) bb[j] = wave_scan(bb[j]); \
          _Pragma("unroll") for (int j = 0; j < 8; j += 2) { \
            const float e0 = __builtin_amdgcn_exp2f(bb[j] * LOG2E), e1 = __builtin_amdgcn_exp2f(bb[j + 1] * LOG2E); \
            const float i0 = __builtin_amdgcn_rcpf(e0), i1 = __builtin_amdgcn_rcpf(e1); \
            const unsigned qw = q8[j >> 1], kw = k8[j >> 1]; \
            qd[j >> 1] = cvt_pk_bf16(bf_lo(qw) * e0, bf_hi(qw) * e1); \
            ki[j >> 1] = cvt_pk_bf16(bf_lo(kw) * i0, bf_hi(kw) * i1); \
            const float d0 = __int_as_float(__builtin_amdgcn_readlane(__float_as_int(e0), 63)), d1 = __int_as_float(__builtin_amdgcn_readlane(__float_as_int(e1), 63)); \
            if (lane == 0) { *(LAS float*)(lds + L_DEC + (8 * w + j) * 4) = d0; *(LAS float*)(lds + L_DEC + (8 * w + j + 1) * 4) = d1; } \
            *(LAS unsigned short*)(lds + L_KIT + (8 * w + j) * PT + lane * 2) = (unsigned short)(ki[j >> 1] & 0xffffu); \
            *(LAS unsigned short*)(lds + L_KIT + (8 * w + j + 1) * PT + lane * 2) = (unsigned short)(ki[j >> 1] >> 16); \
          } \
          *(LAS v4u*)(lds + L_QD + lane * PT + 16 * w) = (v4u){qd[0], qd[1], qd[2], qd[3]}; \
          *(LAS v4u*)(lds + L_KI + lane * PT + 16 * w) = (v4u){ki[0], ki[1], ki[2], ki[3]}; } \
        _Pragma("unroll") for (int i = 0; i < 4; ++i) { \
            *(LAS unsigned short*)(lds + L_VT + (vch0 * 8 + 2 * i) * PT + vrow * 2) = (unsigned short)(X.rv0[i] & 0xffffu); \
            *(LAS unsigned short*)(lds + L_VT + (vch0 * 8 + 2 * i + 1) * PT + vrow * 2) = (unsigned short)(X.rv0[i] >> 16); \
            *(LAS unsigned short*)(lds + L_VT + (vch0 * 8 + 64 + 2 * i) * PT + vrow * 2) = (unsigned short)(X.rv1[i] & 0xffffu); \
            *(LAS unsigned short*)(lds + L_VT + (vch0 * 8 + 64 + 2 * i + 1) * PT + vrow * 2) = (unsigned short)(X.rv1[i] >> 16); \
        } \
        if (w >= 4) { \
            _Pragma("unroll") for (int db = 0; db < 4; ++db) \
                _Pragma("unroll") for (int vb = 0; vb < 2; ++vb) { v2u o_; o_.x = cvt_pk_bf16(S[db][vb][0], S[db][vb][1]); o_.y = cvt_pk_bf16(S[db][vb][2], S[db][vb][3]); \
                    *(LAS v2u*)(lds + L_SBT + (32 * sw + 16 * vb + l15) * PT + (16 * db + 4 * lq) * 2) = o_; } \
        } \
        GBAR(); \
          \
        GLA_RAW(Y); \
        GLA_LOAD(X, (n) + 2); SR_LOAD(SRS0, SRS1, (n) + 1); \
        if (w < 4) { \
            bf16x8 qf[2]; \
            _Pragma("unroll") for (int ks = 0; ks < 2; ++ks) qf[ks] = *(const LAS bf16x8*)(lds + L_QD + (16 * w + l15) * PT + (32 * ks + 8 * lq) * 2); \
            _Pragma("unroll") for (int sb = 0; sb < 4; ++sb) { \
                f32x4 a = (f32x4){0.f, 0.f, 0.f, 0.f}; \
                _Pragma("unroll") for (int ks = 0; ks < 2; ++ks) { const bf16x8 kf = *(const LAS bf16x8*)(lds + L_KI + (16 * sb + l15) * PT + (32 * ks + 8 * lq) * 2); \
                    a = __builtin_amdgcn_mfma_f32_16x16x32_bf16(kf, qf[ks], a, 0, 0, 0); } \
                _Pragma("unroll") for (int r = 0; r < 4; ++r) if (16 * sb + 4 * lq + r > c) a[r] = 0.f; \
                v2u o_; o_.x = cvt_pk_bf16(a[0], a[1]); o_.y = cvt_pk_bf16(a[2], a[3]); \
                *(LAS v2u*)(lds + L_ATT + w * 2304 + l15 * PT + (16 * sb + 4 * lq) * 2) = o_; \
            } \
            asm volatile("s_waitcnt lgkmcnt(0)" ::: "memory"); \
            bf16x8 af[2]; \
            _Pragma("unroll") for (int ks = 0; ks < 2; ++ks) af[ks] = *(const LAS bf16x8*)(lds + L_ATT + w * 2304 + l15 * PT + (32 * ks + 8 * lq) * 2); \
            f32x4 o[8]; float ssq = 0.f; \
            _Pragma("unroll") for (int vb = 0; vb < 8; ++vb) { \
                f32x4 a = (f32x4){0.f, 0.f, 0.f, 0.f}; \
                _Pragma("unroll") for (int ks = 0; ks < 2; ++ks) { const bf16x8 vf = *(const LAS bf16x8*)(lds + L_VT + (16 * vb + l15) * PT + (32 * ks + 8 * lq) * 2); \
                    a = __builtin_amdgcn_mfma_f32_16x16x32_bf16(vf, af[ks], a, 0, 0, 0); } \
                _Pragma("unroll") for (int ks = 0; ks < 2; ++ks) { const bf16x8 sf = *(const LAS bf16x8*)(lds + L_SBT + (16 * vb + l15) * PT + (32 * ks + 8 * lq) * 2); \
                    a = __builtin_amdgcn_mfma_f32_16x16x32_bf16(sf, qf[ks], a, 0, 0, 0); } \
                o[vb] = a; ssq += (a[0] * a[0] + a[1] * a[1]) + (a[2] * a[2] + a[3] * a[3]); \
            } \
            ssq += __shfl_xor(ssq, 16); ssq += __shfl_xor(ssq, 32); \
            const float rs = 1.0f / sqrtf(ssq * (1.f / 128.f) + EPS); \
            _Pragma("unroll") for (int vb = 0; vb < 8; ++vb) { const f32x4 g = gn[vb] * rs; \
                v2u w2; w2.x = cvt_pk_bf16(o[vb][0] * g[0], o[vb][1] * g[1]); w2.y = cvt_pk_bf16(o[vb][2] * g[2], o[vb][3] * g[3]); \
                *(LAS v2u*)(lds + L_OT + c * PW + (16 * vb + 4 * lq) * 2) = w2; } \
        } else { \
            _Pragma("unroll") for (int ks = 0; ks < 2; ++ks) { \
                bf16x8 vf[2]; \
                _Pragma("unroll") for (int vb = 0; vb < 2; ++vb) vf[vb] = *(const LAS bf16x8*)(lds + L_VT + (32 * sw + 16 * vb + l15) * PT + (32 * ks + 8 * lq) * 2); \
                _Pragma("unroll") for (int db = 0; db < 4; ++db) { const bf16x8 kf = *(const LAS bf16x8*)(lds + L_KIT + (16 * db + l15) * PT + (32 * ks + 8 * lq) * 2); \
                    _Pragma("unroll") for (int vb = 0; vb < 2; ++vb) S[db][vb] = __builtin_amdgcn_mfma_f32_16x16x32_bf16(kf, vf[vb], S[db][vb], 0, 0, 0); } \
            } \
            _Pragma("unroll") for (int db = 0; db < 4; ++db) { const f32x4 dc = *(const LAS f32x4*)(lds + L_DEC + (16 * db + 4 * lq) * 4); S[db][0] = S[db][0] * dc; S[db][1] = S[db][1] * dc; } \
        } \
        GBAR(); \
    } while (0)
#pragma unroll 1
    for (int n = 0; n < NCH; n += 2) { GLA_CHUNK(sA, sB, srB0, srB1, n); GLA_CHUNK(sB, sA, srA0, srA1, n + 1); }
    GLA_OUT(srB0, srB1, NCH - 1);
    GBAR();
#undef GLA_CHUNK
#undef GLA_LOAD
#undef GLA_RAW
#undef SR_LOAD
#undef GLA_OUT
}
#undef GBAR
}

namespace pg8 {
struct PleOrder {
    StaticOrder so; int G, c;
    __device__ __forceinline__ bool next(int i, Unit& u) const {
        if (G != 256) return so.next(i, u);
        if (c < 128 || i >= 4) return false; const int L = (c - 128) * 4 + i; u.pm = L >> 2; u.pn = L & 3; return true; }
    __device__ __forceinline__ unsigned arow(const Unit&, int) const { return 0u; }
};
struct BranchOrder {
    StaticOrder so;
    __device__ __forceinline__ bool next(int i, Unit& u) const { Unit t; if (!so.next(i >> 1, t)) return false; u.pm = t.pm + (i & 1) * 128; u.pn = t.pn + (i & 1) * 4; return true; }
    __device__ __forceinline__ unsigned arow(const Unit&, int) const { return 0u; }
};
struct EpiBranch {
    static constexpr bool PERM = true;
    const bf16_t* gates; bf16_t* m1; bf16_t* mg;
    __device__ __forceinline__ void operator()(const f32x4 (&acc)[2][2][4][2], const Unit& u, int wr, int wc, int fr, int fq) const {
        const bool isb = u.pm >= 128; const int pm = isb ? u.pm - 128 : u.pm, pn = isb ? u.pn - 4 : u.pn;
        const int row0 = pm * BM + wr * 64 + fr, col0 = pn * BM + wc * 32 + 8 * fq, tid = (wr * 4 + wc) * 64 + fq * 16 + fr, tile = pm * 4 + pn;
        const unsigned char* gp = (const unsigned char*)gates + tp_off((isb ? 512 : 0) + tile, 0, tid); unsigned char* m1p = (unsigned char*)m1 + tp_off(tile, 0, tid);
        bf16_t* mp = mg + (size_t)row0 * DM + col0;
#pragma unroll
        for (int ai = 0; ai < 2; ++ai) {
            v4u G[4][2], Pm[4][2];
#pragma unroll
            for (int m = 0; m < 4; ++m)
#pragma unroll
                for (int bj = 0; bj < 2; ++bj) G[m][bj] = *(const v4u*)(gp + (size_t)((ai * 4 + m) * 2 + bj) * 8192);
            if (isb) {
#pragma unroll
                for (int m = 0; m < 4; ++m)
#pragma unroll
                    for (int bj = 0; bj < 2; ++bj) Pm[m][bj] = *(const v4u*)(m1p + (size_t)((ai * 4 + m) * 2 + bj) * 8192);
            } else {
#pragma unroll
                for (int m = 0; m < 4; ++m)
#pragma unroll
                    for (int bj = 0; bj < 2; ++bj) Pm[m][bj] = (v4u){0u, 0u, 0u, 0u};
            }
#pragma unroll
            for (int m = 0; m < 4; ++m)
#pragma unroll
                for (int bj = 0; bj < 2; ++bj) { const v4u g = G[m][bj], p = Pm[m][bj];
                    const f32x4 a0 = acc[ai][bj][m][0], a1 = acc[ai][bj][m][1];
                    const float r0 = a0[0] * bf_lo(g.x) + bf_lo(p.x), r1 = a0[1] * bf_hi(g.x) + bf_hi(p.x), r2 = a0[2] * bf_lo(g.y) + bf_lo(p.y), r3 = a0[3] * bf_hi(g.y) + bf_hi(p.y);
                    const float r4 = a1[0] * bf_lo(g.z) + bf_lo(p.z), r5 = a1[1] * bf_hi(g.z) + bf_hi(p.z), r6 = a1[2] * bf_lo(g.w) + bf_lo(p.w), r7 = a1[3] * bf_hi(g.w) + bf_hi(p.w);
                    v4u w; w.x = cvt_pk_bf16(r0, r1); w.y = cvt_pk_bf16(r2, r3); w.z = cvt_pk_bf16(r4, r5); w.w = cvt_pk_bf16(r6, r7);
                    if (isb) *(v4u*)(mp + (size_t)(ai * HALF + m * 16) * DM + bj * HALF) = w;
                    else *(v4u*)(m1p + (size_t)((ai * 4 + m) * 2 + bj) * 8192) = w; }
        }
    }
};
template <bool LOADS, bool STORES> struct EpiBranchProbe {
    static constexpr bool PERM = true;
    const bf16_t* gates; bf16_t* m1; bf16_t* mg;
    __device__ __forceinline__ void operator()(const f32x4 (&acc)[2][2][4][2], const Unit& u, int wr, int wc, int fr, int fq) const {
        const bool isb = u.pm >= 128; const int pm = isb ? u.pm - 128 : u.pm, pn = isb ? u.pn - 4 : u.pn;
        const int row0 = pm * BM + wr * 64 + fr, col0 = pn * BM + wc * 32 + 8 * fq, tid = (wr * 4 + wc) * 64 + fq * 16 + fr, tile = pm * 4 + pn;
        const unsigned char* gp = (const unsigned char*)gates + tp_off((isb ? 512 : 0) + tile, 0, tid); unsigned char* m1p = (unsigned char*)m1 + tp_off(tile, 0, tid);
        bf16_t* mp = mg + (size_t)row0 * DM + col0;
#pragma unroll
        for (int ai = 0; ai < 2; ++ai) {
            v4u G[4][2], Pm[4][2];
#pragma unroll
            for (int m = 0; m < 4; ++m)
#pragma unroll
                for (int bj = 0; bj < 2; ++bj) G[m][bj] = LOADS ? *(const v4u*)(gp + (size_t)((ai * 4 + m) * 2 + bj) * 8192) : (v4u){0x3f803f80u, 0x3f803f80u, 0x3f803f80u, 0x3f803f80u};
            if (isb && LOADS) {
#pragma unroll
                for (int m = 0; m < 4; ++m)
#pragma unroll
                    for (int bj = 0; bj < 2; ++bj) Pm[m][bj] = *(const v4u*)(m1p + (size_t)((ai * 4 + m) * 2 + bj) * 8192);
            } else {
#pragma unroll
                for (int m = 0; m < 4; ++m)
#pragma unroll
                    for (int bj = 0; bj < 2; ++bj) Pm[m][bj] = (v4u){0u, 0u, 0u, 0u};
            }
#pragma unroll
            for (int m = 0; m < 4; ++m)
#pragma unroll
                for (int bj = 0; bj < 2; ++bj) { const v4u g = G[m][bj], p = Pm[m][bj];
                    const f32x4 a0 = acc[ai][bj][m][0], a1 = acc[ai][bj][m][1];
                    const float r0 = a0[0] * bf_lo(g.x) + bf_lo(p.x), r1 = a0[1] * bf_hi(g.x) + bf_hi(p.x), r2 = a0[2] * bf_lo(g.y) + bf_lo(p.y), r3 = a0[3] * bf_hi(g.y) + bf_hi(p.y);
                    const float r4 = a1[0] * bf_lo(g.z) + bf_lo(p.z), r5 = a1[1] * bf_hi(g.z) + bf_hi(p.z), r6 = a1[2] * bf_lo(g.w) + bf_lo(p.w), r7 = a1[3] * bf_hi(g.w) + bf_hi(p.w);
                    v4u w; w.x = cvt_pk_bf16(r0, r1); w.y = cvt_pk_bf16(r2, r3); w.z = cvt_pk_bf16(r4, r5); w.w = cvt_pk_bf16(r6, r7);
                    if (STORES) { if (isb) *(v4u*)(mp + (size_t)(ai * HALF + m * 16) * DM + bj * HALF) = w;
                    else *(v4u*)(m1p + (size_t)((ai * 4 + m) * 2 + bj) * 8192) = w; }
                    else if (w.x == 0x12345678u && w.y == 0x9abcdef0u) *(v4u*)(m1p) = w; }
        }
    }
};
struct EpiNull { static constexpr bool PERM = true; float* sink;
    __device__ __forceinline__ void operator()(const f32x4 (&acc)[2][2][4][2], const Unit& u, int wr, int wc, int fr, int fq) const {
        float s = 0.f;
#pragma unroll
        for (int ai = 0; ai < 2; ++ai)
#pragma unroll
            for (int bj = 0; bj < 2; ++bj)
#pragma unroll
                for (int m = 0; m < 4; ++m)
#pragma unroll
                    for (int n = 0; n < 2; ++n) s += acc[ai][bj][m][n][0] + acc[ai][bj][m][n][1] + acc[ai][bj][m][n][2] + acc[ai][bj][m][n][3];
        if (s == 1.2345e-30f) *sink = s; } };
struct EpiOut {
    static constexpr bool PERM = true;
    const float* x; bf16_t* hb; float* ss;
    __device__ __forceinline__ void operator()(const f32x4 (&acc)[2][2][4][2], const Unit& u, int wr, int wc, int fr, int fq) const {
        const int row0 = u.pm * BM + wr * 64 + fr, col0 = u.pn * BM + wc * 32 + 8 * fq;
        const float* xp = x + (size_t)row0 * DM + col0; bf16_t* hp = hb + (size_t)row0 * DM + col0;
#pragma unroll
        for (int ai = 0; ai < 2; ++ai) {
            f32x4 X[4][2][2];
#pragma unroll
            for (int m = 0; m < 4; ++m)
#pragma unroll
                for (int bj = 0; bj < 2; ++bj) { const float* q = xp + (size_t)(ai * HALF + m * 16) * DM + bj * HALF; X[m][bj][0] = *(const f32x4*)q; X[m][bj][1] = *(const f32x4*)(q + 4); }
#pragma unroll
            for (int m = 0; m < 4; ++m) { float s = 0.f;
#pragma unroll
                for (int bj = 0; bj < 2; ++bj) { const f32x4 v0 = acc[ai][bj][m][0] + X[m][bj][0], v1 = acc[ai][bj][m][1] + X[m][bj][1];
                    s += (v0[0] * v0[0] + v0[1] * v0[1]) + (v0[2] * v0[2] + v0[3] * v0[3]) + (v1[0] * v1[0] + v1[1] * v1[1]) + (v1[2] * v1[2] + v1[3] * v1[3]);
                    v4u w; w.x = cvt_pk_bf16(v0[0], v0[1]); w.y = cvt_pk_bf16(v0[2], v0[3]); w.z = cvt_pk_bf16(v1[0], v1[1]); w.w = cvt_pk_bf16(v1[2], v1[3]);
                    *(v4u*)(hp + (size_t)(ai * HALF + m * 16) * DM + bj * HALF) = w; }
                s += __shfl_xor(s, 16); s += __shfl_xor(s, 32);
                if (fq == 0) atomicAdd(ss + row0 + ai * HALF + m * 16, s); }
        }
    }
};
template <int npn> struct MoeOrder {
    const LAS int* ts; const LAS int* cnt; const int* list; const float* lval; int G, c;
    __device__ __forceinline__ int expert_of(int tile) const { int e = 0;
#pragma unroll 1
        for (int i = 1; i < NEXP; ++i) if (ts[i] <= tile) e = i; return e; }
    __device__ __forceinline__ bool next(int i, Unit& u) const {
        const int L = i * G + c, total = ts[NEXP] * npn; if (L >= total) return false;
        const int tile = L / npn, pl = L % npn; u.pm = tile; u.pn = expert_of(tile) * npn + pl; return true; }
    __device__ __forceinline__ int entry(const Unit& u, int r) const { const int e = u.pn / npn, pos = (u.pm - ts[e]) * BM + r; return pos < cnt[e] ? list[(size_t)e * T + pos] : -1; }
    __device__ __forceinline__ unsigned arow(const Unit& u, int r) const { const int en = entry(u, r); return en < 0 ? 0u : (unsigned)(en >> 1); }
    __device__ __forceinline__ size_t lpos(const Unit& u, int r, bool& valid) const { const int e = u.pn / npn, pos = (u.pm - ts[e]) * BM + r; valid = pos < cnt[e]; return (size_t)e * T + (valid ? pos : 0); }
};
struct EpiUp {
    static constexpr bool PERM = true;
    MoeOrder<2> mo; bf16_t* he;
    __device__ __forceinline__ void operator()(const f32x4 (&acc)[2][2][4][2], const Unit& u, int wr, int wc, int fr, int fq) const {
        const int pl = u.pn & 1, col0 = pl * 128 + wc * 32 + 8 * fq;
        float rsv[2][4];
#pragma unroll
        for (int ai = 0; ai < 2; ++ai)
#pragma unroll
            for (int m = 0; m < 4; ++m) { bool valid; const size_t lp = mo.lpos(u, ai * HALF + wr * 64 + m * 16 + fr, valid); const float v = mo.lval[lp]; rsv[ai][m] = valid ? v : 0.f; }
#pragma unroll
        for (int ai = 0; ai < 2; ++ai)
#pragma unroll
            for (int m = 0; m < 4; ++m) { const int r = ai * HALF + wr * 64 + m * 16 + fr; const float rs = rsv[ai][m];
                const f32x4 g0 = acc[ai][0][m][0] * rs, g1 = acc[ai][0][m][1] * rs, u0 = acc[ai][1][m][0] * rs, u1 = acc[ai][1][m][1] * rs;
                v4u w; w.x = cvt_pk_bf16(g0[0] * sigmoidf_(g0[0]) * u0[0], g0[1] * sigmoidf_(g0[1]) * u0[1]); w.y = cvt_pk_bf16(g0[2] * sigmoidf_(g0[2]) * u0[2], g0[3] * sigmoidf_(g0[3]) * u0[3]);
                w.z = cvt_pk_bf16(g1[0] * sigmoidf_(g1[0]) * u1[0], g1[1] * sigmoidf_(g1[1]) * u1[1]); w.w = cvt_pk_bf16(g1[2] * sigmoidf_(g1[2]) * u1[2], g1[3] * sigmoidf_(g1[3]) * u1[3]);
                *(v4u*)(he + (size_t)(u.pm * BM + r) * DEXP + col0) = w; }
    }
};
struct EpiDown {
    static constexpr bool PERM = true;
    MoeOrder<4> mo; bf16_t* yb;
    __device__ __forceinline__ void operator()(const f32x4 (&acc)[2][2][4][2], const Unit& u, int wr, int wc, int fr, int fq) const {
        const int col0 = (u.pn & 3) * BM + wc * 32 + 8 * fq;
        float wv[2][4]; int env[2][4];
#pragma unroll
        for (int ai = 0; ai < 2; ++ai)
#pragma unroll
            for (int m = 0; m < 4; ++m) { bool valid; const size_t lp = mo.lpos(u, ai * HALF + wr * 64 + m * 16 + fr, valid); const float v = mo.lval[lp]; const int en = mo.list[lp]; wv[ai][m] = v; env[ai][m] = valid ? en : -1; }
#pragma unroll
        for (int ai = 0; ai < 2; ++ai)
#pragma unroll
            for (int m = 0; m < 4; ++m) { const int en = env[ai][m];
                if (en >= 0) { const float wt = wv[ai][m];
#pragma unroll
                    for (int bj = 0; bj < 2; ++bj) { const f32x4 v0 = acc[ai][bj][m][0] * wt, v1 = acc[ai][bj][m][1] * wt;
                        v4u w; w.x = cvt_pk_bf16(v0[0], v0[1]); w.y = cvt_pk_bf16(v0[2], v0[3]); w.z = cvt_pk_bf16(v1[0], v1[1]); w.w = cvt_pk_bf16(v1[2], v1[3]);
                        *(v4u*)(yb + (size_t)en * DM + col0 + bj * HALF) = w; } } }
    }
};
struct EpiFinal {
    static constexpr bool PERM = true;
    const bf16_t* h2b; const bf16_t* er; const float* sse; const float* gple; bf16_t* vb16; float* ssf;
    __device__ __forceinline__ void operator()(const f32x4 (&acc)[2][2][4][2], const Unit& u, int wr, int wc, int fr, int fq) const {
        const int row0 = u.pm * BM + wr * 64 + fr, col0 = u.pn * BM + wc * 32 + 8 * fq;
#pragma unroll
        for (int ai = 0; ai < 2; ++ai)
#pragma unroll
        for (int mh = 0; mh < 2; ++mh) {
            v4u H[2][2], Ee[2][2]; float rev[2];
#pragma unroll
            for (int mm = 0; mm < 2; ++mm) { const int m = mh * 2 + mm; rev[mm] = sse[row0 + ai * HALF + m * 16];
#pragma unroll
                for (int bj = 0; bj < 2; ++bj) { const size_t off = (size_t)(row0 + ai * HALF + m * 16) * DM + col0 + bj * HALF; H[mm][bj] = *(const v4u*)(h2b + off); Ee[mm][bj] = *(const v4u*)((const unsigned char*)er + tp_off(u.pm * 4 + u.pn, (ai * 4 + m) * 2 + bj, (wr * 4 + wc) * 64 + fq * 16 + fr)); } }
#pragma unroll
            for (int mm = 0; mm < 2; ++mm) { const int m = mh * 2 + mm; const int row = row0 + ai * HALF + m * 16; float s = 0.f; const float re = 1.0f / sqrtf(rev[mm] * (1.f / DM) + EPS);
#pragma unroll
                for (int bj = 0; bj < 2; ++bj) { const size_t off = (size_t)row * DM + col0 + bj * HALF;
                    const v4u hh = H[mm][bj], ee = Ee[mm][bj]; const f32x4 g0 = *(const f32x4*)(gple + col0 + bj * HALF) * re, g1 = *(const f32x4*)(gple + col0 + bj * HALF + 4) * re;
                    const f32x4 a0 = acc[ai][bj][m][0], a1 = acc[ai][bj][m][1]; f32x4 v0, v1;
                    v0[0] = bf_lo(hh.x) + sigmoidf_(a0[0]) * bf_lo(ee.x) * g0[0]; v0[1] = bf_hi(hh.x) + sigmoidf_(a0[1]) * bf_hi(ee.x) * g0[1];
                    v0[2] = bf_lo(hh.y) + sigmoidf_(a0[2]) * bf_lo(ee.y) * g0[2]; v0[3] = bf_hi(hh.y) + sigmoidf_(a0[3]) * bf_hi(ee.y) * g0[3];
                    v1[0] = bf_lo(hh.z) + sigmoidf_(a1[0]) * bf_lo(ee.z) * g1[0]; v1[1] = bf_hi(hh.z) + sigmoidf_(a1[1]) * bf_hi(ee.z) * g1[1];
                    v1[2] = bf_lo(hh.w) + sigmoidf_(a1[2]) * bf_lo(ee.w) * g1[2]; v1[3] = bf_hi(hh.w) + sigmoidf_(a1[3]) * bf_hi(ee.w) * g1[3];
                    s += (v0[0] * v0[0] + v0[1] * v0[1]) + (v0[2] * v0[2] + v0[3] * v0[3]) + (v1[0] * v1[0] + v1[1] * v1[1]) + (v1[2] * v1[2] + v1[3] * v1[3]);
                    v4u wv; wv.x = cvt_pk_bf16(v0[0], v0[1]); wv.y = cvt_pk_bf16(v0[2], v0[3]); wv.z = cvt_pk_bf16(v1[0], v1[1]); wv.w = cvt_pk_bf16(v1[2], v1[3]);
                    *(v4u*)(vb16 + off) = wv; }
                s += __shfl_xor(s, 16); s += __shfl_xor(s, 32);
                if (fq == 0) atomicAdd(ssf + row, s); }
        }
    }
};
}

constexpr int WR_PT = 2064;
__device__ __forceinline__ void p4_router(const Frame& F, const Params& P) {
    unsigned char* ws = PWS(); unsigned* ctl = (unsigned*)(ws + WS_CTL);
    const bf16_t* hb = (const bf16_t*)(ws + WS_XB); const bf16_t* Wr = (const bf16_t*)(ws + WS_WR); const float* ss2 = (const float*)(ctl + CW_SS2);
    const float* b_rg = PIN(18); const float* b_re = PIN(20);
    int* list = (int*)(ws + WS_LIST); float* lrs = (float*)(ws + WS_LRS); float* lw = (float*)(ws + WS_LW);
    LAS unsigned char* lds = F.lds; const int lane = F.lane, w = F.wave, l15 = lane & 15, lq = lane >> 4;
    for (int i = F.tid; i < 48 * 128; i += NTHREADS) { const int r = i >> 7, c = i & 127; *(LAS v4u*)(lds + r * WR_PT + c * 16) = *(const v4u*)(Wr + (size_t)r * DM + c * 8); }
    LAS int* lcnt = (LAS int*)(lds + 100352);
    LAS float* lsc = (LAS float*)(lds + 101376) + w * (16 * 49);
    for (int grp = F.vcu * 8 + w; grp < T / 16; grp += F.G * 8) {
        if (F.tid < 64) lcnt[F.tid] = 0;
        __syncthreads();
        const int t0 = grp * 16;
        f32x4 a0 = {0.f, 0.f, 0.f, 0.f}, a1 = a0, a2 = a0;
        const bf16_t* hrow = hb + (size_t)(t0 + l15) * DM + 8 * lq;
#pragma unroll 4
        for (int ks = 0; ks < 32; ++ks) { const bf16x8 hf = *(const bf16x8*)(hrow + 32 * ks);
            const bf16x8 w0 = *(const LAS bf16x8*)(lds + (l15) * WR_PT + (32 * ks + 8 * lq) * 2), w1 = *(const LAS bf16x8*)(lds + (16 + l15) * WR_PT + (32 * ks + 8 * lq) * 2), w2 = *(const LAS bf16x8*)(lds + (32 + l15) * WR_PT + (32 * ks + 8 * lq) * 2);
            a0 = __builtin_amdgcn_mfma_f32_16x16x32_bf16(w0, hf, a0, 0, 0, 0); a1 = __builtin_amdgcn_mfma_f32_16x16x32_bf16(w1, hf, a1, 0, 0, 0); a2 = __builtin_amdgcn_mfma_f32_16x16x32_bf16(w2, hf, a2, 0, 0, 0); }
#pragma unroll
        for (int r = 0; r < 4; ++r) { lsc[l15 * 49 + 4 * lq + r] = a0[r]; lsc[l15 * 49 + 16 + 4 * lq + r] = a1[r]; lsc[l15 * 49 + 32 + 4 * lq + r] = a2[r]; }
        asm volatile("s_waitcnt lgkmcnt(0)" ::: "memory");
        int e0g = 0, e1g = 0, s0 = 0, s1 = 0; float w0 = 0.f, w1 = 0.f, rsk = 0.f;
        if (lane < 16) { const int t = t0 + lane; const float rs = 1.0f / sqrtf(ss2[t] * (1.f / DM) + EPS); rsk = rs; const LAS float* lg = lsc + lane * 49;
            int g = 0; float mg = lg[0] * rs + b_rg[0]; float gl[4]; gl[0] = mg;
#pragma unroll
            for (int i = 1; i < 4; ++i) { gl[i] = lg[i] * rs + b_rg[i]; if (gl[i] > mg) { mg = gl[i]; g = i; } }
            float sg = 0.f;
#pragma unroll
            for (int i = 0; i < 4; ++i) sg += __expf(gl[i] - mg);
            const float gp = 1.f / sg;
            float m0 = -INFINITY, m1 = -INFINITY; int i0 = 0, i1 = 0;
            for (int i = 0; i < 8; ++i) { const float v = lg[4 + g * 8 + i] * rs + b_re[g * 8 + i]; if (v > m0) { m1 = m0; i1 = i0; m0 = v; i0 = i; } else if (v > m1) { m1 = v; i1 = i; } }
            const float p1 = __expf(m1 - m0), inv = 1.f / (1.f + p1);
            e0g = g * 8 + i0; e1g = g * 8 + i1; w0 = gp * inv; w1 = gp * p1 * inv;
            s0 = atomicAdd((int*)&lcnt[e0g], 1); s1 = atomicAdd((int*)&lcnt[e1g], 1);
            }
        __syncthreads();
        if (F.tid < 32) { const int c = lcnt[F.tid]; lcnt[32 + F.tid] = c ? atomicAdd((int*)(ctl + CW_CNT + F.tid), c) : 0; }
        __syncthreads();
        if (lane < 16) { const int t = t0 + lane; const size_t p0 = (size_t)e0g * T + lcnt[32 + e0g] + s0, p1 = (size_t)e1g * T + lcnt[32 + e1g] + s1;
            list[p0] = t * 2; list[p1] = t * 2 + 1; lrs[p0] = rsk; lrs[p1] = rsk; lw[p0] = w0; lw[p1] = w1; }
        __syncthreads();
    }
}
__device__ __forceinline__ void moe_tables(const Frame& F, const unsigned* ctl) {
    LAS int* ts = (LAS int*)(F.lds + XTRA_OFF); LAS int* cnt = ts + 64;
    if (F.tid == 0) { int acc = 0; for (int e = 0; e < NEXP; ++e) { const int c = (int)__hip_atomic_load(ctl + CW_CNT + e, __ATOMIC_RELAXED, __HIP_MEMORY_SCOPE_AGENT); cnt[e] = c; ts[e] = acc; acc += (c + 255) >> 8; } ts[NEXP] = acc; }
    __syncthreads();
}

#ifndef PM
#define PM 0xfff
#endif
#ifndef PROBE
#define PROBE 0
#endif
#ifndef P1_ALIGN
#define P1_ALIGN true
#endif
__global__ void __launch_bounds__(NTHREADS, 2) fwd_megakernel(Params P) {
    extern __shared__ __attribute__((aligned(16))) unsigned char lds_raw[];
    Frame F;
    F.lds = (LAS unsigned char*)lds_raw;
    F.tid = threadIdx.x; F.lane = F.tid & 63; F.wave = __builtin_amdgcn_readfirstlane(F.tid >> 6);
    F.G = gridDim.x; { const int bx = blockIdx.x; F.vcu = (F.G % 8 == 0) ? (bx % 8) * (F.G / 8) + bx / 8 : bx; }
    { volatile LAS unsigned* st = (volatile LAS unsigned*)(F.lds + XTRA_OFF + 8192); if (F.tid < 2) st[F.tid] = 0u; }
    __syncthreads();
    const XcdBarrier gbar = xcd_barrier_post((unsigned*)(PWS() + WS_CTL) + CW_BAR, (volatile LAS unsigned*)(F.lds + XTRA_OFF + 8192));
#define GRID_SYNC() xcd_barrier(gbar)

    if (PM & 1) p0_prologue(F, P);
    GRID_SYNC();
#if PROBE == 7
    p0_prologue(F, P);
    GRID_SYNC();
#endif

#if PROBE == 11
    {
        unsigned char* ws = PWS(); bf16_t* gates = (bf16_t*)POUT();
        pg8::Gemm g{(const bf16_t*)(ws + WS_XB), (const bf16_t*)(ws + WS_WP), T, NPROJ, DM}; pg8::StaticOrder S; S.init(T, NPROJ, F.G, (int)blockIdx.x);
        pg8::EpiProjStoreOnly E{ws, gates, (const float*)(ws + WS_RSTD1)};
        pg8::gemm_phase<pg8::EpiProjStoreOnly, pg8::StaticOrder, true, false>(F.lds, g, S, E);
    }
    GRID_SYNC();
#endif
    if (PM & 2) {
        unsigned char* ws = PWS(); bf16_t* gates = (bf16_t*)POUT();
        pg8::Gemm g{(const bf16_t*)(ws + WS_XB), (const bf16_t*)(ws + WS_WP), T, NPROJ, DM}; pg8::StaticOrder S; S.init(T, NPROJ, F.G, (int)blockIdx.x);
        pg8::EpiProj E{ws, gates, (const float*)(ws + WS_RSTD1), PIN(6), (const float*)(ws + WS_COS), (const float*)(ws + WS_SIN)};
#ifdef STAGGER_US
        if ((int)blockIdx.x >= 128) { const unsigned long long t0 = __builtin_amdgcn_s_memrealtime(); while (__builtin_amdgcn_s_memrealtime() - t0 < (unsigned long long)(STAGGER_US * 100)) __builtin_amdgcn_s_sleep(32); }
#endif
        pg8::gemm_phase<pg8::EpiProj, pg8::StaticOrder, P1_ALIGN, false>(F.lds, g, S, E);
    }
#if PROBE == 3
    GRID_SYNC();
    if (PM & 2) {
        unsigned char* ws = PWS(); bf16_t* gates = (bf16_t*)POUT();
        pg8::Gemm g{(const bf16_t*)(ws + WS_XB), (const bf16_t*)(ws + WS_WP), T, NPROJ, DM}; pg8::StaticOrder S; S.init(T, NPROJ, F.G, (int)blockIdx.x);
        pg8::EpiProj E{ws, gates, (const float*)(ws + WS_RSTD1), PIN(6), (const float*)(ws + WS_COS), (const float*)(ws + WS_SIN)};
        pg8::gemm_phase<pg8::EpiProj, pg8::StaticOrder, true, false>(F.lds, g, S, E);
    }
#endif
#if PROBE == 9
    GRID_SYNC();
    {
        unsigned char* ws = PWS();
        pg8::Gemm g{(const bf16_t*)(ws + WS_XB), (const bf16_t*)(ws + WS_WP), T, NPROJ, DM}; pg8::StaticOrder S; S.init(T, NPROJ, F.G, (int)blockIdx.x);
        pg8::EpiNull E{(float*)(ws + WS_RSTD1)};
        pg8::gemm_phase<pg8::EpiNull, pg8::StaticOrder, true, false>(F.lds, g, S, E);
    }
#endif
#if PROBE == 10
    GRID_SYNC();
    {
        unsigned char* ws = PWS();
        pg8::Gemm g{(const bf16_t*)(ws + WS_XB), (const bf16_t*)(ws + WS_WAB), 2 * T, 2048, 512}; pg8::BranchOrder S; S.so.init(T, DM, F.G, (int)blockIdx.x);
        pg8::EpiNull E{(float*)(ws + WS_RSTD1)};
        pg8::gemm_phase<pg8::EpiNull, pg8::BranchOrder, true, false>(F.lds, g, S, E);
    }
#endif
    if (PM & 4) {
        unsigned char* ws = PWS(); unsigned* ctl = (unsigned*)(ws + WS_CTL);
        pg8::Gemm g{(const bf16_t*)(ws + WS_PB), (const bf16_t*)(ws + WS_WPLE), T, DM, PLE}; pg8::PleOrder S; S.so.init(T, DM, F.G, (int)blockIdx.x); S.G = F.G; S.c = (int)blockIdx.x;
        pg8::EpiPle E{(bf16_t*)(ws + WS_ER), (float*)(ctl + CW_SSE)};
        pg8::gemm_phase<pg8::EpiPle, pg8::PleOrder, true, false>(F.lds, g, S, E);
    }
    GRID_SYNC();

    if (PM & 8) {
        unsigned char* ws = PWS(); unsigned* ctl = (unsigned*)(ws + WS_CTL);
        float lam;
        { float d1 = 0.f, d2 = 0.f; for (int i = 0; i < 64; ++i) { d1 += PIN(8)[i] * PIN(9)[i]; d2 += PIN(10)[i] * PIN(11)[i]; } lam = expf(d1) - expf(d2) + LAMBDA_INIT; }
        LAS int* qslot = (LAS int*)(F.lds + XTRA_OFF + 4096);
        bf16_t* oab = (bf16_t*)(ws + WS_XB);
#define P2_LOOP(QW, FIRST, LAST) \
        for (;;) { \
            __syncthreads(); \
            if (F.tid == 0) qslot[0] = (FIRST) + (int)atomicAdd(ctl + CW_QUEUE + (QW), 1u); \
            __syncthreads(); \
            const int item = qslot[0]; \
            if (item >= (LAST)) break; \
            if (item < 64) { \
                gla::gla_item(item >> 2, item & 3, (const bf16_t*)(ws + WS_GQ), (const bf16_t*)(ws + WS_GK), (const bf16_t*)(ws + WS_GV), (const bf16_t*)(ws + WS_SR), \
                              (const float*)(ws + WS_LA), PIN(7), oab, F.lds); \
            } else { \
                const int j = item - 64, qb = 15 - (j >> 6), bh = j & 63, b = bh >> 2, h = bh & 3; \
                const size_t base = (size_t)b * SEQ * 512 + h * 128; \
                da::attn_unit((const bf16_t*)(ws + WS_DQ) + base, (const bf16_t*)(ws + WS_DK) + base, (const bf16_t*)(ws + WS_DV) + base, \
                              oab + (size_t)T * 512 + base, qb * 128, lam, PIN(12), (char*)lds_raw); \
            } \
        }
#if PROBE == 1
        P2_LOOP(1, 0, 64) GRID_SYNC();
#elif PROBE == 2
        P2_LOOP(1, 64, 64 + 1024) GRID_SYNC();
#endif
        P2_LOOP(0, 0, 64 + 1024)
    }
    GRID_SYNC();

#if PROBE == 12 || PROBE == 13 || PROBE == 14
    {
        unsigned char* ws = PWS(); bf16_t* gates = (bf16_t*)POUT();
        pg8::Gemm g{(const bf16_t*)(ws + WS_XB), (const bf16_t*)(ws + WS_WAB), 2 * T, 2048, 512}; pg8::BranchOrder S; S.so.init(T, DM, F.G, (int)blockIdx.x);
#if PROBE == 12
        typedef pg8::EpiBranchProbe<true, true> EP;
#elif PROBE == 13
        typedef pg8::EpiBranchProbe<false, true> EP;
#else
        typedef pg8::EpiBranchProbe<true, false> EP;
#endif
        EP E{gates, (bf16_t*)(ws + WS_DQ), (bf16_t*)(ws + WS_MG)};
        pg8::gemm_phase<EP, pg8::BranchOrder, true, false>(F.lds, g, S, E);
    }
    GRID_SYNC();
#endif
    if (PM & 16) {
        unsigned char* ws = PWS(); bf16_t* gates = (bf16_t*)POUT();
        pg8::Gemm g{(const bf16_t*)(ws + WS_XB), (const bf16_t*)(ws + WS_WAB), 2 * T, 2048, 512}; pg8::BranchOrder S; S.so.init(T, DM, F.G, (int)blockIdx.x);
        pg8::EpiBranch E{gates, (bf16_t*)(ws + WS_DQ), (bf16_t*)(ws + WS_MG)};
        pg8::gemm_phase<pg8::EpiBranch, pg8::BranchOrder, true, false>(F.lds, g, S, E);
    }
    GRID_SYNC();
#if PROBE == 4
    if (PM & 16) {
        unsigned char* ws = PWS(); bf16_t* gates = (bf16_t*)POUT();
        pg8::Gemm g{(const bf16_t*)(ws + WS_XB), (const bf16_t*)(ws + WS_WAB), 2 * T, 2048, 512}; pg8::BranchOrder S; S.so.init(T, DM, F.G, (int)blockIdx.x);
        pg8::EpiBranch E{gates, (bf16_t*)(ws + WS_DQ), (bf16_t*)(ws + WS_MG)};
        pg8::gemm_phase<pg8::EpiBranch, pg8::BranchOrder, true, false>(F.lds, g, S, E);
    }
    GRID_SYNC();
#endif

    if (PM & 32) {
        unsigned char* ws = PWS(); unsigned* ctl = (unsigned*)(ws + WS_CTL);
        pg8::Gemm g{(const bf16_t*)(ws + WS_MG), (const bf16_t*)(ws + WS_WO), T, DM, DM}; pg8::StaticOrder S; S.init(T, DM, F.G, (int)blockIdx.x);
        pg8::EpiOut E{PIN(0), (bf16_t*)(ws + WS_XB), (float*)(ctl + CW_SS2)};
        pg8::gemm_phase<pg8::EpiOut, pg8::StaticOrder, true, false>(F.lds, g, S, E);
    }
    GRID_SYNC();

    if (PM & 64) p4_router(F, P);
    GRID_SYNC();

    moe_tables(F, (const unsigned*)(PWS() + WS_CTL));
    if (PM & 128) {
        unsigned char* ws = PWS(); unsigned* ctl = (unsigned*)(ws + WS_CTL);
        pg8::MoeOrder<2> mo{(const LAS int*)(F.lds + XTRA_OFF), (const LAS int*)(F.lds + XTRA_OFF) + 64, (const int*)(ws + WS_LIST), (const float*)(ws + WS_LRS), F.G, (int)blockIdx.x};
        pg8::Gemm g{(const bf16_t*)(ws + WS_XB), (const bf16_t*)(ws + WS_WGU), T, NEXP * 512, DM};
        pg8::EpiUp E{mo, (bf16_t*)(ws + WS_HE)};
        pg8::gemm_phase<pg8::EpiUp, pg8::MoeOrder<2>, true, true>(F.lds, g, mo, E);
    }
    GRID_SYNC();
#if PROBE == 5
    if (PM & 128) {
        unsigned char* ws = PWS(); unsigned* ctl = (unsigned*)(ws + WS_CTL);
        pg8::MoeOrder<2> mo{(const LAS int*)(F.lds + XTRA_OFF), (const LAS int*)(F.lds + XTRA_OFF) + 64, (const int*)(ws + WS_LIST), (const float*)(ws + WS_LRS), F.G, (int)blockIdx.x};
        pg8::Gemm g{(const bf16_t*)(ws + WS_XB), (const bf16_t*)(ws + WS_WGU), T, NEXP * 512, DM};
        pg8::EpiUp E{mo, (bf16_t*)(ws + WS_HE)};
        pg8::gemm_phase<pg8::EpiUp, pg8::MoeOrder<2>, true, true>(F.lds, g, mo, E);
    }
    GRID_SYNC();
#endif
    if (PM & 256) {
        unsigned char* ws = PWS();
        pg8::MoeOrder<4> mo{(const LAS int*)(F.lds + XTRA_OFF), (const LAS int*)(F.lds + XTRA_OFF) + 64, (const int*)(ws + WS_LIST), (const float*)(ws + WS_LW), F.G, (int)blockIdx.x};
        pg8::Gemm g{(const bf16_t*)(ws + WS_HE), (const bf16_t*)(ws + WS_WD), MOE_ROWS, NEXP * 1024, DEXP};
        pg8::EpiDown E{mo, (bf16_t*)(ws + WS_YB)};
        pg8::gemm_phase<pg8::EpiDown, pg8::MoeOrder<4>, true, false>(F.lds, g, mo, E);
    }
    GRID_SYNC();
#if PROBE == 6
    if (PM & 256) {
        unsigned char* ws = PWS();
        pg8::MoeOrder<4> mo{(const LAS int*)(F.lds + XTRA_OFF), (const LAS int*)(F.lds + XTRA_OFF) + 64, (const int*)(ws + WS_LIST), (const float*)(ws + WS_LW), F.G, (int)blockIdx.x};
        pg8::Gemm g{(const bf16_t*)(ws + WS_HE), (const bf16_t*)(ws + WS_WD), MOE_ROWS, NEXP * 1024, DEXP};
        pg8::EpiDown E{mo, (bf16_t*)(ws + WS_YB)};
        pg8::gemm_phase<pg8::EpiDown, pg8::MoeOrder<4>, true, false>(F.lds, g, mo, E);
    }
    GRID_SYNC();
#endif
    if (PM & 512) {
        unsigned char* ws = PWS();
        const bf16_t* hb = (const bf16_t*)(ws + WS_XB); const bf16_t* yb = (const bf16_t*)(ws + WS_YB); bf16_t* h2b = (bf16_t*)(ws + WS_H2B);
        const int gt = F.vcu * NTHREADS + F.tid, NGT = F.G * NTHREADS;
        for (int i = gt; i < T * DM / 8; i += NGT) { const int t = i >> 7, c = (i & 127) * 8;
            const v4u a = *(const v4u*)(hb + (size_t)t * DM + c), y0 = *(const v4u*)(yb + (size_t)(2 * t) * DM + c), y1 = *(const v4u*)(yb + (size_t)(2 * t + 1) * DM + c);
            v4u o; o.x = cvt_pk_bf16(bf_lo(a.x) + bf_lo(y0.x) + bf_lo(y1.x), bf_hi(a.x) + bf_hi(y0.x) + bf_hi(y1.x)); o.y = cvt_pk_bf16(bf_lo(a.y) + bf_lo(y0.y) + bf_lo(y1.y), bf_hi(a.y) + bf_hi(y0.y) + bf_hi(y1.y));
            o.z = cvt_pk_bf16(bf_lo(a.z) + bf_lo(y0.z) + bf_lo(y1.z), bf_hi(a.z) + bf_hi(y0.z) + bf_hi(y1.z)); o.w = cvt_pk_bf16(bf_lo(a.w) + bf_lo(y0.w) + bf_lo(y1.w), bf_hi(a.w) + bf_hi(y0.w) + bf_hi(y1.w));
            *(v4u*)(h2b + (size_t)t * DM + c) = o; }
    }
    GRID_SYNC();
#if PROBE == 8
    if (PM & 512) {
        unsigned char* ws = PWS();
        const bf16_t* hb = (const bf16_t*)(ws + WS_XB); const bf16_t* yb = (const bf16_t*)(ws + WS_YB); bf16_t* h2b = (bf16_t*)(ws + WS_H2B);
        const int gt = F.vcu * NTHREADS + F.tid, NGT = F.G * NTHREADS;
        for (int i = gt; i < T * DM / 8; i += NGT) { const int t = i >> 7, c = (i & 127) * 8;
            const v4u a = *(const v4u*)(hb + (size_t)t * DM + c), y0 = *(const v4u*)(yb + (size_t)(2 * t) * DM + c), y1 = *(const v4u*)(yb + (size_t)(2 * t + 1) * DM + c);
            v4u o; o.x = cvt_pk_bf16(bf_lo(a.x) + bf_lo(y0.x) + bf_lo(y1.x), bf_hi(a.x) + bf_hi(y0.x) + bf_hi(y1.x)); o.y = cvt_pk_bf16(bf_lo(a.y) + bf_lo(y0.y) + bf_lo(y1.y), bf_hi(a.y) + bf_hi(y0.y) + bf_hi(y1.y));
            o.z = cvt_pk_bf16(bf_lo(a.z) + bf_lo(y0.z) + bf_lo(y1.z), bf_hi(a.z) + bf_hi(y0.z) + bf_hi(y1.z)); o.w = cvt_pk_bf16(bf_lo(a.w) + bf_lo(y0.w) + bf_lo(y1.w), bf_hi(a.w) + bf_hi(y0.w) + bf_hi(y1.w));
            *(v4u*)(h2b + (size_t)t * DM + c) = o; }
    }
    GRID_SYNC();
#endif
    if (PM & 1024) {
        unsigned char* ws = PWS(); unsigned* ctl = (unsigned*)(ws + WS_CTL);
        pg8::Gemm g{(const bf16_t*)(ws + WS_H2B), (const bf16_t*)(ws + WS_WPG), T, DM, DM}; pg8::StaticOrder S; S.init(T, DM, F.G, (int)blockIdx.x);
        pg8::EpiFinal E{(const bf16_t*)(ws + WS_H2B), (const bf16_t*)(ws + WS_ER), (const float*)(ctl + CW_SSE), PIN(25), (bf16_t*)(ws + WS_YB), (float*)(ctl + CW_SSF)};
        pg8::gemm_phase<pg8::EpiFinal, pg8::StaticOrder, true, false>(F.lds, g, S, E);
    }
    GRID_SYNC();
    if (PM & 2048) {
        unsigned char* ws = PWS(); unsigned* ctl = (unsigned*)(ws + WS_CTL);
        const float* ssf = (const float*)(ctl + CW_SSF); const float* gf = PIN(27); float* out = POUT();
        const int gt = F.vcu * NTHREADS + F.tid, NGT = F.G * NTHREADS;
        for (int i = gt; i < T * DM / 4; i += NGT) { const int t = i >> 8, c = (i & 255) * 4; const float rs = 1.0f / sqrtf(ssf[t] * (1.f / DM) + EPS);
            const v2u pv = *(const v2u*)((const bf16_t*)(ws + WS_YB) + (size_t)t * DM + c); const f32x4 g = *(const f32x4*)(gf + c); f32x4 v = {bf_lo(pv.x), bf_hi(pv.x), bf_lo(pv.y), bf_hi(pv.y)}; v = v * g * rs; *(f32x4*)(out + (size_t)t * DM + c) = v; }
    }
}

extern "C" void kernel_launch(void* const* d_in, const int* in_sizes, int n_in, void* d_out, int out_size, void* d_ws, size_t ws_size, hipStream_t stream) {
    static int grid = 0;
    if (grid == 0) {
        if (n_in != 28 || out_size != T * DM || ws_size < WS_END) { fprintf(stderr, "kernel_launch: unexpected shapes (n_in %d, out %d, ws %zu < %zu)\n", n_in, out_size, ws_size, (size_t)WS_END); grid = -1; return; }
        int dev = 0, cus = 0, per_cu = 0;
        hipGetDevice(&dev); hipDeviceGetAttribute(&cus, hipDeviceAttributeMultiprocessorCount, dev);
        if (hipFuncSetAttribute((const void*)fwd_megakernel, hipFuncAttributeMaxDynamicSharedMemorySize, LDS_BYTES) != hipSuccess) { fprintf(stderr, "kernel_launch: hipFuncSetAttribute failed\n"); grid = -1; return; }
        if (hipOccupancyMaxActiveBlocksPerMultiprocessor(&per_cu, (const void*)fwd_megakernel, NTHREADS, LDS_BYTES) != hipSuccess || per_cu < 1) { fprintf(stderr, "kernel_launch: occupancy query says %d blocks/CU\n", per_cu); grid = -1; return; }
        grid = cus;
        fprintf(stderr, "kernel_launch: cus %d per_cu %d grid %d ws %zu\n", cus, per_cu, grid, ws_size);
    }
    if (grid < 0) return;
    hipMemsetAsync((char*)d_ws + WS_CTL, 0, CTL_ZERO_BYTES, stream);
    Params p{};
    for (int i = 0; i < 28; ++i) p.p[i] = d_in[i];
    p.p[28] = d_out; p.p[29] = d_ws;
    void* args[] = {&p};
    hipError_t e = hipLaunchCooperativeKernel((const void*)fwd_megakernel, dim3(grid), dim3(NTHREADS), args, LDS_BYTES, stream);
    if (e != hipSuccess) fprintf(stderr, "cooperative launch failed: %s (grid %d)\n", hipGetErrorString(e), grid);
}
```

```cpp
#include <hip/hip_runtime.h>
#include <hip/hip_cooperative_groups.h>
#include <hip/hip_bf16.h>
#include <cstdio>
#include <cstdint>
#include <cmath>
namespace cg = cooperative_groups;

constexpr int NB = 16, SEQ = 2048, DM = 1024, T = NB * SEQ, DIN = 5136, NPROJ = 5376, PLE = 256;
constexpr int NEXP = 32, DEXP = 256;
constexpr float EPS = 1e-6f;
constexpr float LOG2E = 1.4426950408889634f;
constexpr float QSCALE2 = 0.125f * LOG2E;
constexpr float LAMBDA_INIT = 0.2f;
constexpr int C_Q = 0, C_K = 256, C_V = 512, C_R = 1024, C_AL = 1536, C_DQ = 1552, C_DK = 2064, C_DV = 2576, C_GA = 3088, C_GB = 4112;
constexpr int P_Q = 0, P_K = 256, P_V = 512, P_R = 1024, P_AL = 1536, P_DQ = 1792, P_DK = 2304, P_DV = 2816, P_GA = 3328, P_GB = 4352;

constexpr size_t MiB = 1u << 20;
constexpr size_t WS_CTL = 0, CTL_ZERO_BYTES = 1 * MiB;
constexpr int CW_CNT = 64;
constexpr int CW_QUEUE = 128;
constexpr int CW_BAR = 4096;
constexpr int CW_SS2 = 65536;
constexpr int CW_SSE = 65536 + 32768;
constexpr int CW_SSF = 65536 + 65536;
static_assert((CW_SSF + 32768) * 4 <= (int)CTL_ZERO_BYTES, "ctl");
constexpr size_t WS_RSTD1 = 1 * MiB;
constexpr size_t WS_TOKE = 1 * MiB + 256 * 1024;
constexpr size_t WS_TOKW = 1 * MiB + 512 * 1024;
constexpr size_t WS_COS = 2 * MiB, WS_SIN = 3 * MiB;
constexpr size_t WS_LIST = 4 * MiB;
constexpr size_t WS_LRS = 138 * MiB + 16 * MiB - 8 * MiB;
constexpr size_t WS_LW = WS_LRS + 4 * MiB;
constexpr size_t WS_WP = 8 * MiB;
constexpr size_t WS_WGU = 19 * MiB;
constexpr size_t WS_WD = 51 * MiB;
constexpr size_t WS_WAB = 67 * MiB;
constexpr size_t WS_WO = 69 * MiB;
constexpr size_t WS_WPG = 71 * MiB;
constexpr size_t WS_WPLE = 73 * MiB;
constexpr size_t WS_WR = 73 * MiB + 512 * 1024;
constexpr size_t WS_XB = 74 * MiB;
constexpr size_t WS_PB = 138 * MiB;
constexpr size_t WS_ER = 154 * MiB;
constexpr size_t WS_GQ = 218 * MiB, WS_GK = 234 * MiB, WS_GV = 250 * MiB, WS_SR = 282 * MiB, WS_LA = 314 * MiB, WS_DQ = 346 * MiB, WS_DK = 378 * MiB, WS_DV = 410 * MiB;
constexpr size_t WS_MG = 218 * MiB;
constexpr size_t WS_H2B = 282 * MiB;
constexpr size_t WS_YB = 346 * MiB;
constexpr size_t WS_HE = 474 * MiB;
constexpr size_t WS_END = 512 * MiB;
constexpr int MOE_ROWS = 2 * T + NEXP * 256;
static_assert(WS_HE + (size_t)MOE_ROWS * DEXP * 2 <= WS_END, "ws");

constexpr int RING_BYTES = 131072;
constexpr int XTRA_OFF = RING_BYTES;
constexpr int LDS_BYTES = RING_BYTES + 20480;
constexpr int NTHREADS = 512;

#define GAS __attribute__((address_space(1)))
#define LAS __attribute__((address_space(3)))
typedef unsigned short bf16_t;
typedef unsigned v4u __attribute__((ext_vector_type(4)));
typedef unsigned v2u __attribute__((ext_vector_type(2)));
typedef float f32x4 __attribute__((ext_vector_type(4)));
typedef float f32x2 __attribute__((ext_vector_type(2)));
typedef float f32x16 __attribute__((ext_vector_type(16)));
typedef short bf16x8 __attribute__((ext_vector_type(8)));
typedef short s16x4 __attribute__((ext_vector_type(4)));

__device__ __forceinline__ unsigned cvt_pk_bf16(float lo, float hi) { unsigned r; asm volatile("v_cvt_pk_bf16_f32 %0, %1, %2" : "=v"(r) : "v"(lo), "v"(hi)); return r; }
__device__ __forceinline__ float bf_lo(unsigned w) { return __uint_as_float(w << 16); }
__device__ __forceinline__ float bf_hi(unsigned w) { return __uint_as_float(w & 0xffff0000u); }
__device__ __forceinline__ float sigmoidf_(float x) { return __builtin_amdgcn_rcpf(1.f + __builtin_amdgcn_exp2f(-x * LOG2E)); }
__device__ __forceinline__ float wave_sum(float v) {
#pragma unroll
    for (int o = 1; o < 64; o <<= 1) v += __shfl_xor(v, o);
    return v;
}

namespace pg8 {
constexpr int BM = 256, BK = 64, HALF = 128, HTB = HALF * BK * 2, STAGE_BYTES = 8 * HTB, NXCD = 8, WGM = 8;
__host__ __device__ __forceinline__ int lds_byte(int r, int c) { const int st = (r >> 4) * 2 + (c >> 5), rr = r & 15, cc = c & 31, ob = rr * 64 + cc * 2; return st * 1024 + (ob ^ (((ob >> 9) & 1) << 5)); }
__host__ __device__ __forceinline__ void stage_rc(int b, int& R, int& C) { const int st = b / 1024, sb = b % 1024, swz = sb ^ (((sb >> 9) & 1) << 5); R = (st >> 1) * 16 + swz / 64; C = (st & 1) * 32 + (swz % 64) / 2; }
__host__ __device__ __forceinline__ int perm32(int rho) { const int n = rho >> 4, i = rho & 15; return 8 * (i >> 2) + 4 * n + (i & 3); }
struct Unit { int pm, pn; };
struct Gemm { const bf16_t* A; const bf16_t* Bt; int M, N, K; };
struct StaticOrder {
    int nM, nN, nwg, G, c;
    __host__ __device__ void init(int M, int N, int G_, int c_) { nM = M / BM; nN = N / BM; nwg = nM * nN; G = G_; c = c_; }
    __host__ __device__ bool next(int i, Unit& u) const {
        const long L = (long)i * G + c; if (L >= nwg) return false;
        int wgid = (int)L; { const int q = nwg / NXCD, r = nwg % NXCD, xcd = wgid % NXCD, off = wgid / NXCD; wgid = (xcd < r ? xcd * (q + 1) : r * (q + 1) + (xcd - r) * q) + off; }
        const int nig = WGM * nN, gid = wgid / nig, fm = gid * WGM, gsz = (nM - fm) < WGM ? (nM - fm) : WGM;
        u.pm = fm + ((wgid % nig) % gsz); u.pn = (wgid % nig) / gsz; return true;
    }
    __device__ __forceinline__ unsigned arow(const Unit&, int) const { return 0u; }
};

template <class Epi, class Sched, bool ALIGN_EPI, bool GATHER>
__device__ __forceinline__ void gemm_phase(LAS unsigned char* lds, const Gemm g, const Sched& S, const Epi& E) {
    int tid = threadIdx.x; asm volatile("" : "+v"(tid));
    const int wid = __builtin_amdgcn_readfirstlane(tid >> 6), lane = tid & 63, wr = wid >> 2, wc = wid & 3, fr = lane & 15, fq = lane >> 4;
    const int K = g.K, nt = K / BK;
    unsigned voffB[2]; int RA[2], CA[2];
#pragma unroll
    for (int i = 0; i < 2; ++i) { int R, C; stage_rc(tid * 16 + i * 8192, R, C); const int Rb = Epi::PERM ? ((R & ~31) + perm32(R & 31)) : R;
        RA[i] = R; CA[i] = C; voffB[i] = (unsigned)(Rb * K + C) * 2u; }
    const size_t kstep = (size_t)(BK * 2);
    const size_t hstep = (size_t)HALF * K * 2;
    const size_t tstep = 2 * hstep;
    const unsigned ldsw = (unsigned)wid * 1024u;
    const int aoff = lds_byte(wr * 64 + fr, fq * 8), boff = lds_byte(wc * 32 + fr, fq * 8);
#define PG8_SA(b, h) (((b) * 2 + (h)) * HTB)
#define PG8_SB(b, h) ((4 + (b) * 2 + (h)) * HTB)
#define PG8_STAGE(bufoff, gbase, voff) do { _Pragma("unroll") for (int _i = 0; _i < 2; ++_i) \
        __builtin_amdgcn_global_load_lds((const unsigned*)((const char*)(gbase) + (voff)[_i]), (LAS unsigned*)(lds + (bufoff) + ldsw + _i * 8192), 16, 0, 0); } while (0)
#define PG8_STA(bufoff, gbase, v0, v1) do { \
        __builtin_amdgcn_global_load_lds((const unsigned*)((const char*)(gbase) + (v0)), (LAS unsigned*)(lds + (bufoff) + ldsw), 16, 0, 0); \
        __builtin_amdgcn_global_load_lds((const unsigned*)((const char*)(gbase) + (v1)), (LAS unsigned*)(lds + (bufoff) + ldsw + 8192), 16, 0, 0); } while (0)
#define PG8_LDA(dst, b, h) do { _Pragma("unroll") for (int m = 0; m < 4; ++m) _Pragma("unroll") for (int k = 0; k < 2; ++k) dst[m][k] = *(const LAS bf16x8*)(lds + PG8_SA(b, h) + aoff + m * 2048 + k * 1024); } while (0)
#define PG8_LDB(dst, b, h) do { _Pragma("unroll") for (int n = 0; n < 2; ++n) _Pragma("unroll") for (int k = 0; k < 2; ++k) dst[n][k] = *(const LAS bf16x8*)(lds + PG8_SB(b, h) + boff + n * 2048 + k * 1024); } while (0)
#define PG8_MMA(ai, bj, At, Bt) do { __builtin_amdgcn_s_setprio(1); _Pragma("unroll") for (int m = 0; m < 4; ++m) _Pragma("unroll") for (int n = 0; n < 2; ++n) _Pragma("unroll") for (int k = 0; k < 2; ++k) \
        acc[ai][bj][m][n] = __builtin_amdgcn_mfma_f32_16x16x32_bf16(Bt[n][k], At[m][k], acc[ai][bj][m][n], 0, 0, 0); __builtin_amdgcn_s_setprio(0); } while (0)
#define PG8_WAIT_V(n) asm volatile("s_waitcnt vmcnt(" #n ")" ::: "memory")
#define PG8_WAIT_L(n) asm volatile("s_waitcnt lgkmcnt(" #n ")" ::: "memory")
#define PG8_BAR __builtin_amdgcn_s_barrier()
#define PG8_SCHED __builtin_amdgcn_sched_barrier(0)
    Unit cur, nxt; int ui = 0;
    if (!S.next(0, cur)) return;
    f32x4 acc[2][2][4][2];
#pragma unroll
    for (int a = 0; a < 2; ++a)
#pragma unroll
        for (int b = 0; b < 2; ++b)
#pragma unroll
            for (int m = 0; m < 4; ++m)
#pragma unroll
                for (int n = 0; n < 2; ++n) acc[a][b][m][n] = (f32x4){0.f, 0.f, 0.f, 0.f};
    bf16x8 At[4][2], B0[2][2], B1[2][2];
    unsigned vA00, vA01, vA10, vA11, vN00, vN01, vN10, vN11;
#define PG8_AOFF(u, h, i) (GATHER ? (unsigned)(((size_t)S.arow(u, (h) * HALF + RA[i]) * (size_t)K + CA[i]) * 2u) : (unsigned)((h) * hstep + ((size_t)RA[i] * K + CA[i]) * 2u))
    vA00 = PG8_AOFF(cur, 0, 0); vA01 = PG8_AOFF(cur, 0, 1); vA10 = PG8_AOFF(cur, 1, 0); vA11 = PG8_AOFF(cur, 1, 1);
    vN00 = vA00; vN01 = vA01; vN10 = vA10; vN11 = vA11;
    const char* cA = (const char*)g.A + (GATHER ? (size_t)0 : (size_t)cur.pm * tstep); const char* cB = (const char*)g.Bt + (size_t)cur.pn * tstep;
    PG8_STAGE(PG8_SB(0, 0), cB, voffB); PG8_STAGE(PG8_SB(0, 1), cB + hstep, voffB); PG8_STA(PG8_SA(0, 0), cA, vA00, vA01); PG8_STA(PG8_SA(0, 1), cA, vA10, vA11);
    if (wr == 1) PG8_BAR;
    PG8_WAIT_V(2); PG8_BAR;
    PG8_STAGE(PG8_SB(1, 0), cB + kstep, voffB); PG8_STA(PG8_SA(1, 0), cA + kstep, vA00, vA01); PG8_STAGE(PG8_SB(1, 1), cB + hstep + kstep, voffB);
    PG8_WAIT_V(6); PG8_BAR;
#pragma unroll 1
    for (;;) {
        const bool has_next = S.next(ui + 1, nxt);
        const char* nA = has_next ? (const char*)g.A + (GATHER ? (size_t)0 : (size_t)nxt.pm * tstep) : cA; const char* nB = has_next ? (const char*)g.Bt + (size_t)nxt.pn * tstep : cB;
        if constexpr (GATHER) { if (has_next) { vN00 = PG8_AOFF(nxt, 0, 0); vN01 = PG8_AOFF(nxt, 0, 1); vN10 = PG8_AOFF(nxt, 1, 0); vN11 = PG8_AOFF(nxt, 1, 1); } else { vN00 = vA00; vN01 = vA01; vN10 = vA10; vN11 = vA11; } }
#pragma unroll 1
        for (int t = 0; t < nt; t += 2) {
            const bool last = (t == nt - 2);
            const char* a1 = cA + (size_t)(t + 1) * kstep;
            const char* a2 = last ? nA : cA + (size_t)(t + 2) * kstep; const char* b2 = last ? nB : cB + (size_t)(t + 2) * kstep;
            const char* a3 = a2 + kstep; const char* b3 = b2 + kstep;
            unsigned w00 = vA00, w01 = vA01, w10 = vA10, w11 = vA11;
            if constexpr (GATHER) { if (last) { w00 = vN00; w01 = vN01; w10 = vN10; w11 = vN11; } }
            PG8_LDB(B0, 0, 0); PG8_LDB(B1, 0, 1); PG8_SCHED; PG8_LDA(At, 0, 0); PG8_STA(PG8_SA(1, 1), a1, vA10, vA11);
            PG8_WAIT_V(8); PG8_WAIT_L(0); PG8_BAR; PG8_MMA(0, 0, At, B0); PG8_MMA(0, 1, At, B1); PG8_BAR; PG8_SCHED;
            PG8_LDA(At, 0, 1); PG8_STAGE(PG8_SB(0, 0), b2, voffB); PG8_STAGE(PG8_SB(0, 1), b2 + hstep, voffB); PG8_STA(PG8_SA(0, 0), a2, w00, w01);
            PG8_WAIT_V(8); PG8_WAIT_L(0); PG8_BAR; PG8_MMA(1, 0, At, B0); PG8_MMA(1, 1, At, B1); PG8_BAR; PG8_SCHED;
            PG8_LDB(B0, 1, 0); PG8_LDB(B1, 1, 1); PG8_SCHED; PG8_LDA(At, 1, 0); PG8_STA(PG8_SA(0, 1), a2, w10, w11);
            PG8_WAIT_V(8); PG8_WAIT_L(0); PG8_BAR; PG8_MMA(0, 0, At, B0); PG8_MMA(0, 1, At, B1); PG8_BAR; PG8_SCHED;
            PG8_LDA(At, 1, 1); PG8_STAGE(PG8_SB(1, 0), b3, voffB); PG8_STAGE(PG8_SB(1, 1), b3 + hstep, voffB); PG8_STA(PG8_SA(1, 0), a3, w00, w01);
            PG8_WAIT_V(8); PG8_WAIT_L(0); PG8_BAR; PG8_MMA(1, 0, At, B0); PG8_MMA(1, 1, At, B1); PG8_BAR; PG8_SCHED;
        }
        if constexpr (ALIGN_EPI) { if (wr == 0) PG8_BAR; }
        E(acc, cur, wr, wc, fr, fq);
        if (!has_next) break;
#pragma unroll
        for (int a = 0; a < 2; ++a)
#pragma unroll
            for (int b = 0; b < 2; ++b)
#pragma unroll
                for (int m = 0; m < 4; ++m)
#pragma unroll
                    for (int n = 0; n < 2; ++n) acc[a][b][m][n] = (f32x4){0.f, 0.f, 0.f, 0.f};
        cur = nxt; cA = nA; cB = nB; ++ui;
        vA00 = vN00; vA01 = vN01; vA10 = vN10; vA11 = vN11;
        if constexpr (ALIGN_EPI) { if (wr == 1) PG8_BAR; }
    }
    PG8_WAIT_V(0);
    if constexpr (!ALIGN_EPI) { if (wr == 0) PG8_BAR; }
    PG8_BAR;
#undef PG8_AOFF
#undef PG8_SA
#undef PG8_SB
#undef PG8_STAGE
#undef PG8_STA
#undef PG8_LDA
#undef PG8_LDB
#undef PG8_MMA
#undef PG8_WAIT_V
#undef PG8_WAIT_L
#undef PG8_BAR
#undef PG8_SCHED
}
}

struct Params { const void* p[30]; };
__device__ __forceinline__ const void* parg(const Params& P, int i) { asm volatile("" : "+s"(i)); return P.p[i]; }
#define PIN(i) ((const float*)parg(P, (i)))
#define POUT() ((float*)parg(P, 28))
#define PWS() ((unsigned char*)parg(P, 29))
struct Frame {
    LAS unsigned char* lds;
    int tid, lane, wave, vcu, G;
};

#define XB_TMO      128
#define XB_XCNT(j)  (256  + 64 * (j))
#define XB_XSUB(j)  (1280 + 64 * (j))
#define XB_XGEN(j)  (2304 + 64 * (j))
#define XB_TOP      3328
#define XB_TOPGEN   3392
#define XCD_BAR_WORDS 3456
#define XB_SPIN_CAP (1u << 20)
__device__ __forceinline__ unsigned xb_ld(unsigned* p)              { return __hip_atomic_load(p, __ATOMIC_RELAXED, __HIP_MEMORY_SCOPE_AGENT); }
__device__ __forceinline__ unsigned xb_add(unsigned* p, unsigned v) { return __hip_atomic_fetch_add(p, v, __ATOMIC_RELAXED, __HIP_MEMORY_SCOPE_AGENT); }
__device__ __forceinline__ unsigned xb_xcc_id() { return (unsigned)__builtin_amdgcn_s_getreg((3 << 11) | 20) & 0xFu; }
#define XB_SPIN(cond, bar) do { unsigned _sp = 0; while (cond) { __builtin_amdgcn_s_sleep(1); \
    if ((++_sp & 255u) == 0u) { if (xb_ld(&(bar)[XB_TMO])) break; if (_sp > XB_SPIN_CAP) { atomicAdd(&(bar)[XB_TMO], 1u); break; } } } } while (0)
struct XcdBarrier { unsigned* bar; unsigned x; volatile LAS unsigned* st; };
__device__ __forceinline__ XcdBarrier xcd_barrier_post(unsigned* bar, volatile LAS unsigned* st) {
    XcdBarrier b; b.bar = bar; b.x = xb_xcc_id(); b.st = st;
    if (threadIdx.x == 0) (void)xb_add(&bar[XB_XCNT(b.x)], 1u);
    return b;
}
__device__ __forceinline__ void xcd_barrier_complete(unsigned* bar, unsigned x, unsigned& nloc, unsigned& nx) {
    const unsigned G = gridDim.x * gridDim.y * gridDim.z;
    unsigned sum, cnt, mine, sp = 0u;
    for (;;) {
        sum = 0u; cnt = 0u; mine = 0u;
#pragma unroll
        for (unsigned j = 0; j < 16; ++j) { const unsigned c = xb_ld(&bar[XB_XCNT(j)]); sum += c; cnt += (c > 0u) ? 1u : 0u; mine = (j == x) ? c : mine; }
        if (sum == G) break;
        __builtin_amdgcn_s_sleep(1);
        if ((++sp & 255u) == 0u) { if (xb_ld(&bar[XB_TMO])) break; if (sp > XB_SPIN_CAP) { atomicAdd(&bar[XB_TMO], 1u); break; } }
    }
    nloc = mine > 0u ? mine : 1u; nx = cnt > 0u ? cnt : 1u;
}
__device__ __forceinline__ void xcd_barrier(const XcdBarrier& b) {
    asm volatile("s_waitcnt vmcnt(0)" ::: "memory");
    __syncthreads();
    if (threadIdx.x == 0) {
        unsigned* bar = b.bar;
        __builtin_amdgcn_s_waitcnt(0);
        unsigned nloc = b.st[0], nx = b.st[1];
        if (nloc == 0u) { xcd_barrier_complete(bar, b.x, nloc, nx); b.st[0] = nloc; b.st[1] = nx; }
        const unsigned old = xb_add(&bar[XB_XSUB(b.x)], 1u);
        const unsigned gen = old / nloc;
        if (old + 1u == (gen + 1u) * nloc) {
            __builtin_amdgcn_fence(__ATOMIC_RELEASE, "agent");
            asm volatile("s_waitcnt vmcnt(0)" ::: "memory");
            const unsigned og = xb_add(&bar[XB_TOP], 1u);
            const unsigned tg = og / nx;
            if (og + 1u == (tg + 1u) * nx) xb_add(&bar[XB_TOPGEN], 1u);
            else XB_SPIN(xb_ld(&bar[XB_TOPGEN]) == tg, bar);
            __builtin_amdgcn_fence(__ATOMIC_ACQUIRE, "agent");
            xb_add(&bar[XB_XGEN(b.x)], 1u);
            asm volatile("s_waitcnt vmcnt(0)" ::: "memory");
        } else {
            XB_SPIN(xb_ld(&bar[XB_XGEN(b.x)]) == gen, bar);
            __builtin_amdgcn_fence(__ATOMIC_ACQUIRE, "agent");
            asm volatile("s_waitcnt vmcnt(0)" ::: "memory");
        }
    }
    __syncthreads();
}

struct TrJob { const float* W; int ld, k0; const float* gain; float scale; bf16_t* dst; int K; };
__device__ __forceinline__ void tr_load(const TrJob& j, float (&v)[32], int lane) {
#pragma unroll
    for (int i = 0; i < 32; ++i) { const int kk = 2 * i + (lane >> 5); v[i] = j.W[(size_t)(j.k0 + kk) * j.ld + (lane & 31)]; }
}
__device__ __forceinline__ void tr_finish(const TrJob& j, const float (&v)[32], LAS float* scr, int lane) {
#pragma unroll
    for (int i = 0; i < 32; ++i) { const int kk = 2 * i + (lane >> 5); float x = v[i]; if (j.gain) x *= j.gain[j.k0 + kk]; scr[kk * 33 + (lane & 31)] = x * j.scale; }
    asm volatile("s_waitcnt lgkmcnt(0)" ::: "memory");
    const int c = lane & 7;
#pragma unroll
    for (int jj = 0; jj < 4; ++jj) { const int n = (lane >> 3) + 8 * jj; const LAS float* s = scr + (8 * c) * 33 + n;
        v4u o; o.x = cvt_pk_bf16(s[0 * 33], s[1 * 33]); o.y = cvt_pk_bf16(s[2 * 33], s[3 * 33]); o.z = cvt_pk_bf16(s[4 * 33], s[5 * 33]); o.w = cvt_pk_bf16(s[6 * 33], s[7 * 33]);
        *(v4u*)(j.dst + (size_t)n * j.K + j.k0 + 8 * c) = o; }
    asm volatile("s_waitcnt lgkmcnt(0)" ::: "memory");
}

__device__ __forceinline__ void p0_prologue(const Frame& F, const Params& P) {
    unsigned char* ws = PWS();
    const float* x = PIN(0); const float* p = PIN(1); const int* pos = (const int*)PIN(2);
    const float* attn_norm = PIN(3); const float* w_in = PIN(4); const float* w_a2 = PIN(5);
    const float* w_ba = PIN(13); const float* w_bb = PIN(14); const float* w_out = PIN(15); const float* ffn_norm = PIN(16);
    const float* w_rg = PIN(17); const float* w_re = PIN(19);
    const float* w_gate = PIN(21); const float* w_up = PIN(22); const float* w_down = PIN(23); const float* w_ple = PIN(24); const float* w_pg = PIN(26);
    bf16_t* Wp = (bf16_t*)(ws + WS_WP); bf16_t* Wgu = (bf16_t*)(ws + WS_WGU); bf16_t* Wd = (bf16_t*)(ws + WS_WD); bf16_t* Wab = (bf16_t*)(ws + WS_WAB);
    bf16_t* Wo = (bf16_t*)(ws + WS_WO); bf16_t* Wpg = (bf16_t*)(ws + WS_WPG); bf16_t* Wple = (bf16_t*)(ws + WS_WPLE); bf16_t* Wr = (bf16_t*)(ws + WS_WR);
    LAS float* scr = (LAS float*)(F.lds + F.wave * 16384);
    const int gw = F.vcu * 8 + F.wave, NGW = F.G * 8, lane = F.lane;
    constexpr int I0 = 16 * 48, I1 = 16 * 112, I2 = 8 * 32, I3 = 8 * 32, I4 = 16 * 32, I5 = 16 * 32, I6 = 4 * 32, I7 = 32 * 16 * 8, I8 = I7, I9 = 32 * 4 * 32;
    constexpr int NITEMS = I0 + I1 + I2 + I3 + I4 + I5 + I6 + I7 + I8 + I9;
    auto decode = [&](int it) -> TrJob {
        int r = it; TrJob j;
        if (r < I0) { const int kb = r / 48, nb = r % 48; j = TrJob{w_in + nb * 32, DIN, kb * 64, attn_norm, nb < 8 ? 0.125f : 1.f, Wp + (size_t)(nb * 32) * DM, DM}; return j; } r -= I0;
        if (r < I1) { const int kb = r / 112, nb = r % 112; j = TrJob{w_in + C_DQ + nb * 32, DIN, kb * 64, attn_norm, nb < 16 ? QSCALE2 : 1.f, Wp + (size_t)(P_DQ + nb * 32) * DM, DM}; return j; } r -= I1;
        if (r < I2) { const int kb = r / 32, nb = r % 32; j = TrJob{w_ba + nb * 32, DM, kb * 64, nullptr, 1.f, Wab + (size_t)(nb * 32) * 512, 512}; return j; } r -= I2;
        if (r < I3) { const int kb = r / 32, nb = r % 32; j = TrJob{w_bb + nb * 32, DM, kb * 64, nullptr, 1.f, Wab + (size_t)(1024 + nb * 32) * 512, 512}; return j; } r -= I3;
        if (r < I4) { const int kb = r / 32, nb = r % 32; j = TrJob{w_out + nb * 32, DM, kb * 64, nullptr, 1.f, Wo + (size_t)(nb * 32) * DM, DM}; return j; } r -= I4;
        if (r < I5) { const int kb = r / 32, nb = r % 32; j = TrJob{w_pg + nb * 32, DM, kb * 64, nullptr, 1.f, Wpg + (size_t)(nb * 32) * DM, DM}; return j; } r -= I5;
        if (r < I6) { const int kb = r / 32, nb = r % 32; j = TrJob{w_ple + nb * 32, DM, kb * 64, nullptr, 1.f, Wple + (size_t)(nb * 32) * PLE, PLE}; return j; } r -= I6;
        if (r < I7 + I8) { const int up = r >= I7; if (up) r -= I7; const int e = r / 128, q = r % 128, kb = q / 8, nb = q % 8;
            j = TrJob{(up ? w_up : w_gate) + (size_t)e * DM * DEXP + nb * 32, DEXP, kb * 64, ffn_norm, 1.f, Wgu + (size_t)(e * 512 + (nb >> 2) * 256 + up * 128 + (nb & 3) * 32) * DM, DM}; return j; } r -= I7 + I8;
        { const int e = r / 128, q = r % 128, kb = q / 32, nb = q % 32;
          j = TrJob{w_down + (size_t)e * DEXP * DM + nb * 32, DM, kb * 64, nullptr, 1.f, Wd + (size_t)(e * 1024 + nb * 32) * DEXP, DEXP}; return j; }
    };
    {
        float va[32], vb[32];
        int it = gw;
        if (it < NITEMS) { TrJob ja = decode(it); tr_load(ja, va, lane);
            for (;;) {
                const int itb = it + NGW; TrJob jb = ja;
                if (itb < NITEMS) { jb = decode(itb); tr_load(jb, vb, lane); }
                tr_finish(ja, va, scr, lane);
                if (itb >= NITEMS) break;
                const int itc = itb + NGW;
                if (itc < NITEMS) { ja = decode(itc); tr_load(ja, va, lane); }
                tr_finish(jb, vb, scr, lane);
                if (itc >= NITEMS) break;
                it = itc;
            }
        }
    }
    for (int it = gw; it < 16 * 8; it += NGW) { const int kb = it / 8, jb = it % 8, k = kb * 64 + lane;
        float wv[16];
#pragma unroll
        for (int r = 0; r < 16; ++r) wv[r] = w_in[(size_t)k * DIN + C_AL + r];
        const float g = attn_norm[k];
        for (int jj = 0; jj < 32; ++jj) { const int j = jb * 32 + jj; float s = 0.f;
#pragma unroll
            for (int r = 0; r < 16; ++r) s += wv[r] * w_a2[r * 256 + j];
            Wp[(size_t)(P_AL + j) * DM + k] = (bf16_t)(cvt_pk_bf16(s * g, 0.f) & 0xffffu); } }
    const int gt = F.vcu * NTHREADS + F.tid, NGT = F.G * NTHREADS;
    for (int i = gt; i < 48 * DM; i += NGT) { const int n = i >> 10, k = i & 1023; float v = 0.f;
        if (n < 4) v = w_rg[k * 4 + n] * ffn_norm[k]; else if (n < 36) v = w_re[k * 32 + (n - 4)] * ffn_norm[k];
        Wr[i] = (bf16_t)(cvt_pk_bf16(v, 0.f) & 0xffffu); }
    { bf16_t* xb = (bf16_t*)(ws + WS_XB); float* rstd1 = (float*)(ws + WS_RSTD1);
      for (int m0 = gw * 4; m0 < T; m0 += NGW * 4) { f32x4 v[4][4];
#pragma unroll
          for (int r = 0; r < 4; ++r) { const GAS f32x4* xr = (const GAS f32x4*)(x + (size_t)(m0 + r) * DM) + lane;
#pragma unroll
              for (int j = 0; j < 4; ++j) v[r][j] = xr[64 * j]; }
#pragma unroll
          for (int r = 0; r < 4; ++r) { float s = 0.f;
#pragma unroll
              for (int j = 0; j < 4; ++j) s += (v[r][j].x * v[r][j].x + v[r][j].y * v[r][j].y) + (v[r][j].z * v[r][j].z + v[r][j].w * v[r][j].w);
              s = wave_sum(s);
              GAS v2u* o8 = (GAS v2u*)(xb + (size_t)(m0 + r) * DM) + lane;
#pragma unroll
              for (int j = 0; j < 4; ++j) { v2u o; o.x = cvt_pk_bf16(v[r][j].x, v[r][j].y); o.y = cvt_pk_bf16(v[r][j].z, v[r][j].w); o8[64 * j] = o; }
              if (lane == 0) rstd1[m0 + r] = 1.0f / sqrtf(s * (1.f / DM) + EPS); } } }
    { bf16_t* pb = (bf16_t*)(ws + WS_PB);
      for (int i0 = gt; i0 < T * PLE / 8; i0 += NGT * 4) { f32x4 a[4], b[4];
#pragma unroll
          for (int u = 0; u < 4; ++u) { const int i = i0 + u * NGT; if (i < T * PLE / 8) { a[u] = *(const f32x4*)(p + (size_t)i * 8); b[u] = *(const f32x4*)(p + (size_t)i * 8 + 4); } }
#pragma unroll
          for (int u = 0; u < 4; ++u) { const int i = i0 + u * NGT; if (i < T * PLE / 8) { v4u o; o.x = cvt_pk_bf16(a[u].x, a[u].y); o.y = cvt_pk_bf16(a[u].z, a[u].w); o.z = cvt_pk_bf16(b[u].x, b[u].y); o.w = cvt_pk_bf16(b[u].z, b[u].w); *(v4u*)(pb + (size_t)i * 8) = o; } } } }
    { float* ct = (float*)(ws + WS_COS); float* st = (float*)(ws + WS_SIN);
      for (int i = gt; i < T * 8; i += NGT) { const int t = i >> 3, j = i & 7; const double ang = (double)pos[t] * exp2(-(double)j * (18.931568569324174 / 8.0));
          ct[i] = (float)cos(ang); st[i] = (float)sin(ang); } }
}

#ifdef USE_NT
#define NT_STORE(v, p) __builtin_nontemporal_store((v), (p))
#else
#define NT_STORE(v, p) (*(p) = (v))
#endif
namespace pg8 {
__device__ __forceinline__ size_t tp_off(int tile, int slot, int tid) { return ((size_t)tile * 16 + slot) * 8192 + (size_t)tid * 16; }
struct EpiProj {
    static constexpr bool PERM = true;
    unsigned char* ws; bf16_t* gates; const float* rstd; const float* b_a; const float* cost; const float* sint;
    __device__ __forceinline__ void operator()(const f32x4 (&acc)[2][2][4][2], const Unit& u, int wr, int wc, int fr, int fq) const {
        const int pn = u.pn, row0 = u.pm * BM + wr * 64 + fr, cl0 = wc * 32 + 8 * fq;
        int mode = 0, pitch = 512, cb = 0; unsigned char* dst = nullptr;
        if (pn == 0) { dst = ws + WS_GQ; pitch = 256; }
        else if (pn == 1) { dst = ws + WS_GK; pitch = 256; }
        else if (pn < 4) { dst = ws + WS_GV; cb = (pn - 2) * 256; }
        else if (pn < 6) { dst = ws + WS_SR; cb = (pn - 4) * 256; mode = 1; }
        else if (pn == 6) { dst = ws + WS_LA; pitch = 256; mode = 2; }
        else if (pn < 9) { dst = ws + WS_DQ; cb = (pn - 7) * 256; mode = 3; }
        else if (pn < 11) { dst = ws + WS_DK; cb = (pn - 9) * 256; mode = 3; }
        else if (pn < 13) { dst = ws + WS_DV; cb = (pn - 11) * 256; }
        else { dst = (unsigned char*)gates; pitch = 2048; cb = (pn - 13) * 256; mode = 4; }
#pragma unroll
        for (int ai = 0; ai < 2; ++ai)
#pragma unroll
            for (int m = 0; m < 4; ++m) {
                const int row = row0 + ai * HALF + m * 16; const float rs = rstd[row];
                f32x4 cs0, cs1, sn0, sn1;
                if (mode == 3) { cs0 = *(const f32x4*)(cost + (size_t)row * 8); cs1 = *(const f32x4*)(cost + (size_t)row * 8 + 4); sn0 = *(const f32x4*)(sint + (size_t)row * 8); sn1 = *(const f32x4*)(sint + (size_t)row * 8 + 4); }
#pragma unroll
                for (int bj = 0; bj < 2; ++bj) {
                    f32x4 v0 = acc[ai][bj][m][0] * rs, v1 = acc[ai][bj][m][1] * rs;
                    const int col = cb + bj * HALF + cl0;
                    if (mode == 2) {
                        const f32x4 b0 = *(const f32x4*)(b_a + col), b1 = *(const f32x4*)(b_a + col + 4);
                        v0 = v0 + b0; v1 = v1 + b1;
#pragma unroll
                        for (int i = 0; i < 4; ++i) { float xx = v0[i]; v0[i] = (fminf(xx, 0.f) - __builtin_amdgcn_logf(1.f + __builtin_amdgcn_exp2f(-fabsf(xx) * LOG2E)) * 0.6931471805599453f) * 0.0625f;
                                                      xx = v1[i]; v1[i] = (fminf(xx, 0.f) - __builtin_amdgcn_logf(1.f + __builtin_amdgcn_exp2f(-fabsf(xx) * LOG2E)) * 0.6931471805599453f) * 0.0625f; }
                        float* o = (float*)dst + (size_t)row * pitch + col; *(f32x4*)o = v0; *(f32x4*)(o + 4) = v1;
                        continue;
                    }
                    if (mode == 1) {
#pragma unroll
                        for (int i = 0; i < 4; ++i) { v0[i] = v0[i] * sigmoidf_(v0[i]); v1[i] = v1[i] * sigmoidf_(v1[i]); }
                    } else if (mode == 4) {
#pragma unroll
                        for (int i = 0; i < 4; ++i) { v0[i] = sigmoidf_(v0[i]); v1[i] = sigmoidf_(v1[i]); }
                    } else if (mode == 3) {
                        if ((wc & 1) == 0) {
                            f32x4 p0, p1;
#pragma unroll
                            for (int i = 0; i < 4; ++i) { p0[i] = __shfl_xor(v0[i], 16); p1[i] = __shfl_xor(v1[i], 16); }
                            if (fq == 0) { v0 = v0 * cs0 - p0 * sn0; v1 = v1 * cs1 - p1 * sn1; }
                            else if (fq == 1) { v0 = v0 * cs0 + p0 * sn0; v1 = v1 * cs1 + p1 * sn1; }
                        }
                    }
                    v4u w; w.x = cvt_pk_bf16(v0[0], v0[1]); w.y = cvt_pk_bf16(v0[2], v0[3]); w.z = cvt_pk_bf16(v1[0], v1[1]); w.w = cvt_pk_bf16(v1[2], v1[3]);
                    if (mode == 4) { const int pg = pn - 13; NT_STORE(w, (v4u*)((unsigned char*)gates + tp_off((pg >> 2) * 512 + u.pm * 4 + (pg & 3), (ai * 4 + m) * 2 + bj, (wr * 4 + wc) * 64 + fq * 16 + fr))); }
                    else NT_STORE(w, (v4u*)((bf16_t*)dst + (size_t)row * pitch + col));
                }
            }
    }
};
struct EpiProjStoreOnly {
    static constexpr bool PERM = true;
    unsigned char* ws; bf16_t* gates; const float* rstd;
    __device__ __forceinline__ void operator()(const f32x4 (&acc)[2][2][4][2], const Unit& u, int wr, int wc, int fr, int fq) const {
        const int pn = u.pn, row0 = u.pm * BM + wr * 64 + fr, cl0 = wc * 32 + 8 * fq;
        int pitch = 512, cb = 0; unsigned char* dst = nullptr; int f32out = 0;
        if (pn == 0) { dst = ws + WS_GQ; pitch = 256; }
        else if (pn == 1) { dst = ws + WS_GK; pitch = 256; }
        else if (pn < 4) { dst = ws + WS_GV; cb = (pn - 2) * 256; }
        else if (pn < 6) { dst = ws + WS_SR; cb = (pn - 4) * 256; }
        else if (pn == 6) { dst = ws + WS_LA; pitch = 256; f32out = 1; }
        else if (pn < 9) { dst = ws + WS_DQ; cb = (pn - 7) * 256; }
        else if (pn < 11) { dst = ws + WS_DK; cb = (pn - 9) * 256; }
        else if (pn < 13) { dst = ws + WS_DV; cb = (pn - 11) * 256; }
        else { dst = (unsigned char*)gates; pitch = 2048; cb = (pn - 13) * 256; }
#pragma unroll
        for (int ai = 0; ai < 2; ++ai)
#pragma unroll
            for (int m = 0; m < 4; ++m) { const int row = row0 + ai * HALF + m * 16; const float rs = rstd[row];
#pragma unroll
                for (int bj = 0; bj < 2; ++bj) { const f32x4 v0 = acc[ai][bj][m][0] * rs, v1 = acc[ai][bj][m][1] * rs; const int col = cb + bj * HALF + cl0;
                    if (f32out) { float* o = (float*)dst + (size_t)row * pitch + col; *(f32x4*)o = v0; *(f32x4*)(o + 4) = v1; }
                    else { v4u w; w.x = cvt_pk_bf16(v0[0], v0[1]); w.y = cvt_pk_bf16(v0[2], v0[3]); w.z = cvt_pk_bf16(v1[0], v1[1]); w.w = cvt_pk_bf16(v1[2], v1[3]);
                        *(v4u*)((bf16_t*)dst + (size_t)row * pitch + col) = w; } } }
    }
};
struct EpiPle {
    static constexpr bool PERM = true;
    bf16_t* er; float* sse;
    __device__ __forceinline__ void operator()(const f32x4 (&acc)[2][2][4][2], const Unit& u, int wr, int wc, int fr, int fq) const {
        const int row0 = u.pm * BM + wr * 64 + fr, col0 = u.pn * BM + wc * 32 + 8 * fq;
#pragma unroll
        for (int ai = 0; ai < 2; ++ai)
#pragma unroll
            for (int m = 0; m < 4; ++m) { const int row = row0 + ai * HALF + m * 16; float s = 0.f;
#pragma unroll
                for (int bj = 0; bj < 2; ++bj) { const f32x4 v0 = acc[ai][bj][m][0], v1 = acc[ai][bj][m][1];
                    s += (v0[0] * v0[0] + v0[1] * v0[1]) + (v0[2] * v0[2] + v0[3] * v0[3]) + (v1[0] * v1[0] + v1[1] * v1[1]) + (v1[2] * v1[2] + v1[3] * v1[3]);
                    v4u w; w.x = cvt_pk_bf16(v0[0], v0[1]); w.y = cvt_pk_bf16(v0[2], v0[3]); w.z = cvt_pk_bf16(v1[0], v1[1]); w.w = cvt_pk_bf16(v1[2], v1[3]);
                    *(v4u*)((unsigned char*)er + tp_off(u.pm * 4 + u.pn, (ai * 4 + m) * 2 + bj, (wr * 4 + wc) * 64 + fq * 16 + fr)) = w; }
                s += __shfl_xor(s, 16); s += __shfl_xor(s, 32);
                if (fq == 0) atomicAdd(sse + row, s); }
    }
};
}

namespace da {
constexpr int NW = 8, QBLK = 32, KVBLK = 64, QB = 128, PITCH = 512;
constexpr int SHM_V = KVBLK * 128 * 2, SHM_K = KVBLK * 128 * 2;
constexpr int OFF_WS = 2 * SHM_V + 2 * SHM_K, OFF_EX = OFF_WS + NW * 64 * 4, LDS_NEED = OFF_EX + 4 * 32 * 128 * 4;
constexpr float THRL = 11.5f;
#define KSWZ(row, colB) ((row) * 256 + ((colB) ^ (((row) & 7) << 4)))
#define SBAR() __builtin_amdgcn_sched_barrier(0)
__device__ __forceinline__ int v_st(int k, int c) { const int kk = (k & ~0xC) | ((k & 4) << 1) | ((k & 8) >> 1); return ((kk >> 3) * 4 + (c >> 5)) * 512 + ((kk & 7) * 32 + (c & 31)) * 2; }
__device__ __forceinline__ int v_rd_base(int lane) { return ((lane & 3) << 3) | (((lane >> 2) & 3) << 6) | (((lane >> 4) & 1) << 5) | (((lane >> 5) & 1) << 8); }
constexpr int v_rd_off(int d0, int ks, int half) { return d0 * 512 + ks * 4096 + half * 2048; }
__device__ __forceinline__ int crow(int r, int hi) { return (r & 3) + 8 * (r >> 2) + 4 * hi; }
__device__ __forceinline__ void mask_tile(f32x16& p0, f32x16& p1, int dq) {
    const float NEG = -__builtin_inff();
#pragma unroll
    for (int r = 0; r < 16; ++r) { const int c = (r & 3) + 8 * (r >> 2); if (dq - c < 0) p0[r] = NEG; if (dq - c - 32 < 0) p1[r] = NEG; }
}
__device__ __forceinline__ void partialSM(f32x16& p0, f32x16& p1, float& m_reg, float& mn, float& alpha) {
    float pmax = p0[0];
#pragma unroll
    for (int r = 1; r < 16; ++r) pmax = fmaxf(pmax, p0[r]);
#pragma unroll
    for (int r = 0; r < 16; ++r) pmax = fmaxf(pmax, p1[r]);
    { auto rr = __builtin_amdgcn_permlane32_swap(__float_as_uint(pmax), __float_as_uint(pmax), false, false); pmax = fmaxf(__uint_as_float(rr[0]), __uint_as_float(rr[1])); }
    if (__builtin_expect(__all((pmax - m_reg) <= THRL), 1)) { mn = m_reg; alpha = 1.f; }
    else { mn = fmaxf(m_reg, pmax); alpha = __builtin_amdgcn_exp2f(m_reg - mn); m_reg = mn; }
#pragma unroll
    for (int r = 0; r < 16; ++r) { p0[r] = p0[r] - mn; p1[r] = p1[r] - mn; }
#pragma unroll
    for (int r = 0; r < 16; ++r) p0[r] = __builtin_amdgcn_exp2f(p0[r]);
}
__device__ __forceinline__ void finishSM(f32x16& p0, f32x16& p1, float alpha, float& l_reg, bf16x8& pa0, bf16x8& pa1, bf16x8& pa2, bf16x8& pa3) {
#pragma unroll
    for (int r = 0; r < 16; ++r) p1[r] = __builtin_amdgcn_exp2f(p1[r]);
    float ps = 0;
#pragma unroll
    for (int r = 0; r < 16; ++r) ps += p0[r];
#pragma unroll
    for (int r = 0; r < 16; ++r) ps += p1[r];
    { auto rr = __builtin_amdgcn_permlane32_swap(__float_as_uint(ps), __float_as_uint(ps), false, false); ps = __uint_as_float(rr[0]) + __uint_as_float(rr[1]); }
    l_reg = l_reg * alpha + ps;
#define PK4(P, B_, OUT) do { unsigned a0 = cvt_pk_bf16(P[B_+0], P[B_+1]), a1 = cvt_pk_bf16(P[B_+2], P[B_+3]); unsigned b0 = cvt_pk_bf16(P[B_+4], P[B_+5]), b1 = cvt_pk_bf16(P[B_+6], P[B_+7]); \
        auto r0 = __builtin_amdgcn_permlane32_swap(a0, b0, false, false); auto r1 = __builtin_amdgcn_permlane32_swap(a1, b1, false, false); \
        v4u w = {r0[0], r1[0], r0[1], r1[1]}; OUT = *reinterpret_cast<bf16x8*>(&w); } while (0)
    PK4(p0, 0, pa0); PK4(p0, 8, pa1); PK4(p1, 0, pa2); PK4(p1, 8, pa3);
#undef PK4
}
template <int KB>
__device__ __forceinline__ void qkt(f32x16& p0, f32x16& p1, const char* K_lds, int r32, int hi, int comp, const bf16x8* qr) {
    p0 = f32x16{}; p1 = f32x16{};
#pragma unroll
    for (int dd = 0; dd < 4; ++dd) { const char* a = K_lds + KB * SHM_K + KSWZ(r32, (dd * 16 + hi * 8) * 2) + comp * 128;
        bf16x8 b0 = *reinterpret_cast<const bf16x8*>(a);
        bf16x8 b1 = *reinterpret_cast<const bf16x8*>(a + 32 * 256);
        p0 = __builtin_amdgcn_mfma_f32_32x32x16_bf16(b0, qr[dd], p0, 0, 0, 0);
        p1 = __builtin_amdgcn_mfma_f32_32x32x16_bf16(b1, qr[dd], p1, 0, 0, 0); }
}
template <int VB>
__device__ __forceinline__ void pv_tile(f32x16* o, int vb0, bf16x8 pa0, bf16x8 pa1, bf16x8 pa2, bf16x8 pa3) {
#define TRRD(dst, off) asm volatile("ds_read_b64_tr_b16 %0, %1 offset:%2" : "=&v"(dst) : "v"(vb0), "i"(off) : "memory")
#define PV_D0(d0) do { s16x4 l0, l1, l2, l3, h0, h1, h2, h3; constexpr int b_ = VB * SHM_V + v_rd_off(d0, 0, 0); \
        TRRD(l0, b_); TRRD(h0, b_ + 2048); TRRD(l1, b_ + 4096); TRRD(h1, b_ + 6144); TRRD(l2, b_ + 8192); TRRD(h2, b_ + 10240); TRRD(l3, b_ + 12288); TRRD(h3, b_ + 14336); \
        asm volatile("s_waitcnt lgkmcnt(0)" ::: "memory"); SBAR(); \
        o[d0] = __builtin_amdgcn_mfma_f32_32x32x16_bf16(pa0, (bf16x8){l0[0], l0[1], l0[2], l0[3], h0[0], h0[1], h0[2], h0[3]}, o[d0], 0, 0, 0); \
        o[d0] = __builtin_amdgcn_mfma_f32_32x32x16_bf16(pa1, (bf16x8){l1[0], l1[1], l1[2], l1[3], h1[0], h1[1], h1[2], h1[3]}, o[d0], 0, 0, 0); \
        o[d0] = __builtin_amdgcn_mfma_f32_32x32x16_bf16(pa2, (bf16x8){l2[0], l2[1], l2[2], l2[3], h2[0], h2[1], h2[2], h2[3]}, o[d0], 0, 0, 0); \
        o[d0] = __builtin_amdgcn_mfma_f32_32x32x16_bf16(pa3, (bf16x8){l3[0], l3[1], l3[2], l3[3], h3[0], h3[1], h3[2], h3[3]}, o[d0], 0, 0, 0); } while (0)
    PV_D0(0); PV_D0(1); PV_D0(2); PV_D0(3);
#undef PV_D0
#undef TRRD
}
__device__ __forceinline__ void attn_unit(const bf16_t* Qg, const bf16_t* Kg, const bf16_t* Vg, bf16_t* Og, int P0, float lam, const float* subln, char* lds) {
    int tid = threadIdx.x; asm volatile("" : "+v"(tid));
    const int wid = __builtin_amdgcn_readfirstlane(tid >> 6), lane = tid & 63, r32 = lane & 31, hi = lane >> 5;
    const int comp = wid & 1, rg = wid >> 1;
    const int NT = (P0 + QB - 1) / KVBLK + 1;
    const int qlo = P0 + rg * QBLK, qm = qlo + r32 - 4 * hi;
    char* V_lds = lds; char* K_lds = lds + 2 * SHM_V;
    float* wsf = (float*)(lds + OFF_WS) + wid * 64; float* li_l = wsf, * al_l = wsf + 32;
    float* exch = (float*)(lds + OFF_EX) + rg * (32 * 128);
    float m_reg = -1e30f, l_reg = 0; f32x16 o[4] = {};
    const int sr = tid >> 4, sc = (tid & 15) * 8, vst0 = v_st(sr, sc), vst1 = v_st(32 + sr, sc), kws = KSWZ(sr, sc * 2);
    const int vb0 = (int)(uintptr_t)V_lds + v_rd_base(lane);
    bf16x8 st_v0, st_v1, st_k0, st_k1;
#define ROW(p, k0, rr) ((p) + (size_t)((k0) + (rr)) * PITCH + sc)
#define LD8(p) (*reinterpret_cast<const bf16x8*>(p))
#define SLOAD_H(k0) do { st_v0 = LD8(ROW(Vg, k0, sr)); st_v1 = LD8(ROW(Vg, k0, 32 + sr)); st_k0 = LD8(ROW(Kg, k0, sr)); st_k1 = LD8(ROW(Kg, k0, 32 + sr)); } while (0)
#define SWRITE_HK(bf) do { *(bf16x8*)(K_lds + (bf) * SHM_K + kws) = st_k0; *(bf16x8*)(K_lds + (bf) * SHM_K + kws + 32 * 256) = st_k1; } while (0)
#define SWRITE_HV(bf) do { *(bf16x8*)(V_lds + (bf) * SHM_V + vst0) = st_v0; *(bf16x8*)(V_lds + (bf) * SHM_V + vst1) = st_v1; } while (0)
#define VMW() asm volatile("s_waitcnt vmcnt(0)" ::: "memory")
    bf16x8 qr[4];
#pragma unroll
    for (int dd = 0; dd < 4; ++dd) qr[dd] = LD8(Qg + (size_t)(qlo + r32) * PITCH + comp * 64 + dd * 16 + hi * 8);
    { bf16x8 t_v0, t_v1, t_k0, t_k1;
      SLOAD_H(0); t_v0 = LD8(ROW(Vg, KVBLK, sr)); t_v1 = LD8(ROW(Vg, KVBLK, 32 + sr)); t_k0 = LD8(ROW(Kg, KVBLK, sr)); t_k1 = LD8(ROW(Kg, KVBLK, 32 + sr));
      VMW(); SWRITE_HK(0); SWRITE_HV(0); st_v0 = t_v0; st_v1 = t_v1; st_k0 = t_k0; st_k1 = t_k1; SBAR(); }
    __syncthreads();
#define RESC(a) do { if (__any((a) < 1.f)) { if (hi == 0) al_l[r32] = (a); asm volatile("s_waitcnt lgkmcnt(0)" ::: "memory"); \
                     _Pragma("unroll") for (int d_ = 0; d_ < 4; ++d_) _Pragma("unroll") for (int r = 0; r < 16; ++r) o[d_][r] *= al_l[crow(r, hi)]; } } while (0)
#define KBASE(t) ((t) * KVBLK)
#define MASKT(P0_, P1_, t) do { const int kb_ = KBASE(t); if (kb_ + KVBLK - 1 > qlo) mask_tile(P0_, P1_, qm - kb_); } while (0)
    f32x16 pA0, pA1, pB0, pB1; float mnA, mnB, alA, alB; bf16x8 pa0, pa1, pa2, pa3;
    SBAR(); qkt<0>(pA0, pA1, K_lds, r32, hi, comp, qr);
    MASKT(pA0, pA1, 0); partialSM(pA0, pA1, m_reg, mnA, alA);
    VMW(); SWRITE_HK(1); SWRITE_HV(1);
    __syncthreads();
#define HALF_STEP(PX0, PX1, mnX, alX, PY0, PY1, alY, t, KB, VB, SB) do { \
        SBAR(); qkt<KB>(PX0, PX1, K_lds, r32, hi, comp, qr); \
        finishSM(PY0, PY1, alY, l_reg, pa0, pa1, pa2, pa3); SBAR(); \
        if ((t) + 1 < NT) { SLOAD_H(KBASE((t) + 1)); SBAR(); } \
        pv_tile<VB>(o, vb0, pa0, pa1, pa2, pa3); MASKT(PX0, PX1, (t)); partialSM(PX0, PX1, m_reg, mnX, alX); \
        __syncthreads(); \
        if ((t) + 1 < NT) { VMW(); SWRITE_HK(SB); SWRITE_HV(SB); } \
        RESC(alX); __syncthreads(); } while (0)
    for (int t = 1; t + 1 < NT; t += 2) {
        HALF_STEP(pB0, pB1, mnB, alB, pA0, pA1, alA, t, 1, 0, 0);
        HALF_STEP(pA0, pA1, mnA, alA, pB0, pB1, alB, t + 1, 0, 1, 1);
    }
    SBAR(); qkt<1>(pB0, pB1, K_lds, r32, hi, comp, qr); SBAR();
    finishSM(pA0, pA1, alA, l_reg, pa0, pa1, pa2, pa3); SBAR();
    pv_tile<0>(o, vb0, pa0, pa1, pa2, pa3);
    MASKT(pB0, pB1, NT - 1); partialSM(pB0, pB1, m_reg, mnB, alB); __syncthreads(); RESC(alB);
    finishSM(pB0, pB1, alB, l_reg, pa0, pa1, pa2, pa3); SBAR(); pv_tile<1>(o, vb0, pa0, pa1, pa2, pa3);
    if (hi == 0) li_l[r32] = l_reg; asm volatile("s_waitcnt lgkmcnt(0)" ::: "memory");
    float rli[16];
#pragma unroll
    for (int r = 0; r < 16; ++r) rli[r] = __builtin_amdgcn_rcpf(li_l[crow(r, hi)]);
    if (comp == 1) {
#pragma unroll
        for (int r = 0; r < 16; ++r) { const float f = rli[r] * lam;
#pragma unroll
            for (int d0 = 0; d0 < 4; ++d0) exch[crow(r, hi) * 128 + d0 * 32 + r32] = o[d0][r] * f; }
    }
    __syncthreads();
    if (comp == 0) {
#pragma unroll
        for (int r = 0; r < 16; ++r) { const int orow = crow(r, hi);
#pragma unroll
            for (int d0 = 0; d0 < 4; ++d0) { const int a = orow * 128 + d0 * 32 + r32; exch[a] = o[d0][r] * rli[r] - exch[a]; } }
        asm volatile("s_waitcnt lgkmcnt(0)" ::: "memory");
        const int pc = lane & 15, pr = lane >> 4;
        const f32x4 g0 = *(const f32x4*)(subln + pc * 8) * (1.f - LAMBDA_INIT), g1 = *(const f32x4*)(subln + pc * 8 + 4) * (1.f - LAMBDA_INIT);
#pragma unroll
        for (int i = 0; i < 8; ++i) { const int row = 4 * i + pr; const f32x4 v0 = *(const f32x4*)(exch + row * 128 + pc * 8), v1 = *(const f32x4*)(exch + row * 128 + pc * 8 + 4);
            float s = (v0[0] * v0[0] + v0[1] * v0[1]) + (v0[2] * v0[2] + v0[3] * v0[3]) + (v1[0] * v1[0] + v1[1] * v1[1]) + (v1[2] * v1[2] + v1[3] * v1[3]);
            s += __shfl_xor(s, 1); s += __shfl_xor(s, 2); s += __shfl_xor(s, 4); s += __shfl_xor(s, 8);
            const float rs = 1.0f / sqrtf(s * (1.f / 128.f) + EPS);
            const f32x4 w0 = v0 * g0 * rs, w1 = v1 * g1 * rs;
            v4u wv; wv.x = cvt_pk_bf16(w0[0], w0[1]); wv.y = cvt_pk_bf16(w0[2], w0[3]); wv.z = cvt_pk_bf16(w1[0], w1[1]); wv.w = cvt_pk_bf16(w1[2], w1[3]);
            *(v4u*)(Og + (size_t)(qlo + row) * PITCH + pc * 8) = wv; }
    }
    __syncthreads();
#undef ROW
#undef LD8
#undef SLOAD_H
#undef SWRITE_HK
#undef SWRITE_HV
#undef VMW
#undef RESC
#undef KBASE
#undef MASKT
#undef HALF_STEP
}
#undef KSWZ
#undef SBAR
}

namespace gla {
constexpr int PT = 144, PW = 272;
constexpr int L_QD = 0, L_KI = 9216, L_KIT = 18432, L_VT = 27648, L_SBT = 46080, L_ATT = 64512, L_DEC = 73728;
constexpr int L_QR = 73984, L_KR = L_QR + 9216, L_LR = L_KR + 9216, L_OT = L_LR + 17408, LDS_NEED = L_OT + 17408;
static_assert(LDS_NEED <= RING_BYTES + 4096, "gla lds");
__device__ __forceinline__ float wave_scan(float x) {
#define DPPF(v, ctrl, rmask) __int_as_float(__builtin_amdgcn_update_dpp(0, __float_as_int(v), (ctrl), (rmask), 0xf, false))
    x += DPPF(x, 0x111, 0xf); x += DPPF(x, 0x112, 0xf); x += DPPF(x, 0x114, 0xf); x += DPPF(x, 0x118, 0xf);
    x += DPPF(x, 0x142, 0xa); x += DPPF(x, 0x143, 0xc);
#undef DPPF
    return x;
}
struct Stage { v4u rq, rk, rla0, rla1, rv0, rv1; };
#define GBAR() asm volatile("s_waitcnt lgkmcnt(0)\n\ts_barrier" ::: "memory")
__device__ __forceinline__ void gla_item(int b, int h, const bf16_t* gq, const bf16_t* gk, const bf16_t* gv, const bf16_t* sr, const float* la, const float* gnorm, bf16_t* oa, LAS unsigned char* lds) {
    int tid = threadIdx.x; asm volatile("" : "+v"(tid));
    const int w = __builtin_amdgcn_readfirstlane(tid >> 6), lane = tid & 63, l15 = lane & 15, lq = lane >> 4;
    const size_t tok0 = (size_t)b * SEQ;
    constexpr int NCH = SEQ / 64;
    const int qrow = tid >> 3, qch = tid & 7;
    const int prow0 = tid >> 4, pch = tid & 15;
    const int vrow = 16 * (w & 3) + l15, vch0 = lq + 4 * (w >> 2);
    const bf16_t* qg = gq + (tok0 + qrow) * 256 + h * 64 + qch * 8;
    const bf16_t* kg = gk + (tok0 + qrow) * 256 + h * 64 + qch * 8;
    const float* lg = la + (tok0 + prow0) * 256 + h * 64 + pch * 4;
    const bf16_t* vg = gv + (tok0 + vrow) * 512 + h * 128 + vch0 * 8;
    const bf16_t* sg = sr + (tok0 + prow0) * 512 + h * 128 + pch * 8;
    bf16_t* og = oa + (tok0 + prow0) * 512 + h * 128 + pch * 8;
#define GLA_LOAD(ST, n_) do { const size_t adv_ = (size_t)((n_) < NCH ? (n_) : NCH - 1) * 64; \
        ST.rq = *(const v4u*)(qg + adv_ * 256); ST.rk = *(const v4u*)(kg + adv_ * 256); \
        ST.rla0 = *(const v4u*)(lg + adv_ * 256); ST.rla1 = *(const v4u*)(lg + (adv_ + 32) * 256); \
        ST.rv0 = *(const v4u*)(vg + adv_ * 512); ST.rv1 = *(const v4u*)(vg + adv_ * 512 + 64); } while (0)
#define GLA_RAW(ST) do { *(LAS v4u*)(lds + L_QR + qrow * PT + qch * 16) = ST.rq; *(LAS v4u*)(lds + L_KR + qrow * PT + qch * 16) = ST.rk; \
        *(LAS v4u*)(lds + L_LR + prow0 * PW + pch * 16) = ST.rla0; *(LAS v4u*)(lds + L_LR + (prow0 + 32) * PW + pch * 16) = ST.rla1; } while (0)
#define SR_LOAD(S0, S1, n_) do { const size_t adv_ = (size_t)((n_) < NCH ? (n_) : NCH - 1) * 64; S0 = *(const v4u*)(sg + adv_ * 512); S1 = *(const v4u*)(sg + (adv_ + 32) * 512); } while (0)
#define GLA_OUT(S0, S1, m_) do { const size_t adv_ = (size_t)(m_) * 64; \
        _Pragma("unroll") for (int i_ = 0; i_ < 2; ++i_) { const v4u ov = *(const LAS v4u*)(lds + L_OT + (prow0 + 32 * i_) * PW + pch * 16); const v4u sv = i_ ? S1 : S0; v4u r_; \
            r_.x = cvt_pk_bf16(bf_lo(ov.x) * bf_lo(sv.x), bf_hi(ov.x) * bf_hi(sv.x)); r_.y = cvt_pk_bf16(bf_lo(ov.y) * bf_lo(sv.y), bf_hi(ov.y) * bf_hi(sv.y)); \
            r_.z = cvt_pk_bf16(bf_lo(ov.z) * bf_lo(sv.z), bf_hi(ov.z) * bf_hi(sv.z)); r_.w = cvt_pk_bf16(bf_lo(ov.w) * bf_lo(sv.w), bf_hi(ov.w) * bf_hi(sv.w)); \
            *(v4u*)(og + (adv_ + 32 * i_) * 512) = r_; } } while (0)
    Stage sA, sB; v4u srA0, srA1, srB0 = {0u, 0u, 0u, 0u}, srB1 = {0u, 0u, 0u, 0u};
    GLA_LOAD(sA, 0); SR_LOAD(srA0, srA1, 0); GLA_LOAD(sB, 1);
    GLA_RAW(sA);
    f32x4 S[4][2];
#pragma unroll
    for (int i = 0; i < 4; ++i) { S[i][0] = (f32x4){0.f, 0.f, 0.f, 0.f}; S[i][1] = (f32x4){0.f, 0.f, 0.f, 0.f}; }
    const int sw = w - 4;
    const int c = 16 * w + l15;
    f32x4 gn[8];
#pragma unroll
    for (int vb = 0; vb < 8; ++vb) gn[vb] = *(const f32x4*)(gnorm + 16 * vb + 4 * lq);
    GBAR();
#define GLA_CHUNK(X, Y, SRS0, SRS1, n) do { \
          \
        if ((n) > 0) GLA_OUT(SRS0, SRS1, (n) - 1); \
        { const v4u q8 = *(const LAS v4u*)(lds + L_QR + lane * PT + 16 * w), k8 = *(const LAS v4u*)(lds + L_KR + lane * PT + 16 * w); \
          const f32x4 la0 = *(const LAS f32x4*)(lds + L_LR + lane * PW + 32 * w), la1 = *(const LAS f32x4*)(lds + L_LR + lane * PW + 32 * w + 16); \
          float bb[8] = {la0[0], la0[1], la0[2], la0[3], la1[0], la1[1], la1[2], la1[3]}; \
          unsigned qd[4], ki[4]; \
          _Pragma("unroll") for (int j = 0; j < 8; ++j) bb[j] = wave_scan(bb[j]); \
          _Pragma("unroll") for (int j = 0; j < 8; j += 2) { \
            const float e0 = __builtin_amdgcn_exp2f(bb[j] * LOG2E), e1 = __builtin_amdgcn_exp2f(bb[j + 1] * LOG2E); \
            const float i0 = __builtin_amdgcn_rcpf(e0), i1 = __builtin_amdgcn_rcpf(e1); \
            const unsigned qw = q8[j >> 1], kw = k8[j >> 1]; \
            qd[j >> 1] = cvt_pk_bf16(bf_lo(qw) * e0, bf_hi(qw) * e1); \
            ki[j >> 1] = cvt_pk_bf16(bf_lo(kw) * i0, bf_hi(kw) * i1); \
            const float d0 = __int_as_float(__builtin_amdgcn_readlane(__float_as_int(e0), 63)), d1 = __int_as_float(__builtin_amdgcn_readlane(__float_as_int(e1), 63)); \
            if (lane == 0) { *(LAS float*)(lds + L_DEC + (8 * w + j) * 4) = d0; *(LAS float*)(lds + L_DEC + (8 * w + j + 1) * 4) = d1; } \
            *(LAS unsigned short*)(lds + L_KIT + (8 * w + j) * PT + lane * 2) = (unsigned short)(ki[j >> 1] & 0xffffu); \
            *(LAS unsigned short*)(lds + L_KIT + (8 * w + j + 1) * PT + lane * 2) = (unsigned short)(ki[j >> 1] >> 16); \
          } \
          *(LAS v4u*)(lds + L_QD + lane * PT + 16 * w) = (v4u){qd[0], qd[1], qd[2], qd[3]}; \
          *(LAS v4u*)(lds + L_KI + lane * PT + 16 * w) = (v4u){ki[0], ki[1], ki[2], ki[3]}; } \
        _Pragma("unroll") for (int i = 0; i < 4; ++i) { \
            *(LAS unsigned short*)(lds + L_VT + (vch0 * 8 + 2 * i) * PT + vrow * 2) = (unsigned short)(X.rv0[i] & 0xffffu); \
            *(LAS unsigned short*)(lds + L_VT + (vch0 * 8 + 2 * i + 1) * PT + vrow * 2) = (unsigned short)(X.rv0[i] >> 16); \
            *(LAS unsigned short*)(lds + L_VT + (vch0 * 8 + 64 + 2 * i) * PT + vrow * 2) = (unsigned short)(X.rv1[i] & 0xffffu); \
            *(LAS unsigned short*)(lds + L_VT + (vch0 * 8 + 64 + 2 * i + 1) * PT + vrow * 2) = (unsigned short)(X.rv1[i] >> 16); \
        } \
        if (w >= 4) { \
            _Pragma("unroll") for (int db = 0; db < 4; ++db) \
                _Pragma("unroll") for (int vb = 0; vb < 2; ++vb) { v2u o_; o_.x = cvt_pk_bf16(S[db][vb][0], S[db][vb][1]); o_.y = cvt_pk_bf16(S[db][vb][2], S[db][vb][3]); \
                    *(LAS v2u*)(lds + L_SBT + (32 * sw + 16 * vb + l15) * PT + (16 * db + 4 * lq) * 2) = o_; } \
        } \
        GBAR(); \
          \
        GLA_RAW(Y); \
        GLA_LOAD(X, (n) + 2); SR_LOAD(SRS0, SRS1, (n) + 1); \
        if (w < 4) { \
            bf16x8 qf[2]; \
            _Pragma("unroll") for (int ks = 0; ks < 2; ++ks) qf[ks] = *(const LAS bf16x8*)(lds + L_QD + (16 * w + l15) * PT + (32 * ks + 8 * lq) * 2); \
            _Pragma("unroll") for (int sb = 0; sb < 4; ++sb) { \
                f32x4 a = (f32x4){0.f, 0.f, 0.f, 0.f}; \
                _Pragma("unroll") for (int ks = 0; ks < 2; ++ks) { const bf16x8 kf = *(const LAS bf16x8*)(lds + L_KI + (16 * sb + l15) * PT + (32 * ks + 8 * lq) * 2); \
                    a = __builtin_amdgcn_mfma_f32_16x16x32_bf16(kf, qf[ks], a, 0, 0, 0); } \
                _Pragma("unroll") for (int r = 0; r < 4; ++r) if (16 * sb + 4 * lq + r > c) a[r] = 0.f; \
                v2u o_; o_.x = cvt_pk_bf16(a[0], a[1]); o_.y = cvt_pk_bf16(a[2], a[3]); \
                *(LAS v2u*)(lds + L_ATT + w * 2304 + l15 * PT + (16 * sb + 4 * lq) * 2) = o_; \
            } \
            asm volatile("s_waitcnt lgkmcnt(0)" ::: "memory"); \
            bf16x8 af[2]; \
            _Pragma("unroll") for (int ks = 0; ks < 2; ++ks) af[ks] = *(const LAS bf16x8*)(lds + L_ATT + w * 2304 + l15 * PT + (32 * ks + 8 * lq) * 2); \
            f32x4 o[8]; float ssq = 0.f; \
            _Pragma("unroll") for (int vb = 0; vb < 8; ++vb) { \
                f32x4 a = (f32x4){0.f, 0.f, 0.f, 0.f}; \
                _Pragma("unroll") for (int ks = 0; ks < 2; ++ks) { const bf16x8 vf = *(const LAS bf16x8*)(lds + L_VT + (16 * vb + l15) * PT + (32 * ks + 8 * lq) * 2); \
                    a = __builtin_amdgcn_mfma_f32_16x16x32_bf16(vf, af[ks], a, 0, 0, 0); } \
                _Pragma("unroll") for (int ks = 0; ks < 2; ++ks) { const bf16x8 sf = *(const LAS bf16x8*)(lds + L_SBT + (16 * vb + l15) * PT + (32 * ks + 8 * lq) * 2); \
                    a = __builtin_amdgcn_mfma_f32_16x16x32_bf16(sf, qf[ks], a, 0, 0, 0); } \
                o[vb] = a; ssq += (a[0] * a[0] + a[1] * a[1]) + (a[2] * a[2] + a[3] * a[3]); \
            } \
            ssq += __shfl_xor(ssq, 16); ssq += __shfl_xor(ssq, 32); \
            const float rs = 1.0f / sqrtf(ssq * (1.f / 128.f) + EPS); \
            _Pragma("unroll") for (int vb = 0; vb < 8; ++vb) { const f32x4 g = gn[vb] * rs; \
                v2u w2; w2.x = cvt_pk_bf16(o[vb][0] * g[0], o[vb][1] * g[1]); w2.y = cvt_pk_bf16(o[vb][2] * g[2], o[vb][3] * g[3]); \
                *(LAS v2u*)(lds + L_OT + c * PW + (16 * vb + 4 * lq) * 2) = w2; } \
        } else { \
            _Pragma("unroll") for (int ks = 0; ks < 2; ++ks) { \
                bf16x8 vf[2]; \
                _Pragma("unroll") for (int vb = 0; vb < 2; ++vb) vf[vb] = *(const LAS bf16x8*)(lds + L_VT + (32 * sw + 16 * vb + l15) * PT + (32 * ks + 8 * lq) * 2); \
                _Pragma("unroll") for (int db = 0; db < 4; ++db) { const bf16x8 kf = *(const LAS bf16x8*)(lds + L_KIT + (16 * db + l15) * PT + (32 * ks + 8 * lq) * 2); \
                    _Pragma("unroll") for (int vb = 0; vb < 2; ++vb) S[db][vb] = __builtin_amdgcn_mfma_f32_16x16x32_bf16(kf, vf[vb], S[db][vb], 0, 0, 0); } \
            } \
            _Pragma("unroll") for (int db = 0; db < 4; ++db) { const f32x4 dc = *(const LAS f32x4*)(lds + L_DEC + (16 * db + 4 * lq) * 4); S[db][0] = S[db][0] * dc; S[db][1] = S[db][1] * dc; } \
        } \
        GBAR(); \
    } while (0)
#pragma unroll 1
    for (int n = 0; n < NCH; n += 2) { GLA_CHUNK(sA, sB, srB0, srB1, n); GLA_CHUNK(sB, sA, srA0, srA1, n + 1); }
    GLA_OUT(srB0, srB1, NCH - 1);
    GBAR();
#undef GLA_CHUNK
#undef GLA_LOAD
#undef GLA_RAW
#undef SR_LOAD
#undef GLA_OUT
}
#undef GBAR
}

namespace pg8 {
struct PleOrder {
    StaticOrder so; int G, c;
    __device__ __forceinline__ bool next(int i, Unit& u) const {
        if (G != 256) return so.next(i, u);
        if (c < 128 || i >= 4) return false; const int L = (c - 128) * 4 + i; u.pm = L >> 2; u.pn = L & 3; return true; }
    __device__ __forceinline__ unsigned arow(const Unit&, int) const { return 0u; }
};
struct BranchOrder {
    StaticOrder so;
    __device__ __forceinline__ bool next(int i, Unit& u) const { Unit t; if (!so.next(i >> 1, t)) return false; u.pm = t.pm + (i & 1) * 128; u.pn = t.pn + (i & 1) * 4; return true; }
    __device__ __forceinline__ unsigned arow(const Unit&, int) const { return 0u; }
};
struct EpiBranch {
    static constexpr bool PERM = true;
    const bf16_t* gates; bf16_t* m1; bf16_t* mg;
    __device__ __forceinline__ void operator()(const f32x4 (&acc)[2][2][4][2], const Unit& u, int wr, int wc, int fr, int fq) const {
        const bool isb = u.pm >= 128; const int pm = isb ? u.pm - 128 : u.pm, pn = isb ? u.pn - 4 : u.pn;
        const int row0 = pm * BM + wr * 64 + fr, col0 = pn * BM + wc * 32 + 8 * fq, tid = (wr * 4 + wc) * 64 + fq * 16 + fr, tile = pm * 4 + pn;
        const unsigned char* gp = (const unsigned char*)gates + tp_off((isb ? 512 : 0) + tile, 0, tid); unsigned char* m1p = (unsigned char*)m1 + tp_off(tile, 0, tid);
        bf16_t* mp = mg + (size_t)row0 * DM + col0;
#pragma unroll
        for (int ai = 0; ai < 2; ++ai) {
            v4u G[4][2], Pm[4][2];
#pragma unroll
            for (int m = 0; m < 4; ++m)
#pragma unroll
                for (int bj = 0; bj < 2; ++bj) G[m][bj] = *(const v4u*)(gp + (size_t)((ai * 4 + m) * 2 + bj) * 8192);
            if (isb) {
#pragma unroll
                for (int m = 0; m < 4; ++m)
#pragma unroll
                    for (int bj = 0; bj < 2; ++bj) Pm[m][bj] = *(const v4u*)(m1p + (size_t)((ai * 4 + m) * 2 + bj) * 8192);
            } else {
#pragma unroll
                for (int m = 0; m < 4; ++m)
#pragma unroll
                    for (int bj = 0; bj < 2; ++bj) Pm[m][bj] = (v4u){0u, 0u, 0u, 0u};
            }
#pragma unroll
            for (int m = 0; m < 4; ++m)
#pragma unroll
                for (int bj = 0; bj < 2; ++bj) { const v4u g = G[m][bj], p = Pm[m][bj];
                    const f32x4 a0 = acc[ai][bj][m][0], a1 = acc[ai][bj][m][1];
                    const float r0 = a0[0] * bf_lo(g.x) + bf_lo(p.x), r1 = a0[1] * bf_hi(g.x) + bf_hi(p.x), r2 = a0[2] * bf_lo(g.y) + bf_lo(p.y), r3 = a0[3] * bf_hi(g.y) + bf_hi(p.y);
                    const float r4 = a1[0] * bf_lo(g.z) + bf_lo(p.z), r5 = a1[1] * bf_hi(g.z) + bf_hi(p.z), r6 = a1[2] * bf_lo(g.w) + bf_lo(p.w), r7 = a1[3] * bf_hi(g.w) + bf_hi(p.w);
                    v4u w; w.x = cvt_pk_bf16(r0, r1); w.y = cvt_pk_bf16(r2, r3); w.z = cvt_pk_bf16(r4, r5); w.w = cvt_pk_bf16(r6, r7);
                    if (isb) *(v4u*)(mp + (size_t)(ai * HALF + m * 16) * DM + bj * HALF) = w;
                    else *(v4u*)(m1p + (size_t)((ai * 4 + m) * 2 + bj) * 8192) = w; }
        }
    }
};
template <bool LOADS, bool STORES> struct EpiBranchProbe {
    static constexpr bool PERM = true;
    const bf16_t* gates; bf16_t* m1; bf16_t* mg;
    __device__ __forceinline__ void operator()(const f32x4 (&acc)[2][2][4][2], const Unit& u, int wr, int wc, int fr, int fq) const {
        const bool isb = u.pm >= 128; const int pm = isb ? u.pm - 128 : u.pm, pn = isb ? u.pn - 4 : u.pn;
        const int row0 = pm * BM + wr * 64 + fr, col0 = pn * BM + wc * 32 + 8 * fq, tid = (wr * 4 + wc) * 64 + fq * 16 + fr, tile = pm * 4 + pn;
        const unsigned char* gp = (const unsigned char*)gates + tp_off((isb ? 512 : 0) + tile, 0, tid); unsigned char* m1p = (unsigned char*)m1 + tp_off(tile, 0, tid);
        bf16_t* mp = mg + (size_t)row0 * DM + col0;
#pragma unroll
        for (int ai = 0; ai < 2; ++ai) {
            v4u G[4][2], Pm[4][2];
#pragma unroll
            for (int m = 0; m < 4; ++m)
#pragma unroll
                for (int bj = 0; bj < 2; ++bj) G[m][bj] = LOADS ? *(const v4u*)(gp + (size_t)((ai * 4 + m) * 2 + bj) * 8192) : (v4u){0x3f803f80u, 0x3f803f80u, 0x3f803f80u, 0x3f803f80u};
            if (isb && LOADS) {
#pragma unroll
                for (int m = 0; m < 4; ++m)
#pragma unroll
                    for (int bj = 0; bj < 2; ++bj) Pm[m][bj] = *(const v4u*)(m1p + (size_t)((ai * 4 + m) * 2 + bj) * 8192);
            } else {
#pragma unroll
                for (int m = 0; m < 4; ++m)
#pragma unroll
                    for (int bj = 0; bj < 2; ++bj) Pm[m][bj] = (v4u){0u, 0u, 0u, 0u};
            }
#pragma unroll
            for (int m = 0; m < 4; ++m)
#pragma unroll
                for (int bj = 0; bj < 2; ++bj) { const v4u g = G[m][bj], p = Pm[m][bj];
                    const f32x4 a0 = acc[ai][bj][m][0], a1 = acc[ai][bj][m][1];
                    const float r0 = a0[0] * bf_lo(g.x) + bf_lo(p.x), r1 = a0[1] * bf_hi(g.x) + bf_hi(p.x), r2 = a0[2] * bf_lo(g.y) + bf_lo(p.y), r3 = a0[3] * bf_hi(g.y) + bf_hi(p.y);
                    const float r4 = a1[0] * bf_lo(g.z) + bf_lo(p.z), r5 = a1[1] * bf_hi(g.z) + bf_hi(p.z), r6 = a1[2] * bf_lo(g.w) + bf_lo(p.w), r7 = a1[3] * bf_hi(g.w) + bf_hi(p.w);
                    v4u w; w.x = cvt_pk_bf16(r0, r1); w.y = cvt_pk_bf16(r2, r3); w.z = cvt_pk_bf16(r4, r5); w.w = cvt_pk_bf16(r6, r7);
                    if (STORES) { if (isb) *(v4u*)(mp + (size_t)(ai * HALF + m * 16) * DM + bj * HALF) = w;
                    else *(v4u*)(m1p + (size_t)((ai * 4 + m) * 2 + bj) * 8192) = w; }
                    else if (w.x == 0x12345678u && w.y == 0x9abcdef0u) *(v4u*)(m1p) = w; }
        }
    }
};
struct EpiNull { static constexpr bool PERM = true; float* sink;
    __device__ __forceinline__ void operator()(const f32x4 (&acc)[2][2][4][2], const Unit& u, int wr, int wc, int fr, int fq) const {
        float s = 0.f;
#pragma unroll
        for (int ai = 0; ai < 2; ++ai)
#pragma unroll
            for (int bj = 0; bj < 2; ++bj)
#pragma unroll
                for (int m = 0; m < 4; ++m)
#pragma unroll
                    for (int n = 0; n < 2; ++n) s += acc[ai][bj][m][n][0] + acc[ai][bj][m][n][1] + acc[ai][bj][m][n][2] + acc[ai][bj][m][n][3];
        if (s == 1.2345e-30f) *sink = s; } };
struct EpiOut {
    static constexpr bool PERM = true;
    const float* x; bf16_t* hb; float* ss;
    __device__ __forceinline__ void operator()(const f32x4 (&acc)[2][2][4][2], const Unit& u, int wr, int wc, int fr, int fq) const {
        const int row0 = u.pm * BM + wr * 64 + fr, col0 = u.pn * BM + wc * 32 + 8 * fq;
        const float* xp = x + (size_t)row0 * DM + col0; bf16_t* hp = hb + (size_t)row0 * DM + col0;
#pragma unroll
        for (int ai = 0; ai < 2; ++ai) {
            f32x4 X[4][2][2];
#pragma unroll
            for (int m = 0; m < 4; ++m)
#pragma unroll
                for (int bj = 0; bj < 2; ++bj) { const float* q = xp + (size_t)(ai * HALF + m * 16) * DM + bj * HALF; X[m][bj][0] = *(const f32x4*)q; X[m][bj][1] = *(const f32x4*)(q + 4); }
#pragma unroll
            for (int m = 0; m < 4; ++m) { float s = 0.f;
#pragma unroll
                for (int bj = 0; bj < 2; ++bj) { const f32x4 v0 = acc[ai][bj][m][0] + X[m][bj][0], v1 = acc[ai][bj][m][1] + X[m][bj][1];
                    s += (v0[0] * v0[0] + v0[1] * v0[1]) + (v0[2] * v0[2] + v0[3] * v0[3]) + (v1[0] * v1[0] + v1[1] * v1[1]) + (v1[2] * v1[2] + v1[3] * v1[3]);
                    v4u w; w.x = cvt_pk_bf16(v0[0], v0[1]); w.y = cvt_pk_bf16(v0[2], v0[3]); w.z = cvt_pk_bf16(v1[0], v1[1]); w.w = cvt_pk_bf16(v1[2], v1[3]);
                    *(v4u*)(hp + (size_t)(ai * HALF + m * 16) * DM + bj * HALF) = w; }
                s += __shfl_xor(s, 16); s += __shfl_xor(s, 32);
                if (fq == 0) atomicAdd(ss + row0 + ai * HALF + m * 16, s); }
        }
    }
};
template <int npn> struct MoeOrder {
    const LAS int* ts; const LAS int* cnt; const int* list; const float* lval; int G, c;
    __device__ __forceinline__ int expert_of(int tile) const { int e = 0;
#pragma unroll 1
        for (int i = 1; i < NEXP; ++i) if (ts[i] <= tile) e = i; return e; }
    __device__ __forceinline__ bool next(int i, Unit& u) const {
        const int L = i * G + c, total = ts[NEXP] * npn; if (L >= total) return false;
        const int tile = L / npn, pl = L % npn; u.pm = tile; u.pn = expert_of(tile) * npn + pl; return true; }
    __device__ __forceinline__ int entry(const Unit& u, int r) const { const int e = u.pn / npn, pos = (u.pm - ts[e]) * BM + r; return pos < cnt[e] ? list[(size_t)e * T + pos] : -1; }
    __device__ __forceinline__ unsigned arow(const Unit& u, int r) const { const int en = entry(u, r); return en < 0 ? 0u : (unsigned)(en >> 1); }
    __device__ __forceinline__ size_t lpos(const Unit& u, int r, bool& valid) const { const int e = u.pn / npn, pos = (u.pm - ts[e]) * BM + r; valid = pos < cnt[e]; return (size_t)e * T + (valid ? pos : 0); }
};
struct EpiUp {
    static constexpr bool PERM = true;
    MoeOrder<2> mo; bf16_t* he;
    __device__ __forceinline__ void operator()(const f32x4 (&acc)[2][2][4][2], const Unit& u, int wr, int wc, int fr, int fq) const {
        const int pl = u.pn & 1, col0 = pl * 128 + wc * 32 + 8 * fq;
        float rsv[2][4];
#pragma unroll
        for (int ai = 0; ai < 2; ++ai)
#pragma unroll
            for (int m = 0; m < 4; ++m) { bool valid; const size_t lp = mo.lpos(u, ai * HALF + wr * 64 + m * 16 + fr, valid); const float v = mo.lval[lp]; rsv[ai][m] = valid ? v : 0.f; }
#pragma unroll
        for (int ai = 0; ai < 2; ++ai)
#pragma unroll
            for (int m = 0; m < 4; ++m) { const int r = ai * HALF + wr * 64 + m * 16 + fr; const float rs = rsv[ai][m];
                const f32x4 g0 = acc[ai][0][m][0] * rs, g1 = acc[ai][0][m][1] * rs, u0 = acc[ai][1][m][0] * rs, u1 = acc[ai][1][m][1] * rs;
                v4u w; w.x = cvt_pk_bf16(g0[0] * sigmoidf_(g0[0]) * u0[0], g0[1] * sigmoidf_(g0[1]) * u0[1]); w.y = cvt_pk_bf16(g0[2] * sigmoidf_(g0[2]) * u0[2], g0[3] * sigmoidf_(g0[3]) * u0[3]);
                w.z = cvt_pk_bf16(g1[0] * sigmoidf_(g1[0]) * u1[0], g1[1] * sigmoidf_(g1[1]) * u1[1]); w.w = cvt_pk_bf16(g1[2] * sigmoidf_(g1[2]) * u1[2], g1[3] * sigmoidf_(g1[3]) * u1[3]);
                *(v4u*)(he + (size_t)(u.pm * BM + r) * DEXP + col0) = w; }
    }
};
struct EpiDown {
    static constexpr bool PERM = true;
    MoeOrder<4> mo; bf16_t* yb;
    __device__ __forceinline__ void operator()(const f32x4 (&acc)[2][2][4][2], const Unit& u, int wr, int wc, int fr, int fq) const {
        const int col0 = (u.pn & 3) * BM + wc * 32 + 8 * fq;
        float wv[2][4]; int env[2][4];
#pragma unroll
        for (int ai = 0; ai < 2; ++ai)
#pragma unroll
            for (int m = 0; m < 4; ++m) { bool valid; const size_t lp = mo.lpos(u, ai * HALF + wr * 64 + m * 16 + fr, valid); const float v = mo.lval[lp]; const int en = mo.list[lp]; wv[ai][m] = v; env[ai][m] = valid ? en : -1; }
#pragma unroll
        for (int ai = 0; ai < 2; ++ai)
#pragma unroll
            for (int m = 0; m < 4; ++m) { const int en = env[ai][m];
                if (en >= 0) { const float wt = wv[ai][m];
#pragma unroll
                    for (int bj = 0; bj < 2; ++bj) { const f32x4 v0 = acc[ai][bj][m][0] * wt, v1 = acc[ai][bj][m][1] * wt;
                        v4u w; w.x = cvt_pk_bf16(v0[0], v0[1]); w.y = cvt_pk_bf16(v0[2], v0[3]); w.z = cvt_pk_bf16(v1[0], v1[1]); w.w = cvt_pk_bf16(v1[2], v1[3]);
                        *(v4u*)(yb + (size_t)en * DM + col0 + bj * HALF) = w; } } }
    }
};
struct EpiFinal {
    static constexpr bool PERM = true;
    const bf16_t* h2b; const bf16_t* er; const float* sse; const float* gple; bf16_t* vb16; float* ssf;
    __device__ __forceinline__ void operator()(const f32x4 (&acc)[2][2][4][2], const Unit& u, int wr, int wc, int fr, int fq) const {
        const int row0 = u.pm * BM + wr * 64 + fr, col0 = u.pn * BM + wc * 32 + 8 * fq;
#pragma unroll
        for (int ai = 0; ai < 2; ++ai)
#pragma unroll
        for (int mh = 0; mh < 2; ++mh) {
            v4u H[2][2], Ee[2][2]; float rev[2];
#pragma unroll
            for (int mm = 0; mm < 2; ++mm) { const int m = mh * 2 + mm; rev[mm] = sse[row0 + ai * HALF + m * 16];
#pragma unroll
                for (int bj = 0; bj < 2; ++bj) { const size_t off = (size_t)(row0 + ai * HALF + m * 16) * DM + col0 + bj * HALF; H[mm][bj] = *(const v4u*)(h2b + off); Ee[mm][bj] = *(const v4u*)((const unsigned char*)er + tp_off(u.pm * 4 + u.pn, (ai * 4 + m) * 2 + bj, (wr * 4 + wc) * 64 + fq * 16 + fr)); } }
#pragma unroll
            for (int mm = 0; mm < 2; ++mm) { const int m = mh * 2 + mm; const int row = row0 + ai * HALF + m * 16; float s = 0.f; const float re = 1.0f / sqrtf(rev[mm] * (1.f / DM) + EPS);
#pragma unroll
                for (int bj = 0; bj < 2; ++bj) { const size_t off = (size_t)row * DM + col0 + bj * HALF;
                    const v4u hh = H[mm][bj], ee = Ee[mm][bj]; const f32x4 g0 = *(const f32x4*)(gple + col0 + bj * HALF) * re, g1 = *(const f32x4*)(gple + col0 + bj * HALF + 4) * re;
                    const f32x4 a0 = acc[ai][bj][m][0], a1 = acc[ai][bj][m][1]; f32x4 v0, v1;
                    v0[0] = bf_lo(hh.x) + sigmoidf_(a0[0]) * bf_lo(ee.x) * g0[0]; v0[1] = bf_hi(hh.x) + sigmoidf_(a0[1]) * bf_hi(ee.x) * g0[1];
                    v0[2] = bf_lo(hh.y) + sigmoidf_(a0[2]) * bf_lo(ee.y) * g0[2]; v0[3] = bf_hi(hh.y) + sigmoidf_(a0[3]) * bf_hi(ee.y) * g0[3];
                    v1[0] = bf_lo(hh.z) + sigmoidf_(a1[0]) * bf_lo(ee.z) * g1[0]; v1[1] = bf_hi(hh.z) + sigmoidf_(a1[1]) * bf_hi(ee.z) * g1[1];
                    v1[2] = bf_lo(hh.w) + sigmoidf_(a1[2]) * bf_lo(ee.w) * g1[2]; v1[3] = bf_hi(hh.w) + sigmoidf_(a1[3]) * bf_hi(ee.w) * g1[3];
                    s += (v0[0] * v0[0] + v0[1] * v0[1]) + (v0[2] * v0[2] + v0[3] * v0[3]) + (v1[0] * v1[0] + v1[1] * v1[1]) + (v1[2] * v1[2] + v1[3] * v1[3]);
                    v4u wv; wv.x = cvt_pk_bf16(v0[0], v0[1]); wv.y = cvt_pk_bf16(v0[2], v0[3]); wv.z = cvt_pk_bf16(v1[0], v1[1]); wv.w = cvt_pk_bf16(v1[2], v1[3]);
                    *(v4u*)(vb16 + off) = wv; }
                s += __shfl_xor(s, 16); s += __shfl_xor(s, 32);
                if (fq == 0) atomicAdd(ssf + row, s); }
        }
    }
};
}

constexpr int WR_PT = 2064;
__device__ __forceinline__ void p4_router(const Frame& F, const Params& P) {
    unsigned char* ws = PWS(); unsigned* ctl = (unsigned*)(ws + WS_CTL);
    const bf16_t* hb = (const bf16_t*)(ws + WS_XB); const bf16_t* Wr = (const bf16_t*)(ws + WS_WR); const float* ss2 = (const float*)(ctl + CW_SS2);
    const float* b_rg = PIN(18); const float* b_re = PIN(20);
    int* list = (int*)(ws + WS_LIST); float* lrs = (float*)(ws + WS_LRS); float* lw = (float*)(ws + WS_LW);
    LAS unsigned char* lds = F.lds; const int lane = F.lane, w = F.wave, l15 = lane & 15, lq = lane >> 4;
    for (int i = F.tid; i < 48 * 128; i += NTHREADS) { const int r = i >> 7, c = i & 127; *(LAS v4u*)(lds + r * WR_PT + c * 16) = *(const v4u*)(Wr + (size_t)r * DM + c * 8); }
    LAS int* lcnt = (LAS int*)(lds + 100352);
    LAS float* lsc = (LAS float*)(lds + 101376) + w * (16 * 49);
    for (int grp = F.vcu * 8 + w; grp < T / 16; grp += F.G * 8) {
        if (F.tid < 64) lcnt[F.tid] = 0;
        __syncthreads();
        const int t0 = grp * 16;
        f32x4 a0 = {0.f, 0.f, 0.f, 0.f}, a1 = a0, a2 = a0;
        const bf16_t* hrow = hb + (size_t)(t0 + l15) * DM + 8 * lq;
        bf16x8 hfr[32];
#pragma unroll
        for (int ks = 0; ks < 32; ++ks) hfr[ks] = *(const bf16x8*)(hrow + 32 * ks);
#pragma unroll
        for (int ks = 0; ks < 32; ++ks) { const bf16x8 hf = hfr[ks];
            const bf16x8 w0 = *(const LAS bf16x8*)(lds + (l15) * WR_PT + (32 * ks + 8 * lq) * 2), w1 = *(const LAS bf16x8*)(lds + (16 + l15) * WR_PT + (32 * ks + 8 * lq) * 2), w2 = *(const LAS bf16x8*)(lds + (32 + l15) * WR_PT + (32 * ks + 8 * lq) * 2);
            a0 = __builtin_amdgcn_mfma_f32_16x16x32_bf16(w0, hf, a0, 0, 0, 0); a1 = __builtin_amdgcn_mfma_f32_16x16x32_bf16(w1, hf, a1, 0, 0, 0); a2 = __builtin_amdgcn_mfma_f32_16x16x32_bf16(w2, hf, a2, 0, 0, 0); }
#pragma unroll
        for (int r = 0; r < 4; ++r) { lsc[l15 * 49 + 4 * lq + r] = a0[r]; lsc[l15 * 49 + 16 + 4 * lq + r] = a1[r]; lsc[l15 * 49 + 32 + 4 * lq + r] = a2[r]; }
        asm volatile("s_waitcnt lgkmcnt(0)" ::: "memory");
        int e0g = 0, e1g = 0, s0 = 0, s1 = 0; float w0 = 0.f, w1 = 0.f, rsk = 0.f;
        if (lane < 16) { const int t = t0 + lane; const float rs = 1.0f / sqrtf(ss2[t] * (1.f / DM) + EPS); rsk = rs; const LAS float* lg = lsc + lane * 49;
            int g = 0; float mg = lg[0] * rs + b_rg[0]; float gl[4]; gl[0] = mg;
#pragma unroll
            for (int i = 1; i < 4; ++i) { gl[i] = lg[i] * rs + b_rg[i]; if (gl[i] > mg) { mg = gl[i]; g = i; } }
            float sg = 0.f;
#pragma unroll
            for (int i = 0; i < 4; ++i) sg += __expf(gl[i] - mg);
            const float gp = 1.f / sg;
            float m0 = -INFINITY, m1 = -INFINITY; int i0 = 0, i1 = 0;
            for (int i = 0; i < 8; ++i) { const float v = lg[4 + g * 8 + i] * rs + b_re[g * 8 + i]; if (v > m0) { m1 = m0; i1 = i0; m0 = v; i0 = i; } else if (v > m1) { m1 = v; i1 = i; } }
            const float p1 = __expf(m1 - m0), inv = 1.f / (1.f + p1);
            e0g = g * 8 + i0; e1g = g * 8 + i1; w0 = gp * inv; w1 = gp * p1 * inv;
            s0 = atomicAdd((int*)&lcnt[e0g], 1); s1 = atomicAdd((int*)&lcnt[e1g], 1);
            }
        __syncthreads();
        if (F.tid < 32) { const int c = lcnt[F.tid]; lcnt[32 + F.tid] = c ? atomicAdd((int*)(ctl + CW_CNT + F.tid), c) : 0; }
        __syncthreads();
        if (lane < 16) { const int t = t0 + lane; const size_t p0 = (size_t)e0g * T + lcnt[32 + e0g] + s0, p1 = (size_t)e1g * T + lcnt[32 + e1g] + s1;
            list[p0] = t * 2; list[p1] = t * 2 + 1; lrs[p0] = rsk; lrs[p1] = rsk; lw[p0] = w0; lw[p1] = w1; }
        __syncthreads();
    }
}
__device__ __forceinline__ void moe_tables(const Frame& F, const unsigned* ctl) {
    LAS int* ts = (LAS int*)(F.lds + XTRA_OFF); LAS int* cnt = ts + 64;
    if (F.tid == 0) { int acc = 0; for (int e = 0; e < NEXP; ++e) { const int c = (int)__hip_atomic_load(ctl + CW_CNT + e, __ATOMIC_RELAXED, __HIP_MEMORY_SCOPE_AGENT); cnt[e] = c; ts[e] = acc; acc += (c + 255) >> 8; } ts[NEXP] = acc; }
    __syncthreads();
}

#ifndef PM
#define PM 0xfff
#endif
#ifndef PROBE
#define PROBE 0
#endif
#ifndef P1_ALIGN
#define P1_ALIGN true
#endif
__global__ void __launch_bounds__(NTHREADS, 2) fwd_megakernel(Params P) {
    extern __shared__ __attribute__((aligned(16))) unsigned char lds_raw[];
    Frame F;
    F.lds = (LAS unsigned char*)lds_raw;
    F.tid = threadIdx.x; F.lane = F.tid & 63; F.wave = __builtin_amdgcn_readfirstlane(F.tid >> 6);
    F.G = gridDim.x; { const int bx = blockIdx.x; F.vcu = (F.G % 8 == 0) ? (bx % 8) * (F.G / 8) + bx / 8 : bx; }
    { volatile LAS unsigned* st = (volatile LAS unsigned*)(F.lds + XTRA_OFF + 8192); if (F.tid < 2) st[F.tid] = 0u; }
    __syncthreads();
    const XcdBarrier gbar = xcd_barrier_post((unsigned*)(PWS() + WS_CTL) + CW_BAR, (volatile LAS unsigned*)(F.lds + XTRA_OFF + 8192));
#define GRID_SYNC() xcd_barrier(gbar)

    if (PM & 1) p0_prologue(F, P);
    GRID_SYNC();
#if PROBE == 7
    p0_prologue(F, P);
    GRID_SYNC();
#endif

#if PROBE == 11
    {
        unsigned char* ws = PWS(); bf16_t* gates = (bf16_t*)POUT();
        pg8::Gemm g{(const bf16_t*)(ws + WS_XB), (const bf16_t*)(ws + WS_WP), T, NPROJ, DM}; pg8::StaticOrder S; S.init(T, NPROJ, F.G, (int)blockIdx.x);
        pg8::EpiProjStoreOnly E{ws, gates, (const float*)(ws + WS_RSTD1)};
        pg8::gemm_phase<pg8::EpiProjStoreOnly, pg8::StaticOrder, true, false>(F.lds, g, S, E);
    }
    GRID_SYNC();
#endif
    if (PM & 2) {
        unsigned char* ws = PWS(); bf16_t* gates = (bf16_t*)POUT();
        pg8::Gemm g{(const bf16_t*)(ws + WS_XB), (const bf16_t*)(ws + WS_WP), T, NPROJ, DM}; pg8::StaticOrder S; S.init(T, NPROJ, F.G, (int)blockIdx.x);
        pg8::EpiProj E{ws, gates, (const float*)(ws + WS_RSTD1), PIN(6), (const float*)(ws + WS_COS), (const float*)(ws + WS_SIN)};
#ifdef STAGGER_US
        if ((int)blockIdx.x >= 128) { const unsigned long long t0 = __builtin_amdgcn_s_memrealtime(); while (__builtin_amdgcn_s_memrealtime() - t0 < (unsigned long long)(STAGGER_US * 100)) __builtin_amdgcn_s_sleep(32); }
#endif
        pg8::gemm_phase<pg8::EpiProj, pg8::StaticOrder, P1_ALIGN, false>(F.lds, g, S, E);
    }
#if PROBE == 3
    GRID_SYNC();
    if (PM & 2) {
        unsigned char* ws = PWS(); bf16_t* gates = (bf16_t*)POUT();
        pg8::Gemm g{(const bf16_t*)(ws + WS_XB), (const bf16_t*)(ws + WS_WP), T, NPROJ, DM}; pg8::StaticOrder S; S.init(T, NPROJ, F.G, (int)blockIdx.x);
        pg8::EpiProj E{ws, gates, (const float*)(ws + WS_RSTD1), PIN(6), (const float*)(ws + WS_COS), (const float*)(ws + WS_SIN)};
        pg8::gemm_phase<pg8::EpiProj, pg8::StaticOrder, true, false>(F.lds, g, S, E);
    }
#endif
#if PROBE == 9
    GRID_SYNC();
    {
        unsigned char* ws = PWS();
        pg8::Gemm g{(const bf16_t*)(ws + WS_XB), (const bf16_t*)(ws + WS_WP), T, NPROJ, DM}; pg8::StaticOrder S; S.init(T, NPROJ, F.G, (int)blockIdx.x);
        pg8::EpiNull E{(float*)(ws + WS_RSTD1)};
        pg8::gemm_phase<pg8::EpiNull, pg8::StaticOrder, true, false>(F.lds, g, S, E);
    }
#endif
#if PROBE == 10
    GRID_SYNC();
    {
        unsigned char* ws = PWS();
        pg8::Gemm g{(const bf16_t*)(ws + WS_XB), (const bf16_t*)(ws + WS_WAB), 2 * T, 2048, 512}; pg8::BranchOrder S; S.so.init(T, DM, F.G, (int)blockIdx.x);
        pg8::EpiNull E{(float*)(ws + WS_RSTD1)};
        pg8::gemm_phase<pg8::EpiNull, pg8::BranchOrder, true, false>(F.lds, g, S, E);
    }
#endif
    if (PM & 4) {
        unsigned char* ws = PWS(); unsigned* ctl = (unsigned*)(ws + WS_CTL);
        pg8::Gemm g{(const bf16_t*)(ws + WS_PB), (const bf16_t*)(ws + WS_WPLE), T, DM, PLE}; pg8::PleOrder S; S.so.init(T, DM, F.G, (int)blockIdx.x); S.G = F.G; S.c = (int)blockIdx.x;
        pg8::EpiPle E{(bf16_t*)(ws + WS_ER), (float*)(ctl + CW_SSE)};
        pg8::gemm_phase<pg8::EpiPle, pg8::PleOrder, true, false>(F.lds, g, S, E);
    }
    GRID_SYNC();

    if (PM & 8) {
        unsigned char* ws = PWS(); unsigned* ctl = (unsigned*)(ws + WS_CTL);
        float lam;
        { float d1 = 0.f, d2 = 0.f; for (int i = 0; i < 64; ++i) { d1 += PIN(8)[i] * PIN(9)[i]; d2 += PIN(10)[i] * PIN(11)[i]; } lam = expf(d1) - expf(d2) + LAMBDA_INIT; }
        LAS int* qslot = (LAS int*)(F.lds + XTRA_OFF + 4096);
        bf16_t* oab = (bf16_t*)(ws + WS_XB);
#define P2_LOOP(QW, FIRST, LAST) \
        for (;;) { \
            __syncthreads(); \
            if (F.tid == 0) qslot[0] = (FIRST) + (int)atomicAdd(ctl + CW_QUEUE + (QW), 1u); \
            __syncthreads(); \
            const int item = qslot[0]; \
            if (item >= (LAST)) break; \
            if (item < 64) { \
                gla::gla_item(item >> 2, item & 3, (const bf16_t*)(ws + WS_GQ), (const bf16_t*)(ws + WS_GK), (const bf16_t*)(ws + WS_GV), (const bf16_t*)(ws + WS_SR), \
                              (const float*)(ws + WS_LA), PIN(7), oab, F.lds); \
            } else { \
                const int j = item - 64, qb = 15 - (j >> 6), bh = j & 63, b = bh >> 2, h = bh & 3; \
                const size_t base = (size_t)b * SEQ * 512 + h * 128; \
                da::attn_unit((const bf16_t*)(ws + WS_DQ) + base, (const bf16_t*)(ws + WS_DK) + base, (const bf16_t*)(ws + WS_DV) + base, \
                              oab + (size_t)T * 512 + base, qb * 128, lam, PIN(12), (char*)lds_raw); \
            } \
        }
#if PROBE == 1
        P2_LOOP(1, 0, 64) GRID_SYNC();
#elif PROBE == 2
        P2_LOOP(1, 64, 64 + 1024) GRID_SYNC();
#endif
        P2_LOOP(0, 0, 64 + 1024)
    }
    GRID_SYNC();

#if PROBE == 12 || PROBE == 13 || PROBE == 14
    {
        unsigned char* ws = PWS(); bf16_t* gates = (bf16_t*)POUT();
        pg8::Gemm g{(const bf16_t*)(ws + WS_XB), (const bf16_t*)(ws + WS_WAB), 2 * T, 2048, 512}; pg8::BranchOrder S; S.so.init(T, DM, F.G, (int)blockIdx.x);
#if PROBE == 12
        typedef pg8::EpiBranchProbe<true, true> EP;
#elif PROBE == 13
        typedef pg8::EpiBranchProbe<false, true> EP;
#else
        typedef pg8::EpiBranchProbe<true, false> EP;
#endif
        EP E{gates, (bf16_t*)(ws + WS_DQ), (bf16_t*)(ws + WS_MG)};
        pg8::gemm_phase<EP, pg8::BranchOrder, true, false>(F.lds, g, S, E);
    }
    GRID_SYNC();
#endif
    if (PM & 16) {
        unsigned char* ws = PWS(); bf16_t* gates = (bf16_t*)POUT();
        pg8::Gemm g{(const bf16_t*)(ws + WS_XB), (const bf16_t*)(ws + WS_WAB), 2 * T, 2048, 512}; pg8::BranchOrder S; S.so.init(T, DM, F.G, (int)blockIdx.x);
        pg8::EpiBranch E{gates, (bf16_t*)(ws + WS_DQ), (bf16_t*)(ws + WS_MG)};
        pg8::gemm_phase<pg8::EpiBranch, pg8::BranchOrder, true, false>(F.lds, g, S, E);
    }
    GRID_SYNC();
#if PROBE == 4
    if (PM & 16) {
        unsigned char* ws = PWS(); bf16_t* gates = (bf16_t*)POUT();
        pg8::Gemm g{(const bf16_t*)(ws + WS_XB), (const bf16_t*)(ws + WS_WAB), 2 * T, 2048, 512}; pg8::BranchOrder S; S.so.init(T, DM, F.G, (int)blockIdx.x);
        pg8::EpiBranch E{gates, (bf16_t*)(ws + WS_DQ), (bf16_t*)(ws + WS_MG)};
        pg8::gemm_phase<pg8::EpiBranch, pg8::BranchOrder, true, false>(F.lds, g, S, E);
    }
    GRID_SYNC();
#endif

    if (PM & 32) {
        unsigned char* ws = PWS(); unsigned* ctl = (unsigned*)(ws + WS_CTL);
        pg8::Gemm g{(const bf16_t*)(ws + WS_MG), (const bf16_t*)(ws + WS_WO), T, DM, DM}; pg8::StaticOrder S; S.init(T, DM, F.G, (int)blockIdx.x);
        pg8::EpiOut E{PIN(0), (bf16_t*)(ws + WS_XB), (float*)(ctl + CW_SS2)};
        pg8::gemm_phase<pg8::EpiOut, pg8::StaticOrder, true, false>(F.lds, g, S, E);
    }
    GRID_SYNC();

    if (PM & 64) p4_router(F, P);
    GRID_SYNC();

    moe_tables(F, (const unsigned*)(PWS() + WS_CTL));
    if (PM & 128) {
        unsigned char* ws = PWS(); unsigned* ctl = (unsigned*)(ws + WS_CTL);
        pg8::MoeOrder<2> mo{(const LAS int*)(F.lds + XTRA_OFF), (const LAS int*)(F.lds + XTRA_OFF) + 64, (const int*)(ws + WS_LIST), (const float*)(ws + WS_LRS), F.G, (int)blockIdx.x};
        pg8::Gemm g{(const bf16_t*)(ws + WS_XB), (const bf16_t*)(ws + WS_WGU), T, NEXP * 512, DM};
        pg8::EpiUp E{mo, (bf16_t*)(ws + WS_HE)};
        pg8::gemm_phase<pg8::EpiUp, pg8::MoeOrder<2>, true, true>(F.lds, g, mo, E);
    }
    GRID_SYNC();
#if PROBE == 5
    if (PM & 128) {
        unsigned char* ws = PWS(); unsigned* ctl = (unsigned*)(ws + WS_CTL);
        pg8::MoeOrder<2> mo{(const LAS int*)(F.lds + XTRA_OFF), (const LAS int*)(F.lds + XTRA_OFF) + 64, (const int*)(ws + WS_LIST), (const float*)(ws + WS_LRS), F.G, (int)blockIdx.x};
        pg8::Gemm g{(const bf16_t*)(ws + WS_XB), (const bf16_t*)(ws + WS_WGU), T, NEXP * 512, DM};
        pg8::EpiUp E{mo, (bf16_t*)(ws + WS_HE)};
        pg8::gemm_phase<pg8::EpiUp, pg8::MoeOrder<2>, true, true>(F.lds, g, mo, E);
    }
    GRID_SYNC();
#endif
    if (PM & 256) {
        unsigned char* ws = PWS();
        pg8::MoeOrder<4> mo{(const LAS int*)(F.lds + XTRA_OFF), (const LAS int*)(F.lds + XTRA_OFF) + 64, (const int*)(ws + WS_LIST), (const float*)(ws + WS_LW), F.G, (int)blockIdx.x};
        pg8::Gemm g{(const bf16_t*)(ws + WS_HE), (const bf16_t*)(ws + WS_WD), MOE_ROWS, NEXP * 1024, DEXP};
        pg8::EpiDown E{mo, (bf16_t*)(ws + WS_YB)};
        pg8::gemm_phase<pg8::EpiDown, pg8::MoeOrder<4>, true, false>(F.lds, g, mo, E);
    }
    GRID_SYNC();
#if PROBE == 6
    if (PM & 256) {
        unsigned char* ws = PWS();
        pg8::MoeOrder<4> mo{(const LAS int*)(F.lds + XTRA_OFF), (const LAS int*)(F.lds + XTRA_OFF) + 64, (const int*)(ws + WS_LIST), (const float*)(ws + WS_LW), F.G, (int)blockIdx.x};
        pg8::Gemm g{(const bf16_t*)(ws + WS_HE), (const bf16_t*)(ws + WS_WD), MOE_ROWS, NEXP * 1024, DEXP};
        pg8::EpiDown E{mo, (bf16_t*)(ws + WS_YB)};
        pg8::gemm_phase<pg8::EpiDown, pg8::MoeOrder<4>, true, false>(F.lds, g, mo, E);
    }
    GRID_SYNC();
#endif
    if (PM & 512) {
        unsigned char* ws = PWS();
        const bf16_t* hb = (const bf16_t*)(ws + WS_XB); const bf16_t* yb = (const bf16_t*)(ws + WS_YB); bf16_t* h2b = (bf16_t*)(ws + WS_H2B);
        const int gt = F.vcu * NTHREADS + F.tid, NGT = F.G * NTHREADS;
        for (int i = gt; i < T * DM / 8; i += NGT) { const int t = i >> 7, c = (i & 127) * 8;
            const v4u a = *(const v4u*)(hb + (size_t)t * DM + c), y0 = *(const v4u*)(yb + (size_t)(2 * t) * DM + c), y1 = *(const v4u*)(yb + (size_t)(2 * t + 1) * DM + c);
            v4u o; o.x = cvt_pk_bf16(bf_lo(a.x) + bf_lo(y0.x) + bf_lo(y1.x), bf_hi(a.x) + bf_hi(y0.x) + bf_hi(y1.x)); o.y = cvt_pk_bf16(bf_lo(a.y) + bf_lo(y0.y) + bf_lo(y1.y), bf_hi(a.y) + bf_hi(y0.y) + bf_hi(y1.y));
            o.z = cvt_pk_bf16(bf_lo(a.z) + bf_lo(y0.z) + bf_lo(y1.z), bf_hi(a.z) + bf_hi(y0.z) + bf_hi(y1.z)); o.w = cvt_pk_bf16(bf_lo(a.w) + bf_lo(y0.w) + bf_lo(y1.w), bf_hi(a.w) + bf_hi(y0.w) + bf_hi(y1.w));
            *(v4u*)(h2b + (size_t)t * DM + c) = o; }
    }
    GRID_SYNC();
#if PROBE == 8
    if (PM & 512) {
        unsigned char* ws = PWS();
        const bf16_t* hb = (const bf16_t*)(ws + WS_XB); const bf16_t* yb = (const bf16_t*)(ws + WS_YB); bf16_t* h2b = (bf16_t*)(ws + WS_H2B);
        const int gt = F.vcu * NTHREADS + F.tid, NGT = F.G * NTHREADS;
        for (int i = gt; i < T * DM / 8; i += NGT) { const int t = i >> 7, c = (i & 127) * 8;
            const v4u a = *(const v4u*)(hb + (size_t)t * DM + c), y0 = *(const v4u*)(yb + (size_t)(2 * t) * DM + c), y1 = *(const v4u*)(yb + (size_t)(2 * t + 1) * DM + c);
            v4u o; o.x = cvt_pk_bf16(bf_lo(a.x) + bf_lo(y0.x) + bf_lo(y1.x), bf_hi(a.x) + bf_hi(y0.x) + bf_hi(y1.x)); o.y = cvt_pk_bf16(bf_lo(a.y) + bf_lo(y0.y) + bf_lo(y1.y), bf_hi(a.y) + bf_hi(y0.y) + bf_hi(y1.y));
            o.z = cvt_pk_bf16(bf_lo(a.z) + bf_lo(y0.z) + bf_lo(y1.z), bf_hi(a.z) + bf_hi(y0.z) + bf_hi(y1.z)); o.w = cvt_pk_bf16(bf_lo(a.w) + bf_lo(y0.w) + bf_lo(y1.w), bf_hi(a.w) + bf_hi(y0.w) + bf_hi(y1.w));
            *(v4u*)(h2b + (size_t)t * DM + c) = o; }
    }
    GRID_SYNC();
#endif
    if (PM & 1024) {
        unsigned char* ws = PWS(); unsigned* ctl = (unsigned*)(ws + WS_CTL);
        pg8::Gemm g{(const bf16_t*)(ws + WS_H2B), (const bf16_t*)(ws + WS_WPG), T, DM, DM}; pg8::StaticOrder S; S.init(T, DM, F.G, (int)blockIdx.x);
        pg8::EpiFinal E{(const bf16_t*)(ws + WS_H2B), (const bf16_t*)(ws + WS_ER), (const float*)(ctl + CW_SSE), PIN(25), (bf16_t*)(ws + WS_YB), (float*)(ctl + CW_SSF)};
        pg8::gemm_phase<pg8::EpiFinal, pg8::StaticOrder, true, false>(F.lds, g, S, E);
    }
    GRID_SYNC();
    if (PM & 2048) {
        unsigned char* ws = PWS(); unsigned* ctl = (unsigned*)(ws + WS_CTL);
        const float* ssf = (const float*)(ctl + CW_SSF); const float* gf = PIN(27); float* out = POUT();
        const int gt = F.vcu * NTHREADS + F.tid, NGT = F.G * NTHREADS;
        for (int i = gt; i < T * DM / 4; i += NGT) { const int t = i >> 8, c = (i & 255) * 4; const float rs = 1.0f / sqrtf(ssf[t] * (1.f / DM) + EPS);
            const v2u pv = *(const v2u*)((const bf16_t*)(ws + WS_YB) + (size_t)t * DM + c); const f32x4 g = *(const f32x4*)(gf + c); f32x4 v = {bf_lo(pv.x), bf_hi(pv.x), bf_lo(pv.y), bf_hi(pv.y)}; v = v * g * rs; *(f32x4*)(out + (size_t)t * DM + c) = v; }
    }
}

extern "C" void kernel_launch(void* const* d_in, const int* in_sizes, int n_in, void* d_out, int out_size, void* d_ws, size_t ws_size, hipStream_t stream) {
    static int grid = 0;
    if (grid == 0) {
        if (n_in != 28 || out_size != T * DM || ws_size < WS_END) { fprintf(stderr, "kernel_launch: unexpected shapes (n_in %d, out %d, ws %zu < %zu)\n", n_in, out_size, ws_size, (size_t)WS_END); grid = -1; return; }
        int dev = 0, cus = 0, per_cu = 0;
        hipGetDevice(&dev); hipDeviceGetAttribute(&cus, hipDeviceAttributeMultiprocessorCount, dev);
        if (hipFuncSetAttribute((const void*)fwd_megakernel, hipFuncAttributeMaxDynamicSharedMemorySize, LDS_BYTES) != hipSuccess) { fprintf(stderr, "kernel_launch: hipFuncSetAttribute failed\n"); grid = -1; return; }
        if (hipOccupancyMaxActiveBlocksPerMultiprocessor(&per_cu, (const void*)fwd_megakernel, NTHREADS, LDS_BYTES) != hipSuccess || per_cu < 1) { fprintf(stderr, "kernel_launch: occupancy query says %d blocks/CU\n", per_cu); grid = -1; return; }
        grid = cus;
        fprintf(stderr, "kernel_launch: cus %d per_cu %d grid %d ws %zu\n", cus, per_cu, grid, ws_size);
    }
    if (grid < 0) return;
    hipMemsetAsync((char*)d_ws + WS_CTL, 0, CTL_ZERO_BYTES, stream);
    Params p{};
    for (int i = 0; i < 28; ++i) p.p[i] = d_in[i];
    p.p[28] = d_out; p.p[29] = d_ws;
    void* args[] = {&p};
    hipError_t e = hipLaunchCooperativeKernel((const void*)fwd_megakernel, dim3(grid), dim3(NTHREADS), args, LDS_BYTES, stream);
    if (e != hipSuccess) fprintf(stderr, "cooperative launch failed: %s (grid %d)\n", hipGetErrorString(e), grid);
}
```
